# Optimizing an MI355X kernel written in HIP

```python
import math
import jax
import jax.numpy as jnp
from jax import lax
import numpy as np

D_MODEL = 1024
BATCH = 2
SEQ = 8192
DEPTH = 2

HEAD_DIM = 64
SB_HEADS = 8
SB_WIDTH = SB_HEADS * HEAD_DIM
CONV_GROUPS = 8
CONV_WIDTH = D_MODEL - SB_WIDTH
CONV_GROUP_DIM = CONV_WIDTH // CONV_GROUPS
CONV_K = 3
EVEN_IN = 3 * SB_WIDTH + 3 * CONV_WIDTH
DIFF_HEADS = 8
DIFF_QK_DIM = 64
DIFF_V_DIM = 2 * DIFF_QK_DIM
DIFF_WIDTH = DIFF_HEADS * DIFF_V_DIM
ODD_IN = DIFF_HEADS * (4 * DIFF_QK_DIM + DIFF_V_DIM)
D_FF = 4 * D_MODEL
N_EVEN = (DEPTH + 1) // 2
N_ODD = DEPTH // 2
Q_BLOCK = 128
NORM_EPS = 1e-6

kernel_name = 'hybrid_stickbreak_shortconv_diffattn'


def rmsnorm(x, g):
    xf = x.astype(jnp.float32)
    y = xf * lax.rsqrt(jnp.mean(jnp.square(xf), axis=-1, keepdims=True) + NORM_EPS)
    return (y * g.astype(jnp.float32)).astype(x.dtype)


def split_heads(t, n_heads):
    b, s, _ = t.shape
    return t.reshape(b, s, n_heads, -1).transpose(0, 2, 1, 3)


def merge_heads(t):
    b, h, s, d = t.shape
    return t.transpose(0, 2, 1, 3).reshape(b, s, h * d)


def stick_breaking_attention(q, k, v):
    seq = q.shape[2]
    scale = HEAD_DIM ** -0.5
    outs = []
    for start in range(0, seq, Q_BLOCK):
        end = start + Q_BLOCK
        z = jnp.einsum('bhqd,bhkd->bhqk', q[:, :, start:end], k[:, :, :end]).astype(jnp.float32) * scale
        past = jnp.arange(end)[None, :] < jnp.arange(start, end)[:, None]
        log_beta = jax.nn.log_sigmoid(z)
        log_keep = jnp.where(past, log_beta - z, 0.0)
        later = lax.cumsum(log_keep, axis=3, reverse=True) - log_keep
        w = jnp.where(past, jnp.exp(log_beta + later), 0.0)
        outs.append(jnp.einsum('bhqk,bhkd->bhqd', w.astype(v.dtype), v[:, :, :end]))
    return jnp.concatenate(outs, axis=2)


def short_gated_conv(b_gate, c_gate, u, w):
    seq = u.shape[1]
    cu = c_gate * u
    padded = jnp.pad(cu, ((0, 0), (CONV_K - 1, 0), (0, 0)))
    y = sum(padded[:, j:j + seq] * w[j] for j in range(CONV_K))
    return b_gate * y


def differential_attention(q1, q2, k1, k2, v, lam):
    seq = q1.shape[2]
    scale = DIFF_QK_DIM ** -0.5
    lam = lam.astype(jnp.float32)
    outs = []
    for start in range(0, seq, Q_BLOCK):
        end = start + Q_BLOCK
        causal = jnp.arange(end)[None, :] <= jnp.arange(start, end)[:, None]
        s1 = jnp.einsum('bhqd,bhkd->bhqk', q1[:, :, start:end], k1[:, :, :end]).astype(jnp.float32) * scale
        s2 = jnp.einsum('bhqd,bhkd->bhqk', q2[:, :, start:end], k2[:, :, :end]).astype(jnp.float32) * scale
        p1 = jax.nn.softmax(jnp.where(causal, s1, -jnp.inf), axis=-1)
        p2 = jax.nn.softmax(jnp.where(causal, s2, -jnp.inf), axis=-1)
        w = p1 - lam * p2
        outs.append(jnp.einsum('bhqk,bhkd->bhqd', w.astype(v.dtype), v[:, :, :end]))
    return jnp.concatenate(outs, axis=2)


def setup_inputs(seed: int = 0) -> dict:
    key = jax.random.key(seed)
    ks = jax.random.split(key, 16)

    def normal(k, shape, scale):
        return jax.random.normal(k, shape, jnp.float32) * scale

    return {
        'x': normal(ks[0], (BATCH, SEQ, D_MODEL), 1.0),
        'norm_mix': 1.0 + normal(ks[1], (DEPTH, D_MODEL), 0.02),
        'norm_mlp': 1.0 + normal(ks[2], (DEPTH, D_MODEL), 0.02),
        'norm_final': 1.0 + normal(ks[3], (D_MODEL,), 0.02),
        'w_in_even': normal(ks[4], (N_EVEN, D_MODEL, EVEN_IN), D_MODEL ** -0.5),
        'conv_w': normal(ks[5], (N_EVEN, CONV_K, CONV_WIDTH), CONV_K ** -0.5),
        'w_out_even': normal(ks[6], (N_EVEN, SB_WIDTH + CONV_WIDTH, D_MODEL), (SB_WIDTH + CONV_WIDTH) ** -0.5),
        'w_in_odd': normal(ks[7], (N_ODD, D_MODEL, ODD_IN), D_MODEL ** -0.5),
        'lam_q1': normal(ks[8], (N_ODD, DIFF_QK_DIM), 0.1),
        'lam_k1': normal(ks[9], (N_ODD, DIFF_QK_DIM), 0.1),
        'lam_q2': normal(ks[10], (N_ODD, DIFF_QK_DIM), 0.1),
        'lam_k2': normal(ks[11], (N_ODD, DIFF_QK_DIM), 0.1),
        'subln_g': 1.0 + normal(ks[12], (N_ODD, DIFF_V_DIM), 0.02),
        'w_out_odd': normal(ks[13], (N_ODD, DIFF_WIDTH, D_MODEL), DIFF_WIDTH ** -0.5),
        'w_up': normal(ks[14], (DEPTH, D_MODEL, D_FF), D_MODEL ** -0.5),
        'w_down': normal(ks[15], (DEPTH, D_FF, D_MODEL), D_FF ** -0.5),
    }


def reference(x, norm_mix, norm_mlp, norm_final, w_in_even, conv_w, w_out_even,
              w_in_odd, lam_q1, lam_k1, lam_q2, lam_k2, subln_g, w_out_odd, w_up, w_down):
    b, s, _ = x.shape
    for layer in range(DEPTH):
        i = layer // 2
        h = rmsnorm(x, norm_mix[layer])
        if layer % 2 == 0:
            proj = h @ w_in_even[i]
            q, k, v, b_gate, c_gate, u = jnp.split(
                proj,
                [SB_WIDTH, 2 * SB_WIDTH, 3 * SB_WIDTH,
                 3 * SB_WIDTH + CONV_WIDTH, 3 * SB_WIDTH + 2 * CONV_WIDTH],
                axis=-1)
            a_out = merge_heads(stick_breaking_attention(
                split_heads(q, SB_HEADS), split_heads(k, SB_HEADS), split_heads(v, SB_HEADS)))
            c_out = short_gated_conv(b_gate, c_gate, u, conv_w[i])
            mix = jnp.concatenate([a_out, c_out], axis=-1) @ w_out_even[i]
        else:
            proj = h @ w_in_odd[i]
            qk_w = DIFF_HEADS * 2 * DIFF_QK_DIM
            q, k, v = jnp.split(proj, [qk_w, 2 * qk_w], axis=-1)
            q = q.reshape(b, s, DIFF_HEADS, 2, DIFF_QK_DIM).transpose(0, 2, 3, 1, 4)
            k = k.reshape(b, s, DIFF_HEADS, 2, DIFF_QK_DIM).transpose(0, 2, 3, 1, 4)
            lambda_init = 0.8 - 0.6 * math.exp(-0.3 * layer)
            lam = (jnp.exp(jnp.sum(lam_q1[i] * lam_k1[i]))
                   - jnp.exp(jnp.sum(lam_q2[i] * lam_k2[i])) + lambda_init)
            o = differential_attention(q[:, :, 0], q[:, :, 1], k[:, :, 0], k[:, :, 1],
                                       split_heads(v, DIFF_HEADS), lam)
            o = rmsnorm(o, subln_g[i]) * (1.0 - lambda_init)
            mix = merge_heads(o) @ w_out_odd[i]
        x = x + mix
        h = rmsnorm(x, norm_mlp[layer])
        x = x + jnp.square(jax.nn.relu(h @ w_up[layer])) @ w_down[layer]
    return rmsnorm(x, norm_final)
```

```cpp
#include <hip/hip_runtime.h>
#include <cstdio>
#include <cstdint>
namespace pg8 {
#define PG8_LAS __attribute__((address_space(3)))
typedef unsigned short bf16_t;
typedef short bf16x8 __attribute__((ext_vector_type(8)));
typedef float f32x4 __attribute__((ext_vector_type(4)));
typedef unsigned u32x4 __attribute__((ext_vector_type(4)));
constexpr int BM = 256, BK = 64, HALF = 128, HTB = HALF * BK * 2  , STAGE_BYTES = 8 * HTB, NXCD = 8, WGM = 8;

__host__ __device__ __forceinline__ int lds_byte(int r, int c) { const int st = (r >> 4) * 2 + (c >> 5), rr = r & 15, cc = c & 31, ob = rr * 64 + cc * 2; return st * 1024 + (ob ^ (((ob >> 9) & 1) << 5)); }
__host__ __device__ __forceinline__ void stage_rc(int b, int& R, int& C) { const int st = b / 1024, sb = b % 1024, swz = sb ^ (((sb >> 9) & 1) << 5); R = (st >> 1) * 16 + swz / 64; C = (st & 1) * 32 + (swz % 64) / 2; }
__host__ __device__ __forceinline__ int perm32(int rho) { const int n = rho >> 4, i = rho & 15; return 8 * (i >> 2) + 4 * n + (i & 3); }

struct Unit { int pm, pn; };
struct Gemm { const bf16_t* A; const bf16_t* Bt; int M, N, K; };

struct StaticOrder {
    int nM, nN, nwg, G, c;
    __host__ __device__ void init(int M, int N, int G_, int c_) { nM = M / BM; nN = N / BM; nwg = nM * nN; G = G_; c = c_; }
    __host__ __device__ bool next(int i, Unit& u) const {
        const long L = (long)i * G + c; if (L >= nwg) return false;
        int wgid = (int)L; { const int q = nwg / NXCD, r = nwg % NXCD, xcd = wgid % NXCD, off = wgid / NXCD; wgid = (xcd < r ? xcd * (q + 1) : r * (q + 1) + (xcd - r) * q) + off; }
        const int nig = WGM * nN, gid = wgid / nig, fm = gid * WGM, gsz = (nM - fm) < WGM ? (nM - fm) : WGM;
        u.pm = fm + ((wgid % nig) % gsz); u.pn = (wgid % nig) / gsz; return true;
    }
    __device__ __forceinline__ void a_ready(const Unit&) const {}
    __device__ __forceinline__ void done(const Unit&) const {}
};

__device__ __forceinline__ unsigned cvt_pk_bf16(float lo, float hi) { unsigned r; asm volatile("v_cvt_pk_bf16_f32 %0, %1, %2" : "=v"(r) : "v"(lo), "v"(hi)); return r; }
typedef float f32x2 __attribute__((ext_vector_type(2)));
__device__ __forceinline__ float rstd_of(float ssq) { return __builtin_amdgcn_rsqf(ssq * (1.0f / 1024.0f) + 1e-6f); }
typedef unsigned u32x2 __attribute__((ext_vector_type(2)));
template <int ACT> struct EpiRow {
    static constexpr bool PERM = true, AFTER_DRAIN = false;
    bf16_t* O; int ldc; const float* ssq; int qtiles; float qscale;
    __device__ __forceinline__ void operator()(const f32x4 (&acc)[2][2][4][2], const Unit& u, int wr, int wc, int fr, int fq) const {
        const int row0 = u.pm * BM + wr * 64 + fr, col0 = u.pn * BM + wc * 32 + 8 * fq;
        const float sc = (u.pn < qtiles) ? qscale : 1.f;
        float rsv[2][4];
#pragma unroll
        for (int ai = 0; ai < 2; ++ai)
#pragma unroll
            for (int m = 0; m < 4; ++m) rsv[ai][m] = ssq[row0 + ai * HALF + m * 16];
#pragma unroll
        for (int ai = 0; ai < 2; ++ai)
#pragma unroll
            for (int m = 0; m < 4; ++m) { const int row = row0 + ai * HALF + m * 16; const float rs = rstd_of(rsv[ai][m]) * sc; bf16_t* rowp = O + (size_t)row * ldc + col0;
#pragma unroll
                for (int bj = 0; bj < 2; ++bj) { f32x4 v0 = acc[ai][bj][m][0], v1 = acc[ai][bj][m][1];
                    if (ACT == 1) { const f32x4 z = {0.f, 0.f, 0.f, 0.f}; v0 = __builtin_elementwise_max(v0, z) * rs; v1 = __builtin_elementwise_max(v1, z) * rs; v0 = v0 * v0; v1 = v1 * v1; }
                    else { v0 = v0 * rs; v1 = v1 * rs; }
                    u32x4 w; w.x = cvt_pk_bf16(v0[0], v0[1]); w.y = cvt_pk_bf16(v0[2], v0[3]); w.z = cvt_pk_bf16(v1[0], v1[1]); w.w = cvt_pk_bf16(v1[2], v1[3]);
                    *(u32x4*)(rowp + bj * HALF) = w; } }
    }
};
struct EpiColScale {
    static constexpr bool PERM = true, AFTER_DRAIN = false;
    bf16_t* O; int ldc; const float* ssq;
    __device__ __forceinline__ void operator()(const f32x4 (&acc)[2][2][4][2], const Unit& u, int wr, int wc, int fr, int fq) const {
        const int row0 = u.pm * BM + wr * 64 + fr, col0 = u.pn * BM + wc * 32 + 8 * fq;
        f32x4 sv[2][2];
#pragma unroll
        for (int bj = 0; bj < 2; ++bj)
#pragma unroll
            for (int n = 0; n < 2; ++n) { const f32x4 s = *(const f32x4*)(ssq + col0 + bj * HALF + 4 * n); sv[bj][n] = (f32x4){rstd_of(s[0]), rstd_of(s[1]), rstd_of(s[2]), rstd_of(s[3])}; }
#pragma unroll
        for (int ai = 0; ai < 2; ++ai)
#pragma unroll
            for (int m = 0; m < 4; ++m) { bf16_t* rowp = O + (size_t)(row0 + ai * HALF + m * 16) * ldc + col0;
#pragma unroll
                for (int bj = 0; bj < 2; ++bj) { const f32x4 v0 = acc[ai][bj][m][0] * sv[bj][0], v1 = acc[ai][bj][m][1] * sv[bj][1];
                    u32x4 w; w.x = cvt_pk_bf16(v0[0], v0[1]); w.y = cvt_pk_bf16(v0[2], v0[3]); w.z = cvt_pk_bf16(v1[0], v1[1]); w.w = cvt_pk_bf16(v1[2], v1[3]);
                    *(u32x4*)(rowp + bj * HALF) = w; } }
    }
};
struct EpiRes {
    static constexpr bool PERM = false, AFTER_DRAIN = false;
    const float* base; float* out; bf16_t* xb; float* ssq;
    __device__ __forceinline__ void operator()(const f32x4 (&acc)[2][2][4][2], const Unit& u, int wr, int wc, int fr, int fq) const {
        const int row0 = u.pm * BM + wr * 64 + fr, col0 = u.pn * BM + wc * 32 + 4 * fq;
#pragma unroll
        for (int ai = 0; ai < 2; ++ai) {
            f32x4 pre[4][2][2];
#pragma unroll
            for (int m = 0; m < 4; ++m) { const size_t off = (size_t)(row0 + ai * HALF + m * 16) * 1024 + col0;
#pragma unroll
                for (int bj = 0; bj < 2; ++bj)
#pragma unroll
                    for (int n = 0; n < 2; ++n) pre[m][bj][n] = __builtin_nontemporal_load((const f32x4*)(base + off + bj * HALF + n * 16)); }
            asm volatile("" ::: "memory");
#pragma unroll
            for (int m = 0; m < 4; ++m) { const int row = row0 + ai * HALF + m * 16; const size_t off = (size_t)row * 1024 + col0; float s = 0.f;
#pragma unroll
                for (int bj = 0; bj < 2; ++bj)
#pragma unroll
                    for (int n = 0; n < 2; ++n) { const f32x4 v = pre[m][bj][n] + acc[ai][bj][m][n];
                        __builtin_nontemporal_store(v, (f32x4*)(out + off + bj * HALF + n * 16)); s += (v[0] * v[0] + v[1] * v[1]) + (v[2] * v[2] + v[3] * v[3]);
                        u32x2 w; w.x = cvt_pk_bf16(v[0], v[1]); w.y = cvt_pk_bf16(v[2], v[3]); *(u32x2*)(xb + off + bj * HALF + n * 16) = w; }
                s += __shfl_xor(s, 16); s += __shfl_xor(s, 32);
                if (fq == 0) __hip_atomic_fetch_add(ssq + row, s, __ATOMIC_RELAXED, __HIP_MEMORY_SCOPE_AGENT); }
            asm volatile("" ::: "memory");
        }
    }
};

struct EpiResFinal {
    static constexpr bool PERM = false, AFTER_DRAIN = true;
    const float* base; float* out; float* ssq; unsigned* cnt; const float* gain;
    __device__ __forceinline__ void operator()(const f32x4 (&)[2][2][4][2], const Unit&, int, int, int, int) const {}
    __device__ __forceinline__ void fused(f32x4 (&acc)[2][2][4][2], const Unit& u, int wr, int wc, int fr, int fq, PG8_LAS unsigned char*, int, int lane) const {
        const int row0 = u.pm * BM + wr * 64 + fr, col0 = u.pn * BM + wc * 32 + 4 * fq;
#pragma unroll
        for (int ai = 0; ai < 2; ++ai) {
            f32x4 pre[4][2][2];
#pragma unroll
            for (int m = 0; m < 4; ++m) { const size_t off = (size_t)(row0 + ai * HALF + m * 16) * 1024 + col0;
#pragma unroll
                for (int bj = 0; bj < 2; ++bj)
#pragma unroll
                    for (int n = 0; n < 2; ++n) pre[m][bj][n] = __builtin_nontemporal_load((const f32x4*)(base + off + bj * HALF + n * 16)); }
            asm volatile("" ::: "memory");
#pragma unroll
            for (int m = 0; m < 4; ++m) { const int row = row0 + ai * HALF + m * 16; float s = 0.f;
#pragma unroll
                for (int bj = 0; bj < 2; ++bj)
#pragma unroll
                    for (int n = 0; n < 2; ++n) { const f32x4 v = pre[m][bj][n] + acc[ai][bj][m][n]; acc[ai][bj][m][n] = v; s += (v[0] * v[0] + v[1] * v[1]) + (v[2] * v[2] + v[3] * v[3]); }
                s += __shfl_xor(s, 16); s += __shfl_xor(s, 32);
                if (fq == 0) __hip_atomic_fetch_add(ssq + row, s, __ATOMIC_RELAXED, __HIP_MEMORY_SCOPE_AGENT); }
        }
        asm volatile("s_waitcnt vmcnt(0)" ::: "memory");
        unsigned* c = cnt + 64 * u.pm;
        if (lane == 0) __hip_atomic_fetch_add(c, 1u, __ATOMIC_RELAXED, __HIP_MEMORY_SCOPE_AGENT);
        { unsigned sp = 0; while ((unsigned)__builtin_amdgcn_readfirstlane(__hip_atomic_load(c, __ATOMIC_RELAXED, __HIP_MEMORY_SCOPE_AGENT)) < 32u) { __builtin_amdgcn_s_sleep(2); if (++sp > (1u << 22)) break; } }
        __builtin_amdgcn_fence(__ATOMIC_ACQUIRE, "agent");
        f32x4 gv[2][2];
#pragma unroll
        for (int bj = 0; bj < 2; ++bj)
#pragma unroll
            for (int n = 0; n < 2; ++n) gv[bj][n] = *(const f32x4*)(gain + col0 + bj * HALF + n * 16);
        float rsv[2][4];
#pragma unroll
        for (int ai = 0; ai < 2; ++ai)
#pragma unroll
            for (int m = 0; m < 4; ++m) rsv[ai][m] = __hip_atomic_load(ssq + row0 + ai * HALF + m * 16, __ATOMIC_RELAXED, __HIP_MEMORY_SCOPE_AGENT);
#pragma unroll
        for (int ai = 0; ai < 2; ++ai)
#pragma unroll
            for (int m = 0; m < 4; ++m) { const float rs = rstd_of(rsv[ai][m]); const size_t off = (size_t)(row0 + ai * HALF + m * 16) * 1024 + col0;
#pragma unroll
                for (int bj = 0; bj < 2; ++bj)
#pragma unroll
                    for (int n = 0; n < 2; ++n) __builtin_nontemporal_store(acc[ai][bj][m][n] * rs * gv[bj][n], (f32x4*)(out + off + bj * HALF + n * 16)); }
    }
};

template <class Epi, class Sched, bool ALIGN_EPI = false, bool SP2 = false>
__device__ __forceinline__ void gemm_phase(PG8_LAS unsigned char* lds, const Gemm g, const Sched& S, const Epi& E) {
    int tid_ = threadIdx.x; asm volatile("" : "+v"(tid_));
    const int tid = tid_, wid = __builtin_amdgcn_readfirstlane(tid >> 6), lane = tid & 63, wr = wid >> 2, wc = wid & 3, fr = lane & 15, fq = lane >> 4;
    const int K = g.K, nt = K / BK;
    unsigned voffA[2], voffB[2];
#pragma unroll
    for (int i = 0; i < 2; ++i) { int R, C; stage_rc(tid * 16 + i * 8192, R, C); const int Rb = Epi::PERM ? ((R & ~31) + perm32(R & 31)) : R;
        voffA[i] = (unsigned)(R * K + C) * 2u; voffB[i] = (unsigned)(Rb * K + C) * 2u; }
    const size_t kstep = (size_t)(BK * 2);
    const size_t hstep = (size_t)HALF * K * 2;
    const size_t tstep = 2 * hstep;
    const unsigned ldsw = (unsigned)wid * 1024u;
    const int aoff = lds_byte(wr * 64 + fr, fq * 8), boff = lds_byte(wc * 32 + fr, fq * 8);
#define PG8_SA(b, h) (((b) * 2 + (h)) * HTB)
#define PG8_SB(b, h) ((4 + (b) * 2 + (h)) * HTB)
#define PG8_STAGE(bufoff, gbase, voff) do { _Pragma("unroll") for (int _i = 0; _i < 2; ++_i) \
        __builtin_amdgcn_global_load_lds((const unsigned*)((const char*)(gbase) + (voff)[_i]), (PG8_LAS unsigned*)(lds + (bufoff) + ldsw + _i * 8192), 16, 0, 0); } while (0)
#define PG8_LDA(dst, b, h) do { _Pragma("unroll") for (int m = 0; m < 4; ++m) _Pragma("unroll") for (int k = 0; k < 2; ++k) dst[m][k] = *(const PG8_LAS bf16x8*)(lds + PG8_SA(b, h) + aoff + m * 2048 + k * 1024); } while (0)
#define PG8_LDB(dst, b, h) do { _Pragma("unroll") for (int n = 0; n < 2; ++n) _Pragma("unroll") for (int k = 0; k < 2; ++k) dst[n][k] = *(const PG8_LAS bf16x8*)(lds + PG8_SB(b, h) + boff + n * 2048 + k * 1024); } while (0)
#define PG8_MMA(ai, bj, At, Bt) do { __builtin_amdgcn_s_setprio(1); _Pragma("unroll") for (int m = 0; m < 4; ++m) _Pragma("unroll") for (int n = 0; n < 2; ++n) _Pragma("unroll") for (int k = 0; k < 2; ++k) \
        acc[ai][bj][m][n] = __builtin_amdgcn_mfma_f32_16x16x32_bf16(Bt[n][k], At[m][k], acc[ai][bj][m][n], 0, 0, 0); __builtin_amdgcn_s_setprio(0); } while (0)
#define PG8_WAIT_V(n) asm volatile("s_waitcnt vmcnt(" #n ")" ::: "memory")
#define PG8_WAIT_L(n) asm volatile("s_waitcnt lgkmcnt(" #n ")" ::: "memory")
#define PG8_BAR __builtin_amdgcn_s_barrier()
#define PG8_SCHED __builtin_amdgcn_sched_barrier(0)
    Unit cur, nxt; int ui = 0;
    if (!S.next(0, cur)) return;
    f32x4 acc[2][2][4][2];
#pragma unroll
    for (int a = 0; a < 2; ++a)
#pragma unroll
        for (int b = 0; b < 2; ++b)
#pragma unroll
            for (int m = 0; m < 4; ++m)
#pragma unroll
                for (int n = 0; n < 2; ++n) acc[a][b][m][n] = (f32x4){0.f, 0.f, 0.f, 0.f};
    bf16x8 At[4][2], B0[2][2], B1[2][2];
    const char* cA = (const char*)g.A + (size_t)cur.pm * tstep; const char* cB = (const char*)g.Bt + (size_t)cur.pn * tstep;
    S.a_ready(cur);
    if constexpr (SP2) {
        PG8_STAGE(PG8_SB(0, 0), cB, voffB); PG8_STAGE(PG8_SB(0, 1), cB + hstep, voffB); PG8_STAGE(PG8_SA(0, 0), cA, voffA); PG8_STAGE(PG8_SA(0, 1), cA + hstep, voffA);
        if (wr == 1) PG8_BAR;
        PG8_WAIT_V(2); PG8_BAR;
        PG8_STAGE(PG8_SB(1, 0), cB + kstep, voffB); PG8_STAGE(PG8_SA(1, 0), cA + kstep, voffA); PG8_STAGE(PG8_SB(1, 1), cB + hstep + kstep, voffB);
        PG8_WAIT_V(6); PG8_BAR;
    } else {
        PG8_STAGE(PG8_SB(0, 0), cB, voffB); PG8_STAGE(PG8_SA(0, 0), cA, voffA); PG8_STAGE(PG8_SB(0, 1), cB + hstep, voffB); PG8_STAGE(PG8_SA(0, 1), cA + hstep, voffA);
        if (wr == 1) PG8_BAR;
        PG8_WAIT_V(4); PG8_BAR;
        PG8_STAGE(PG8_SB(1, 0), cB + kstep, voffB); PG8_STAGE(PG8_SA(1, 0), cA + kstep, voffA); PG8_STAGE(PG8_SB(1, 1), cB + hstep + kstep, voffB);
        PG8_WAIT_V(6); PG8_BAR;
    }
    for (;;) {
        const bool has_next = S.next(ui + 1, nxt);
        const char* nA = has_next ? (const char*)g.A + (size_t)nxt.pm * tstep : cA; const char* nB = has_next ? (const char*)g.Bt + (size_t)nxt.pn * tstep : cB;
        for (int t = 0; t < nt; t += 2) {
            const bool last = (t == nt - 2);
            const char* a1 = cA + (size_t)(t + 1) * kstep;
            const char* a2 = last ? nA : cA + (size_t)(t + 2) * kstep; const char* b2 = last ? nB : cB + (size_t)(t + 2) * kstep;
            const char* a3 = a2 + kstep; const char* b3 = b2 + kstep;
            if (last && has_next) S.a_ready(nxt);
            if constexpr (SP2) {
            PG8_LDB(B0, 0, 0); PG8_LDB(B1, 0, 1); PG8_SCHED; PG8_LDA(At, 0, 0); PG8_STAGE(PG8_SA(1, 1), a1 + hstep, voffA);
            PG8_WAIT_V(8); PG8_WAIT_L(0); PG8_BAR; PG8_MMA(0, 0, At, B0); PG8_MMA(0, 1, At, B1); PG8_BAR; PG8_SCHED;
            PG8_LDA(At, 0, 1); PG8_STAGE(PG8_SB(0, 0), b2, voffB); PG8_STAGE(PG8_SB(0, 1), b2 + hstep, voffB); PG8_STAGE(PG8_SA(0, 0), a2, voffA);
            PG8_WAIT_V(8); PG8_WAIT_L(0); PG8_BAR; PG8_MMA(1, 0, At, B0); PG8_MMA(1, 1, At, B1); PG8_BAR; PG8_SCHED;
            PG8_LDB(B0, 1, 0); PG8_LDB(B1, 1, 1); PG8_SCHED; PG8_LDA(At, 1, 0); PG8_STAGE(PG8_SA(0, 1), a2 + hstep, voffA);
            PG8_WAIT_V(8); PG8_WAIT_L(0); PG8_BAR; PG8_MMA(0, 0, At, B0); PG8_MMA(0, 1, At, B1); PG8_BAR; PG8_SCHED;
            PG8_LDA(At, 1, 1); PG8_STAGE(PG8_SB(1, 0), b3, voffB); PG8_STAGE(PG8_SB(1, 1), b3 + hstep, voffB); PG8_STAGE(PG8_SA(1, 0), a3, voffA);
            PG8_WAIT_V(8); PG8_WAIT_L(0); PG8_BAR; PG8_MMA(1, 0, At, B0); PG8_MMA(1, 1, At, B1); PG8_BAR; PG8_SCHED;
            } else {
            PG8_LDB(B0, 0, 0); PG8_SCHED; PG8_LDA(At, 0, 0); PG8_STAGE(PG8_SA(1, 1), a1 + hstep, voffA);
            PG8_WAIT_L(8); PG8_BAR; PG8_WAIT_L(0); PG8_MMA(0, 0, At, B0); PG8_BAR; PG8_SCHED;
            PG8_LDB(B1, 0, 1); PG8_STAGE(PG8_SB(0, 0), b2, voffB);
            PG8_BAR; PG8_WAIT_L(0); PG8_MMA(0, 1, At, B1); PG8_BAR;
            PG8_LDA(At, 0, 1); PG8_STAGE(PG8_SA(0, 0), a2, voffA);
            PG8_BAR; PG8_WAIT_L(0); PG8_MMA(1, 0, At, B0); PG8_BAR; PG8_SCHED;
            PG8_STAGE(PG8_SB(0, 1), b2 + hstep, voffB);
            PG8_WAIT_V(6); PG8_BAR; PG8_MMA(1, 1, At, B1); PG8_BAR;
            PG8_LDB(B0, 1, 0); PG8_SCHED; PG8_LDA(At, 1, 0); PG8_STAGE(PG8_SA(0, 1), a2 + hstep, voffA);
            PG8_WAIT_L(8); PG8_BAR; PG8_WAIT_L(0); PG8_MMA(0, 0, At, B0); PG8_BAR; PG8_SCHED;
            PG8_LDB(B1, 1, 1); PG8_STAGE(PG8_SB(1, 0), b3, voffB);
            PG8_BAR; PG8_WAIT_L(0); PG8_MMA(0, 1, At, B1); PG8_BAR;
            PG8_LDA(At, 1, 1); PG8_STAGE(PG8_SA(1, 0), a3, voffA);
            PG8_BAR; PG8_WAIT_L(0); PG8_MMA(1, 0, At, B0); PG8_BAR; PG8_SCHED;
            PG8_STAGE(PG8_SB(1, 1), b3 + hstep, voffB);
            PG8_WAIT_V(6); PG8_BAR; PG8_MMA(1, 1, At, B1); PG8_BAR;
            }
        }
        if constexpr (ALIGN_EPI) { if (wr == 0) PG8_BAR; }
        if constexpr (!Epi::AFTER_DRAIN) { E(acc, cur, wr, wc, fr, fq); S.done(cur); }
        if (!has_next) break;
#pragma unroll
        for (int a = 0; a < 2; ++a)
#pragma unroll
            for (int b = 0; b < 2; ++b)
#pragma unroll
                for (int m = 0; m < 4; ++m)
#pragma unroll
                    for (int n = 0; n < 2; ++n) acc[a][b][m][n] = (f32x4){0.f, 0.f, 0.f, 0.f};
        cur = nxt; cA = nA; cB = nB; ++ui;
        if constexpr (ALIGN_EPI) { if (wr == 1) PG8_BAR; }
    }
    PG8_WAIT_V(0);
    if constexpr (!ALIGN_EPI) { if (wr == 0) PG8_BAR; }
    PG8_BAR;
    if constexpr (Epi::AFTER_DRAIN) { E.fused(acc, cur, wr, wc, fr, fq, lds, wid, lane); S.done(cur); }
#undef PG8_SA
#undef PG8_SB
#undef PG8_STAGE
#undef PG8_LDA
#undef PG8_LDB
#undef PG8_MMA
#undef PG8_WAIT_V
#undef PG8_WAIT_L
#undef PG8_BAR
#undef PG8_SCHED
}
}

#ifndef PG8_SP2
#define PG8_SP2 true
#endif
#ifndef PG8_ALIGN
#define PG8_ALIGN true
#endif
#include <hip/hip_bf16.h>
#include <cmath>
namespace dattn {
using bf16=__hip_bfloat16;
using bf16x8=__attribute__((ext_vector_type(8)))short;
using s16x4=__attribute__((ext_vector_type(4)))short;
using f32x16=__attribute__((ext_vector_type(16)))float;
using u32x4=__attribute__((ext_vector_type(4)))unsigned;
using u32x2=__attribute__((ext_vector_type(2)))unsigned;
constexpr int SEQ=8192,DM=3072,QB=256,NSLOT=4,KSLOT=8192,VSLOT=16384;
constexpr int LDS_K=0,LDS_V=NSLOT*KSLOT,LDS_END=LDS_V+NSLOT*VSLOT;
constexpr int OST_ROW=272,OST_WAVE=32*OST_ROW;
static_assert(8*OST_WAVE<=LDS_END,"O staging fits over the rings");
typedef __attribute__((address_space(3))) const char* lds_cptr;
typedef __attribute__((address_space(3))) char* lds_ptr;
typedef short v4i16_t __attribute__((ext_vector_type(4)));
__device__ __forceinline__ void glds16(const void*gsrc,unsigned lds_dst){unsigned keep;
  asm volatile("s_mov_b32 %0, m0\n\ts_mov_b32 m0, %2\n\ts_nop 0\n\tglobal_load_lds_dwordx4 %1, off\n\ts_mov_b32 m0, %0":"=&s"(keep):"v"(gsrc),"s"(lds_dst):"memory");}
__device__ __forceinline__ s16x4 vtr(lds_cptr p){ return __builtin_bit_cast(s16x4,__builtin_amdgcn_ds_read_tr16_b64_v4i16((__attribute__((address_space(3))) v4i16_t*)p)); }
typedef float f32x2_t __attribute__((ext_vector_type(2))); typedef __bf16 bf16x2_t __attribute__((ext_vector_type(2)));
__device__ __forceinline__ unsigned cvtpk_s(float lo,float hi){f32x2_t v={lo,hi};bf16x2_t b=__builtin_convertvector(v,bf16x2_t);return __builtin_bit_cast(unsigned,b);}
#define DWAIT_BAR(N) asm volatile("s_waitcnt vmcnt(" #N ") lgkmcnt(0)\n\ts_barrier":::"memory")
__device__ __forceinline__ void unit(int b,int qb,const bf16*Q,const bf16*__restrict__ K,const bf16*__restrict__ V,bf16*O,int opitch,char*shm){
  const int tid=threadIdx.x,lane=tid&63,r32=lane&31,hi=lane>>5; const int wid=__builtin_amdgcn_readfirstlane(tid>>6);
  const long rowbase=(long)b*SEQ; const int q0=qb*QB;
  const bf16*Qw=Q+(rowbase+q0+wid*32)*DM;
  const unsigned lds0=(unsigned)(uintptr_t)shm;
  const bf16*ksrc=K+rowbase*DM+(long)lane*DM+wid*8;
  const bf16*vsrc=V+rowbase*DM+(long)(16*(wid&3)+(lane>>2))*DM+(wid>>2)*32+(lane&3)*8;
  const unsigned kdst=lds0+LDS_K+wid*1024,vdst=lds0+LDS_V+wid*1024;
  #define DDMA(t,sl) do{ glds16(ksrc+(long)(t)*64*DM,(unsigned)__builtin_amdgcn_readfirstlane(kdst+(sl)*KSLOT)); \
      glds16(vsrc+(long)(t)*64*DM,(unsigned)__builtin_amdgcn_readfirstlane(vdst+(sl)*VSLOT)); \
      glds16(vsrc+(long)(t)*64*DM+64,(unsigned)__builtin_amdgcn_readfirstlane(vdst+(sl)*VSLOT+8192)); }while(0)
  #define SBARR() do{}while(0)
  #define DVRD(dst,vp_,cb_) do{ _Pragma("unroll") for(int c_=0;c_<4;++c_){ dst[2*c_]=vtr((vp_)+((cb_)>>1)*8192+((cb_)&1)*4096+c_*1024); dst[2*c_+1]=vtr((vp_)+((cb_)>>1)*8192+((cb_)&1)*4096+c_*1024+512); } }while(0)
  #define DVF(src,c_) (bf16x8){src[2*(c_)][0],src[2*(c_)][1],src[2*(c_)][2],src[2*(c_)][3],src[2*(c_)+1][0],src[2*(c_)+1][1],src[2*(c_)+1][2],src[2*(c_)+1][3]}
  #define DPV(src,cb_) do{ o[cb_]=__builtin_amdgcn_mfma_f32_32x32x16_bf16(DVF(src,0),pw[0],o[cb_],0,0,0); o[cb_]=__builtin_amdgcn_mfma_f32_32x32x16_bf16(DVF(src,1),pw[1],o[cb_],0,0,0); \
      o[cb_]=__builtin_amdgcn_mfma_f32_32x32x16_bf16(DVF(src,2),pw[2],o[cb_],0,0,0); o[cb_]=__builtin_amdgcn_mfma_f32_32x32x16_bf16(DVF(src,3),pw[3],o[cb_],0,0,0); }while(0)
  #define PV_PLAIN(vp_) do{ DPV(va,0); DVRD(va,vp_,2); DPV(vb,1); DVRD(vb,vp_,3); DPV(va,2); DPV(vb,3); }while(0)
  #define EXPS_PLAIN() do{ float ls0=0.f,ls1=0.f; \
      _Pragma("unroll") for(int r=0;r<16;++r){ p0[r]=__builtin_amdgcn_exp2f(p0[r]-mref); ls0+=p0[r]; p1[r]=__builtin_amdgcn_exp2f(p1[r]-mref); ls1+=p1[r]; } l+=ls0+ls1; \
      u32x4 w0,w1,w2,w3; w0.x=cvtpk_s(p0[0],p0[1]);w0.y=cvtpk_s(p0[2],p0[3]);w0.z=cvtpk_s(p0[4],p0[5]);w0.w=cvtpk_s(p0[6],p0[7]); \
      w1.x=cvtpk_s(p0[8],p0[9]);w1.y=cvtpk_s(p0[10],p0[11]);w1.z=cvtpk_s(p0[12],p0[13]);w1.w=cvtpk_s(p0[14],p0[15]); \
      w2.x=cvtpk_s(p1[0],p1[1]);w2.y=cvtpk_s(p1[2],p1[3]);w2.z=cvtpk_s(p1[4],p1[5]);w2.w=cvtpk_s(p1[6],p1[7]); \
      w3.x=cvtpk_s(p1[8],p1[9]);w3.y=cvtpk_s(p1[10],p1[11]);w3.z=cvtpk_s(p1[12],p1[13]);w3.w=cvtpk_s(p1[14],p1[15]); \
      pw[0]=__builtin_bit_cast(bf16x8,w0);pw[1]=__builtin_bit_cast(bf16x8,w1);pw[2]=__builtin_bit_cast(bf16x8,w2);pw[3]=__builtin_bit_cast(bf16x8,w3); }while(0)
  const int NT=(q0+QB)/64;
  DDMA(0,0); DDMA(1,1);
  bf16x8 qr[4];
  #pragma unroll
  for(int d0=0;d0<4;++d0)qr[d0]=*reinterpret_cast<const bf16x8*>(&Qw[(long)r32*DM+d0*16+hi*8]);
  asm volatile("":"+v"(qr[0]),"+v"(qr[1]),"+v"(qr[2]),"+v"(qr[3]));
  const lds_cptr shm3=(lds_cptr)shm;
  const lds_cptr kp0=shm3+LDS_K+hi*1024+r32*16;
  const lds_cptr vp0=shm3+LDS_V+((lane>>4)&1)*32+(lane&3)*8+(4*hi+((lane&15)>>2))*64;
  f32x16 o[4]; o[0]=f32x16{};o[1]=f32x16{};o[2]=f32x16{};o[3]=f32x16{};
  float mref=-1e30f,l=0.f;
  const int qfirst=q0+wid*32, qme=qfirst+r32;
  const int TI=(qfirst+1)>>6;
  int t=0;
  bf16x8 pw[4]; pw[0]=bf16x8{};pw[1]=bf16x8{};pw[2]=bf16x8{};pw[3]=bf16x8{};
  for(;t<TI;++t){
    const int slot=t&3;
    if(t+1<NT){DWAIT_BAR(3);}else{DWAIT_BAR(0);}
    if(t+2<NT){ DDMA(t+2,(t+2)&3); }
    const lds_cptr kp=kp0+slot*KSLOT; const lds_cptr vpp=vp0+((t?t-1:0)&3)*VSLOT;
    bf16x8 kf[8];
    #pragma unroll
    for(int d0=0;d0<4;++d0){ kf[2*d0]=*(const __attribute__((address_space(3))) bf16x8*)(kp+d0*2048); kf[2*d0+1]=*(const __attribute__((address_space(3))) bf16x8*)(kp+d0*2048+512); }
    s16x4 va[8],vb[8];
    f32x16 p0=f32x16{},p1=f32x16{};
    #pragma unroll
    for(int d0=0;d0<4;++d0){ p0=__builtin_amdgcn_mfma_f32_32x32x16_bf16(kf[2*d0],qr[d0],p0,0,0,0); p1=__builtin_amdgcn_mfma_f32_32x32x16_bf16(kf[2*d0+1],qr[d0],p1,0,0,0); }
    DVRD(va,vpp,0); DVRD(vb,vpp,1);
    float mt=__builtin_fmaxf(__builtin_fmaxf(p0[0],p0[1]),__builtin_fmaxf(p1[0],p1[1]));
    #pragma unroll
    for(int r=2;r<16;r+=2){ mt=__builtin_fmaxf(mt,__builtin_fmaxf(p0[r],p0[r+1])); mt=__builtin_fmaxf(mt,__builtin_fmaxf(p1[r],p1[r+1])); }
    { auto rr=__builtin_amdgcn_permlane32_swap(__float_as_uint(mt),__float_as_uint(mt),false,false); mt=__builtin_fmaxf(__uint_as_float(rr[0]),__uint_as_float(rr[1])); }
    if(__any(mt>mref+8.0f)){
      PV_PLAIN(vpp);
      const float mnew=__builtin_fmaxf(mref,mt); const float alpha=__builtin_amdgcn_exp2f(mref-mnew);
      #pragma unroll
      for(int cb=0;cb<4;++cb)o[cb]=o[cb]*alpha;
      l*=alpha; mref=mnew;
      pw[0]=bf16x8{};pw[1]=bf16x8{};pw[2]=bf16x8{};pw[3]=bf16x8{};
      DVRD(va,vpp,0); DVRD(vb,vpp,1);
    }
    {
      SBARR();
        float ls0=0.f,ls1=0.f;
        o[0]=__builtin_amdgcn_mfma_f32_32x32x16_bf16(DVF(va,0),pw[0],o[0],0,0,0);
        p0[0]=__builtin_amdgcn_exp2f(p0[0]-mref); p0[1]=__builtin_amdgcn_exp2f(p0[1]-mref); ls0+=p0[0]+p0[1];
        SBARR();
        o[0]=__builtin_amdgcn_mfma_f32_32x32x16_bf16(DVF(va,1),pw[1],o[0],0,0,0);
        p0[2]=__builtin_amdgcn_exp2f(p0[2]-mref); p0[3]=__builtin_amdgcn_exp2f(p0[3]-mref); ls0+=p0[2]+p0[3];
        SBARR();
        o[0]=__builtin_amdgcn_mfma_f32_32x32x16_bf16(DVF(va,2),pw[2],o[0],0,0,0);
        p0[4]=__builtin_amdgcn_exp2f(p0[4]-mref); p0[5]=__builtin_amdgcn_exp2f(p0[5]-mref); ls0+=p0[4]+p0[5];
        SBARR();
        o[0]=__builtin_amdgcn_mfma_f32_32x32x16_bf16(DVF(va,3),pw[3],o[0],0,0,0);
        p0[6]=__builtin_amdgcn_exp2f(p0[6]-mref); p0[7]=__builtin_amdgcn_exp2f(p0[7]-mref); ls0+=p0[6]+p0[7];
        DVRD(va,vpp,2);
        SBARR();
        o[1]=__builtin_amdgcn_mfma_f32_32x32x16_bf16(DVF(vb,0),pw[0],o[1],0,0,0);
        p0[8]=__builtin_amdgcn_exp2f(p0[8]-mref); p0[9]=__builtin_amdgcn_exp2f(p0[9]-mref); ls0+=p0[8]+p0[9];
        SBARR();
        o[1]=__builtin_amdgcn_mfma_f32_32x32x16_bf16(DVF(vb,1),pw[1],o[1],0,0,0);
        p0[10]=__builtin_amdgcn_exp2f(p0[10]-mref); p0[11]=__builtin_amdgcn_exp2f(p0[11]-mref); ls0+=p0[10]+p0[11];
        SBARR();
        o[1]=__builtin_amdgcn_mfma_f32_32x32x16_bf16(DVF(vb,2),pw[2],o[1],0,0,0);
        p0[12]=__builtin_amdgcn_exp2f(p0[12]-mref); p0[13]=__builtin_amdgcn_exp2f(p0[13]-mref); ls0+=p0[12]+p0[13];
        SBARR();
        o[1]=__builtin_amdgcn_mfma_f32_32x32x16_bf16(DVF(vb,3),pw[3],o[1],0,0,0);
        p0[14]=__builtin_amdgcn_exp2f(p0[14]-mref); p0[15]=__builtin_amdgcn_exp2f(p0[15]-mref); ls0+=p0[14]+p0[15];
        DVRD(vb,vpp,3);
        SBARR();
        o[2]=__builtin_amdgcn_mfma_f32_32x32x16_bf16(DVF(va,0),pw[0],o[2],0,0,0);
        p1[0]=__builtin_amdgcn_exp2f(p1[0]-mref); p1[1]=__builtin_amdgcn_exp2f(p1[1]-mref); ls1+=p1[0]+p1[1];
        SBARR();
        o[2]=__builtin_amdgcn_mfma_f32_32x32x16_bf16(DVF(va,1),pw[1],o[2],0,0,0);
        p1[2]=__builtin_amdgcn_exp2f(p1[2]-mref); p1[3]=__builtin_amdgcn_exp2f(p1[3]-mref); ls1+=p1[2]+p1[3];
        SBARR();
        o[2]=__builtin_amdgcn_mfma_f32_32x32x16_bf16(DVF(va,2),pw[2],o[2],0,0,0);
        p1[4]=__builtin_amdgcn_exp2f(p1[4]-mref); p1[5]=__builtin_amdgcn_exp2f(p1[5]-mref); ls1+=p1[4]+p1[5];
        SBARR();
        o[2]=__builtin_amdgcn_mfma_f32_32x32x16_bf16(DVF(va,3),pw[3],o[2],0,0,0);
        p1[6]=__builtin_amdgcn_exp2f(p1[6]-mref); p1[7]=__builtin_amdgcn_exp2f(p1[7]-mref); ls1+=p1[6]+p1[7];
        SBARR();
        o[3]=__builtin_amdgcn_mfma_f32_32x32x16_bf16(DVF(vb,0),pw[0],o[3],0,0,0);
        p1[8]=__builtin_amdgcn_exp2f(p1[8]-mref); p1[9]=__builtin_amdgcn_exp2f(p1[9]-mref); ls1+=p1[8]+p1[9];
        SBARR();
        o[3]=__builtin_amdgcn_mfma_f32_32x32x16_bf16(DVF(vb,1),pw[1],o[3],0,0,0);
        p1[10]=__builtin_amdgcn_exp2f(p1[10]-mref); p1[11]=__builtin_amdgcn_exp2f(p1[11]-mref); ls1+=p1[10]+p1[11];
        SBARR();
        o[3]=__builtin_amdgcn_mfma_f32_32x32x16_bf16(DVF(vb,2),pw[2],o[3],0,0,0);
        p1[12]=__builtin_amdgcn_exp2f(p1[12]-mref); p1[13]=__builtin_amdgcn_exp2f(p1[13]-mref); ls1+=p1[12]+p1[13];
        SBARR();
        o[3]=__builtin_amdgcn_mfma_f32_32x32x16_bf16(DVF(vb,3),pw[3],o[3],0,0,0);
        p1[14]=__builtin_amdgcn_exp2f(p1[14]-mref); p1[15]=__builtin_amdgcn_exp2f(p1[15]-mref); ls1+=p1[14]+p1[15];
        SBARR();
        l+=ls0+ls1;
        { u32x4 w0,w1,w2,w3; w0.x=cvtpk_s(p0[0],p0[1]);w0.y=cvtpk_s(p0[2],p0[3]);w0.z=cvtpk_s(p0[4],p0[5]);w0.w=cvtpk_s(p0[6],p0[7]);
          w1.x=cvtpk_s(p0[8],p0[9]);w1.y=cvtpk_s(p0[10],p0[11]);w1.z=cvtpk_s(p0[12],p0[13]);w1.w=cvtpk_s(p0[14],p0[15]);
          w2.x=cvtpk_s(p1[0],p1[1]);w2.y=cvtpk_s(p1[2],p1[3]);w2.z=cvtpk_s(p1[4],p1[5]);w2.w=cvtpk_s(p1[6],p1[7]);
          w3.x=cvtpk_s(p1[8],p1[9]);w3.y=cvtpk_s(p1[10],p1[11]);w3.z=cvtpk_s(p1[12],p1[13]);w3.w=cvtpk_s(p1[14],p1[15]);
          pw[0]=__builtin_bit_cast(bf16x8,w0);pw[1]=__builtin_bit_cast(bf16x8,w1);pw[2]=__builtin_bit_cast(bf16x8,w2);pw[3]=__builtin_bit_cast(bf16x8,w3); }
    }
  }
  if(TI>0){ const lds_cptr vpp=vp0+((t+3)&3)*VSLOT; s16x4 va[8],vb[8]; DVRD(va,vpp,0); DVRD(vb,vpp,1); PV_PLAIN(vpp); }
  for(;t<NT;++t){
    const int slot=t&3;
    if(t+1<NT){DWAIT_BAR(3);}else{DWAIT_BAR(0);}
    if(t+2<NT){ DDMA(t+2,(t+2)&3); }
    const lds_cptr kp=kp0+slot*KSLOT; const lds_cptr vp=vp0+slot*VSLOT;
    #pragma unroll
    for(int s=0;s<2;++s){
      const int key0=64*t+32*s;
      if(key0>qfirst+31)continue;
      f32x16 p=f32x16{};
      #pragma unroll
      for(int d0=0;d0<4;++d0){ const bf16x8 kf=*(const __attribute__((address_space(3))) bf16x8*)(kp+d0*2048+s*512); p=__builtin_amdgcn_mfma_f32_32x32x16_bf16(kf,qr[d0],p,0,0,0); }
      if(key0+31>qfirst){
        #pragma unroll
        for(int r=0;r<16;++r){ const int kv=key0+(r&3)+8*(r>>2)+4*hi; if(kv>qme)p[r]=-INFINITY; } }
      float mt=__builtin_fmaxf(p[0],p[1]);
      #pragma unroll
      for(int r=2;r<16;++r)mt=__builtin_fmaxf(mt,p[r]);
      { auto rr=__builtin_amdgcn_permlane32_swap(__float_as_uint(mt),__float_as_uint(mt),false,false); mt=__builtin_fmaxf(__uint_as_float(rr[0]),__uint_as_float(rr[1])); }
      if(__any(mt>mref+8.0f)){
        const float mnew=__builtin_fmaxf(mref,mt); const float alpha=__builtin_amdgcn_exp2f(mref-mnew);
        #pragma unroll
        for(int cb=0;cb<4;++cb)o[cb]=o[cb]*alpha;
        l*=alpha; mref=mnew; }
      float ls=0.f;
      #pragma unroll
      for(int r=0;r<16;++r){ p[r]=__builtin_amdgcn_exp2f(p[r]-mref); ls+=p[r]; }
      l+=ls;
      u32x4 w0,w1; w0.x=cvtpk_s(p[0],p[1]);w0.y=cvtpk_s(p[2],p[3]);w0.z=cvtpk_s(p[4],p[5]);w0.w=cvtpk_s(p[6],p[7]);
      w1.x=cvtpk_s(p[8],p[9]);w1.y=cvtpk_s(p[10],p[11]);w1.z=cvtpk_s(p[12],p[13]);w1.w=cvtpk_s(p[14],p[15]);
      const bf16x8 pb0=__builtin_bit_cast(bf16x8,w0),pb1=__builtin_bit_cast(bf16x8,w1);
      #pragma unroll
      for(int cb=0;cb<4;++cb){
        const int off=(cb>>1)*8192+(cb&1)*4096+(2*s)*1024;
        const s16x4 a0=vtr(vp+off),a1=vtr(vp+off+512),c0=vtr(vp+off+1024),c1=vtr(vp+off+1536);
        const bf16x8 v0=(bf16x8){a0[0],a0[1],a0[2],a0[3],a1[0],a1[1],a1[2],a1[3]},v1=(bf16x8){c0[0],c0[1],c0[2],c0[3],c1[0],c1[1],c1[2],c1[3]};
        o[cb]=__builtin_amdgcn_mfma_f32_32x32x16_bf16(v0,pb0,o[cb],0,0,0);
        o[cb]=__builtin_amdgcn_mfma_f32_32x32x16_bf16(v1,pb1,o[cb],0,0,0); }
    }

  }
  { auto rr=__builtin_amdgcn_permlane32_swap(__float_as_uint(l),__float_as_uint(l),false,false); l=__uint_as_float(rr[0])+__uint_as_float(rr[1]); }
  const float inv=__builtin_amdgcn_rcpf(l);
  DWAIT_BAR(0);
  const lds_ptr stg=(lds_ptr)shm+wid*OST_WAVE;
  #pragma unroll
  for(int cb=0;cb<4;++cb)
    #pragma unroll
    for(int g=0;g<4;++g){ u32x2 w; w.x=cvtpk_s(o[cb][4*g]*inv,o[cb][4*g+1]*inv); w.y=cvtpk_s(o[cb][4*g+2]*inv,o[cb][4*g+3]*inv);
      *(__attribute__((address_space(3))) u32x2*)(stg+r32*OST_ROW+(32*cb+8*g+4*hi)*2)=w; }
  asm volatile("s_waitcnt lgkmcnt(0)":::"memory");
  bf16*Ow=O+(rowbase+q0+wid*32)*(long)opitch;
  #pragma unroll
  for(int i=0;i<8;++i){ const int row=i*4+(lane>>4),ch=lane&15; const u32x4 v=*(const __attribute__((address_space(3))) u32x4*)(stg+row*OST_ROW+ch*16); *(u32x4*)(Ow+(long)row*opitch+ch*8)=v; }
  asm volatile("s_waitcnt lgkmcnt(0)\n\ts_barrier":::"memory");
  #undef DDMA
  #undef SBARR
  #undef DVRD
  #undef DVF
  #undef DPV
  #undef PV_PLAIN
  #undef EXPS_PLAIN
}
struct DiffUnit { int bh; int qb; int m; };
struct DiffOrder {
  int vcu, G;
  __device__ __forceinline__ DiffOrder(int vcu_,int G_):vcu(vcu_),G(G_){}
  __device__ __forceinline__ bool next(int i,DiffUnit&u)const{
    const int ii=i>>1; u.m=i&1;
    if(G==256){ if(i>=4)return false; const int s=vcu&15; u.bh=vcu>>4; u.qb=ii?31-s:s; return true; }
    const int un=vcu+ii*G; if(un>=512)return false; u.bh=un>>5; u.qb=un&31; return true; }
};
__device__ __forceinline__ void diff_phase(char*shm,const unsigned short*PROJ,unsigned short*OA,const DiffOrder&S){
  DiffUnit u;
  for(int i=0;S.next(i,u);++i){
    const int h=u.bh&7;
    const bf16*Qp=(const bf16*)PROJ+h*128+u.m*64;
    unit(u.bh>>3,u.qb,Qp,Qp+1024,(const bf16*)PROJ+2048+h*128,u.m?((bf16*)PROJ+h*128):((bf16*)OA+h*128),u.m?DM:1024,shm);
  }
}
__device__ __forceinline__ float bflo(unsigned w){return __builtin_bit_cast(float,w<<16);}
__device__ __forceinline__ float bfhi(unsigned w){return __builtin_bit_cast(float,w&0xffff0000u);}
__device__ __forceinline__ void diff_combine(const unsigned short*PROJ,unsigned short*OA,const DiffOrder&S,float lam){
  asm volatile("s_waitcnt vmcnt(0)":::"memory");
  int tid_=threadIdx.x; asm volatile("":"+v"(tid_));
  const int lane=tid_&63; const int wid=__builtin_amdgcn_readfirstlane(tid_>>6); const int c8=(lane&7)*8;
  DiffUnit u;
  for(int i=0;S.next(i,u);i+=2){
    const int h=u.bh&7; const long row0=(long)(u.bh>>3)*SEQ+u.qb*QB+wid*32+(lane>>3);
    #pragma unroll 1
    for(int it=0;it<4;++it){
      unsigned short*ma=OA+(row0+it*8)*1024+h*128+c8; const unsigned short*pb=PROJ+(row0+it*8)*DM+h*128+c8;
      const u32x4 a0=*(const u32x4*)ma,a1=*(const u32x4*)(ma+64),b0=*(const u32x4*)pb,b1=*(const u32x4*)(pb+64);
      float o0[8],o1[8]; float ss=0.f;
      #pragma unroll
      for(int k=0;k<4;++k){ o0[2*k]=bflo(a0[k])-lam*bflo(b0[k]); o0[2*k+1]=bfhi(a0[k])-lam*bfhi(b0[k]); o1[2*k]=bflo(a1[k])-lam*bflo(b1[k]); o1[2*k+1]=bfhi(a1[k])-lam*bfhi(b1[k]); }
      #pragma unroll
      for(int k=0;k<8;++k)ss+=o0[k]*o0[k]+o1[k]*o1[k];
      ss+=__shfl_xor(ss,1); ss+=__shfl_xor(ss,2); ss+=__shfl_xor(ss,4);
      const float rs=__builtin_amdgcn_rsqf(ss*(1.0f/128.0f)+1e-6f);
      u32x4 w0,w1;
      #pragma unroll
      for(int k=0;k<4;++k){ w0[k]=cvtpk_s(o0[2*k]*rs,o0[2*k+1]*rs); w1[k]=cvtpk_s(o1[2*k]*rs,o1[2*k+1]*rs); }
      *(u32x4*)ma=w0; *(u32x4*)(ma+64)=w1;
    }
  }
}
#undef DWAIT_BAR
}
#include <hip/hip_cooperative_groups.h>
namespace cg = cooperative_groups;
constexpr int NWAVES = 8;
constexpr int SEQ = 8192, DMOD = 1024, MTOK = 2 * SEQ, FF = 4096;
constexpr int P0W = 2560;
constexpr int P1W = 3072;
constexpr float QSCALE = 0.125f * 1.4426950408889634f;
constexpr float LAMBDA_INIT1 = 0.35550906f;
constexpr size_t MiB = 1u << 20;
constexpr size_t WS_CTL = 0, CTL_ZERO_BYTES = 1 * MiB;
constexpr size_t WS_SSQ = 65536;
constexpr size_t WS_W = 2 * MiB;
constexpr size_t W_IN = 0, W_OUT = 6 * MiB, W_UP = 8 * MiB, W_DOWN = 16 * MiB, W_LAYER = 24 * MiB;
constexpr size_t WS_XB = 50 * MiB;
constexpr size_t WS_PROJ = 82 * MiB;
constexpr size_t WS_VT = WS_PROJ + 80 * MiB;
constexpr size_t WS_MIX = 178 * MiB;
constexpr size_t WS_H = WS_PROJ;
constexpr size_t WS_END = 210 * MiB;
constexpr int RING_BYTES = 131072, LDS_BYTES = 147456;

#define GAS __attribute__((address_space(1)))
#define LAS __attribute__((address_space(3)))
typedef unsigned short bf16;
typedef unsigned v4u __attribute__((ext_vector_type(4)));
typedef float f32x4 __attribute__((ext_vector_type(4)));
typedef short bf16x8 __attribute__((ext_vector_type(8)));
typedef float f32x16 __attribute__((ext_vector_type(16)));
#define LDS_WAIT() asm volatile("s_waitcnt lgkmcnt(0)" ::: "memory")
__device__ __forceinline__ unsigned f2bf(float f) { unsigned u = __builtin_bit_cast(unsigned, f); return (u + 0x7fffu + ((u >> 16) & 1u)) >> 16; }
__device__ __forceinline__ unsigned pk2(float lo, float hi) { return f2bf(lo) | (f2bf(hi) << 16); }
__device__ __forceinline__ float bf_lo(unsigned w) { return __builtin_bit_cast(float, w << 16); }
__device__ __forceinline__ float bf_hi(unsigned w) { return __builtin_bit_cast(float, w & 0xffff0000u); }
__device__ __forceinline__ float wave_sum(float v) {
#pragma unroll
    for (int o = 1; o < 64; o <<= 1) v += __shfl_xor(v, o);
    return v;
}
__device__ __forceinline__ void x_rows2_to_bf16(const float* xrow, bf16* orow, float* ssq, int lane) {
    const GAS f32x4* xr = (const GAS f32x4*)xrow + lane;
    f32x4 v[8]; float s0 = 0.f, s1 = 0.f;
#pragma unroll
    for (int j = 0; j < 8; ++j) v[j] = __builtin_nontemporal_load(xr + 64 * j);
#pragma unroll
    for (int j = 0; j < 4; ++j) { s0 += (v[j].x * v[j].x + v[j].y * v[j].y) + (v[j].z * v[j].z + v[j].w * v[j].w); s1 += (v[4 + j].x * v[4 + j].x + v[4 + j].y * v[4 + j].y) + (v[4 + j].z * v[4 + j].z + v[4 + j].w * v[4 + j].w); }
    s0 = wave_sum(s0); s1 = wave_sum(s1); if (lane == 0) { ssq[0] = s0; ssq[1] = s1; }
    GAS unsigned long long* o8 = (GAS unsigned long long*)orow + lane;
#pragma unroll
    for (int j = 0; j < 8; ++j) o8[64 * j] = (unsigned long long)pk2(v[j].x, v[j].y) | ((unsigned long long)pk2(v[j].z, v[j].w) << 32);
}

__device__ __forceinline__ int swap23(int i) { return (i & ~12) | ((i & 4) << 1) | ((i & 8) >> 1); }
__device__ __forceinline__ unsigned cvtpk2(float lo, float hi) { typedef float f2 __attribute__((ext_vector_type(2))); typedef __bf16 b2 __attribute__((ext_vector_type(2))); f2 v = {lo, hi}; b2 b = __builtin_convertvector(v, b2); return __builtin_bit_cast(unsigned, b); }
__device__ __forceinline__ void sb_unit(int b, int h, int qb, const bf16* __restrict__ proj, const bf16* __restrict__ Vt, bf16* __restrict__ mix, LAS unsigned char* stage, int lane) {
    const int r32 = lane & 31, hi = lane >> 5;
    const size_t rowbase = (size_t)b * SEQ; const int t0 = qb * 32;
    const bf16* qp = proj + (rowbase + t0 + r32) * P0W + h * 64 + hi * 8;
    bf16x8 qr[4];
#pragma unroll
    for (int d0 = 0; d0 < 4; ++d0) qr[d0] = *(const bf16x8*)(qp + d0 * 16);
    const bf16* kbase = proj + (rowbase + swap23(r32)) * P0W + 512 + h * 64 + hi * 8;
    const bf16* vbase = Vt + (size_t)(h * 64 + r32) * MTOK + rowbase + hi * 8;
    f32x16 o0 = {}, o1 = {};
    float R = 0.f;
#define SB_LOAD(KF, VF, kt_) do { const bf16* kp = kbase + (size_t)(kt_) * 32 * P0W; const bf16* vp = vbase + (kt_) * 32; \
        _Pragma("unroll") for (int d0 = 0; d0 < 4; ++d0) KF[d0] = *(const bf16x8*)(kp + d0 * 16); \
        VF[0] = *(const bf16x8*)(vp); VF[1] = *(const bf16x8*)(vp + 16); VF[2] = *(const bf16x8*)(vp + (size_t)32 * MTOK); VF[3] = *(const bf16x8*)(vp + (size_t)32 * MTOK + 16); } while (0)
#define SB_COMPUTE(KF, VF, kt_) do { \
        f32x16 p = {}; \
        _Pragma("unroll") for (int d0 = 0; d0 < 4; ++d0) p = __builtin_amdgcn_mfma_f32_32x32x16_bf16(KF[d0], qr[d0], p, 0, 0, 0); \
        const bool diag = ((kt_) == qb); \
        float sp[16], lb[16]; \
        _Pragma("unroll") for (int r = 0; r < 16; ++r) { const float z = p[r]; const float e = __builtin_amdgcn_exp2f(-__builtin_fabsf(z)); const float l = __builtin_amdgcn_logf(1.0f + e); \
            sp[r] = __builtin_fmaxf(z, 0.f) + l; lb[r] = __builtin_fminf(z, 0.f) - l; \
            if (diag) { const int koff = (r & 7) + 8 * hi + 16 * (r >> 3); if (koff >= r32) { sp[r] = 0.f; lb[r] = -INFINITY; } } } \
        float ex[16], G0, G1; \
        { float run = 0.f; \
          _Pragma("unroll") for (int j = 7; j >= 0; --j) { ex[j] = run; run += sp[j]; } G0 = run; run = 0.f; \
          _Pragma("unroll") for (int j = 7; j >= 0; --j) { ex[8 + j] = run; run += sp[8 + j]; } G1 = run; } \
        const float Gp0 = __shfl_xor(G0, 32), Gp1 = __shfl_xor(G1, 32); \
        const float base1 = R + (hi ? 0.f : Gp1), base0 = R + G1 + Gp1 + (hi ? 0.f : Gp0); \
        float w[16]; \
        _Pragma("unroll") for (int r = 0; r < 16; ++r) w[r] = __builtin_amdgcn_exp2f(lb[r] - ((r < 8) ? base0 : base1) - ex[r]); \
        R += (G0 + G1) + (Gp0 + Gp1); \
        v4u a0, a1; a0.x = cvtpk2(w[0], w[1]); a0.y = cvtpk2(w[2], w[3]); a0.z = cvtpk2(w[4], w[5]); a0.w = cvtpk2(w[6], w[7]); \
        a1.x = cvtpk2(w[8], w[9]); a1.y = cvtpk2(w[10], w[11]); a1.z = cvtpk2(w[12], w[13]); a1.w = cvtpk2(w[14], w[15]); \
        const bf16x8 pa0 = __builtin_bit_cast(bf16x8, a0), pa1 = __builtin_bit_cast(bf16x8, a1); \
        o0 = __builtin_amdgcn_mfma_f32_32x32x16_bf16(pa0, VF[0], o0, 0, 0, 0); o0 = __builtin_amdgcn_mfma_f32_32x32x16_bf16(pa1, VF[1], o0, 0, 0, 0); \
        o1 = __builtin_amdgcn_mfma_f32_32x32x16_bf16(pa0, VF[2], o1, 0, 0, 0); o1 = __builtin_amdgcn_mfma_f32_32x32x16_bf16(pa1, VF[3], o1, 0, 0, 0); \
        done = __all(R > 151.0f) != 0; } while (0)
    bf16x8 kA[4], vA[4], kB[4], vB[4];
    SB_LOAD(kA, vA, qb);
#pragma unroll
    for (int d0 = 0; d0 < 4; ++d0) { kB[d0] = kA[d0]; vB[d0] = vA[d0]; }
    if (qb > 0) SB_LOAD(kB, vB, qb - 1);
    bool done = false;
    for (int kt = qb;; kt -= 2) {
        SB_COMPUTE(kA, vA, kt);
        if (done || kt < 1) break;
        if (kt >= 2) SB_LOAD(kA, vA, kt - 2);
        SB_COMPUTE(kB, vB, kt - 1);
        if (done || kt < 2) break;
        if (kt >= 3) SB_LOAD(kB, vB, kt - 3);
    }
#undef SB_LOAD
#undef SB_COMPUTE
    LAS bf16* stg = (LAS bf16*)stage;
#pragma unroll
    for (int r = 0; r < 16; ++r) { const int orow = (r & 3) + 8 * (r >> 2) + 4 * hi; stg[orow * 64 + r32] = (bf16)f2bf(o0[r]); stg[orow * 64 + 32 + r32] = (bf16)f2bf(o1[r]); }
    LDS_WAIT(); asm volatile("" ::: "memory");
    bf16* op = mix + (rowbase + t0) * 1024 + h * 64;
#pragma unroll
    for (int i = 0; i < 4; ++i) { const int row = i * 8 + (lane >> 3), ch = lane & 7; const v4u v = *(const LAS v4u*)(stg + row * 64 + ch * 8); *(v4u*)(op + (size_t)row * 1024 + ch * 8) = v; }
    LDS_WAIT(); asm volatile("" ::: "memory");
}
__device__ __forceinline__ void conv_items(const bf16* __restrict__ proj, const float* __restrict__ cw, bf16* __restrict__ mix, int gtid, int nthreads) {
    for (int it = gtid; it < (MTOK / 8) * 64; it += nthreads) {
        const int rb = it >> 6, ch = (it & 63) * 8, m0 = rb * 8;
        float w0[8], w1[8], w2[8], c2[8], c1[8];
#pragma unroll
        for (int i = 0; i < 8; ++i) { w0[i] = cw[ch + i]; w1[i] = cw[512 + ch + i]; w2[i] = cw[1024 + ch + i]; c2[i] = 0.f; c1[i] = 0.f; }
        if ((m0 & (SEQ - 1)) != 0) {
            const v4u Ca = *(const v4u*)(proj + (size_t)(m0 - 2) * P0W + 1536 + ch), Ua = *(const v4u*)(proj + (size_t)(m0 - 2) * P0W + 2048 + ch);
            const v4u Cb = *(const v4u*)(proj + (size_t)(m0 - 1) * P0W + 1536 + ch), Ub = *(const v4u*)(proj + (size_t)(m0 - 1) * P0W + 2048 + ch);
#pragma unroll
            for (int i = 0; i < 4; ++i) { c2[2 * i] = bf_lo(Ca[i]) * bf_lo(Ua[i]); c2[2 * i + 1] = bf_hi(Ca[i]) * bf_hi(Ua[i]); c1[2 * i] = bf_lo(Cb[i]) * bf_lo(Ub[i]); c1[2 * i + 1] = bf_hi(Cb[i]) * bf_hi(Ub[i]); }
        }
#pragma unroll
        for (int r = 0; r < 8; ++r) { const bf16* rp = proj + (size_t)(m0 + r) * P0W + ch;
            const v4u Bv = __builtin_nontemporal_load((const v4u*)(rp + 1024)), Cv = __builtin_nontemporal_load((const v4u*)(rp + 1536)), Uv = __builtin_nontemporal_load((const v4u*)(rp + 2048));
            float c0[8], y[8];
#pragma unroll
            for (int i = 0; i < 4; ++i) { c0[2 * i] = bf_lo(Cv[i]) * bf_lo(Uv[i]); c0[2 * i + 1] = bf_hi(Cv[i]) * bf_hi(Uv[i]); }
#pragma unroll
            for (int i = 0; i < 8; ++i) y[i] = w0[i] * c2[i] + w1[i] * c1[i] + w2[i] * c0[i];
            v4u o;
#pragma unroll
            for (int i = 0; i < 4; ++i) o[i] = pk2(bf_lo(Bv[i]) * y[2 * i], bf_hi(Bv[i]) * y[2 * i + 1]);
            *(v4u*)(mix + (size_t)(m0 + r) * 1024 + 512 + ch) = o;
#pragma unroll
            for (int i = 0; i < 8; ++i) { c2[i] = c1[i]; c1[i] = c0[i]; } }
    }
}

typedef GAS unsigned gu32;
#define RLX_AGENT __ATOMIC_RELAXED, __HIP_MEMORY_SCOPE_AGENT
constexpr int CW_PANEL = 8192;
constexpr int CW_BAR = 4096;
constexpr int LDSCTL_OFF = RING_BYTES, MISC_OFF = LDSCTL_OFF + 320;
#define XB_TMO      128
#define XB_XCNT(j)  (256  + 64 * (j))
#define XB_XSUB(j)  (1280 + 64 * (j))
#define XB_XGEN(j)  (2304 + 64 * (j))
#define XB_TOP      3328
#define XB_TOPGEN   3392
#define XCD_BAR_WORDS 3456
#define XB_SPIN_CAP (1u << 18)

__device__ __forceinline__ unsigned xb_ld(unsigned* p)              { return __hip_atomic_load(p, __ATOMIC_RELAXED, __HIP_MEMORY_SCOPE_AGENT); }
__device__ __forceinline__ unsigned xb_add(unsigned* p, unsigned v) { return __hip_atomic_fetch_add(p, v, __ATOMIC_RELAXED, __HIP_MEMORY_SCOPE_AGENT); }
__device__ __forceinline__ unsigned xb_xcc_id() { return (unsigned)__builtin_amdgcn_s_getreg((3 << 11) | 20) & 0xFu; }
#define XB_SPIN(cond, bar) do { unsigned _sp = 0; while (cond) { __builtin_amdgcn_s_sleep(1); \
    if ((++_sp & 255u) == 0u) { if (xb_ld(&(bar)[XB_TMO])) break; if (_sp > XB_SPIN_CAP) { atomicAdd(&(bar)[XB_TMO], 1u); break; } } } } while (0)

struct XcdBarrier {
    unsigned* bar; unsigned x;
    volatile LAS unsigned* st;
};

__device__ __forceinline__ XcdBarrier xcd_barrier_post(unsigned* bar, volatile LAS unsigned* st) {
    XcdBarrier b; b.bar = bar; b.x = xb_xcc_id(); b.st = st;
    if (threadIdx.x == 0) (void)xb_add(&bar[XB_XCNT(b.x)], 1u);
    return b;
}
__device__ __forceinline__ void xcd_barrier_complete(unsigned* bar, unsigned x, unsigned& nloc, unsigned& nx) {
    const unsigned G = gridDim.x * gridDim.y * gridDim.z;
    unsigned sum, cnt, mine, sp = 0u;
    for (;;) {
        sum = 0u; cnt = 0u; mine = 0u;
#pragma unroll
        for (unsigned j = 0; j < 16; ++j) { const unsigned c = xb_ld(&bar[XB_XCNT(j)]); sum += c; cnt += (c > 0u) ? 1u : 0u; mine = (j == x) ? c : mine; }
        if (sum == G) break;
        __builtin_amdgcn_s_sleep(1);
        if ((++sp & 255u) == 0u) { if (xb_ld(&bar[XB_TMO])) break; if (sp > XB_SPIN_CAP) { atomicAdd(&bar[XB_TMO], 1u); break; } }
    }
    nloc = mine > 0u ? mine : 1u; nx = cnt > 0u ? cnt : 1u;
}

__device__ __forceinline__ void xcd_barrier_thread0(const XcdBarrier& b) {
    {
        unsigned* bar = b.bar;
        __builtin_amdgcn_s_waitcnt(0);
        unsigned nloc = b.st[0], nx = b.st[1];
        if (nloc == 0u) { xcd_barrier_complete(bar, b.x, nloc, nx); b.st[0] = nloc; b.st[1] = nx; }
        const unsigned old = xb_add(&bar[XB_XSUB(b.x)], 1u);
        const unsigned gen = old / nloc;
        if (old + 1u == (gen + 1u) * nloc) {
            __builtin_amdgcn_fence(__ATOMIC_RELEASE, "agent");
            asm volatile("s_waitcnt vmcnt(0)" ::: "memory");
            const unsigned og = xb_add(&bar[XB_TOP], 1u);
            const unsigned tg = og / nx;
            if (og + 1u == (tg + 1u) * nx) xb_add(&bar[XB_TOPGEN], 1u);
            else XB_SPIN(xb_ld(&bar[XB_TOPGEN]) == tg, bar);
            __builtin_amdgcn_fence(__ATOMIC_ACQUIRE, "agent");
            xb_add(&bar[XB_XGEN(b.x)], 1u);
            asm volatile("s_waitcnt vmcnt(0)" ::: "memory");
        } else {
            XB_SPIN(xb_ld(&bar[XB_XGEN(b.x)]) == gen, bar);
            __builtin_amdgcn_fence(__ATOMIC_ACQUIRE, "agent");
            asm volatile("s_waitcnt vmcnt(0)" ::: "memory");
        }
    }
}
__device__ __forceinline__ void xcd_barrier(const XcdBarrier& b) {
    asm volatile("s_waitcnt vmcnt(0)" ::: "memory");
    __syncthreads();
    if (threadIdx.x == 0) xcd_barrier_thread0(b);
    __syncthreads();
}
#define LAYER_TAIL(layer) \
        { PHASE_IDS pg8::Gemm g{MIXp, WLp(layer, W_OUT), MTOK, 1024, 1024}; pg8::StaticOrder S; S.init(MTOK, 1024, G, bx); \
          pg8::EpiRes E{layer ? (const float*)XRES : XIN, XRES, XBp, SSQ(2 * layer + 1)}; \
          pg8::gemm_phase<pg8::EpiRes, pg8::StaticOrder, PG8_ALIGN, PG8_SP2>(ldsp, g, S, E); } \
        if (layer == 0) xcd_barrier_work(bar, args, WSLICE(3), ldsp); else xcd_barrier(bar); \
        { PHASE_IDS pg8::Gemm g{XBp, WLp(layer, W_UP), MTOK, FF, 1024}; pg8::StaticOrder S; S.init(MTOK, FF, G, bx); \
          pg8::EpiRow<1> E{HBp, FF, SSQ(2 * layer + 1), 0, 1.f}; \
          pg8::gemm_phase<pg8::EpiRow<1>, pg8::StaticOrder, PG8_ALIGN, PG8_SP2>(ldsp, g, S, E); } \
        if (layer == 0) xcd_barrier_work(bar, args, WSLICE(4), ldsp); else xcd_barrier(bar); \
        if (layer == 1 && gridDim.x == 256) {     \
          PHASE_IDS pg8::Gemm g{HBp, WLp(layer, W_DOWN), MTOK, 1024, FF}; pg8::StaticOrder S; S.init(MTOK, 1024, G, bx); \
          pg8::EpiResFinal E{XRES, XRES, SSQ(4), (unsigned*)(args.ws + WS_CTL) + CW_PANEL, args.in[3]}; \
          pg8::gemm_phase<pg8::EpiResFinal, pg8::StaticOrder, false, PG8_SP2>(ldsp, g, S, E); \
        } else { \
        { PHASE_IDS pg8::Gemm g{HBp, WLp(layer, W_DOWN), MTOK, 1024, FF}; pg8::StaticOrder S; S.init(MTOK, 1024, G, bx); \
          pg8::EpiRes E{XRES, XRES, XBp, SSQ(2 * layer + 2)}; \
          pg8::gemm_phase<pg8::EpiRes, pg8::StaticOrder, PG8_ALIGN, PG8_SP2>(ldsp, g, S, E); } \
        if (layer == 0) xcd_barrier_work(bar, args, WSLICE(5), ldsp); else xcd_barrier(bar); }
constexpr int I_IN = 16 * 96, I_OUT = 16 * 32, I_UP = 16 * 128, I_DN = 64 * 32, I_L = I_IN + I_OUT + I_UP + I_DN;
struct Args { const float* in[16]; float* out; unsigned char* ws; };
struct CvtItem { const float* wp; bf16* op; int N, K; f32x4 g0, g1; };
__device__ __forceinline__ void cvt_decode(const Args& args, int it, int lane, CvtItem& d) {
    const int l = it / I_L; int r = it % I_L;
    const float* W; bf16* WT; int K = 1024, N; const float* gs = nullptr; int gmask = 1023; float gmul = 1.f; bool remap = false;
    if (r < I_IN) { W = l ? args.in[7] : args.in[4]; N = 3072; WT = (bf16*)(args.ws + WS_W + (size_t)l * W_LAYER + W_IN); gs = args.in[1] + l * 1024; remap = (l == 0); }
    else if ((r -= I_IN) < I_OUT) { W = l ? args.in[13] : args.in[6]; N = 1024; WT = (bf16*)(args.ws + WS_W + (size_t)l * W_LAYER + W_OUT); gs = l ? args.in[12] : nullptr; gmask = 127; gmul = 1.0f - LAMBDA_INIT1; }
    else if ((r -= I_OUT) < I_UP) { W = args.in[14] + (size_t)l * 1024 * 4096; N = 4096; WT = (bf16*)(args.ws + WS_W + (size_t)l * W_LAYER + W_UP); gs = args.in[2] + l * 1024; }
    else { r -= I_UP; W = args.in[15] + (size_t)l * 4096 * 1024; K = 4096; N = 1024; WT = (bf16*)(args.ws + WS_W + (size_t)l * W_LAYER + W_DOWN); }
    const int nblk = N / 32, kb = r / nblk, nb = r % nblk, k0 = 64 * kb, n0 = 32 * nb, c = lane & 7;
    int r0 = n0; if (remap) r0 = n0 < 1024 ? n0 : (n0 < 1536 ? n0 + 1536 : n0 - 512);
    d.N = N; d.K = K; d.wp = W + (size_t)(k0 + (lane >> 3)) * N + n0 + 4 * c; d.op = WT + (size_t)(r0 + (lane >> 3)) * K + k0 + 8 * c;
    d.g0 = (f32x4){1.f, 1.f, 1.f, 1.f}; d.g1 = d.g0;
    if (gs) { const float* gp = gs + ((k0 + 8 * c) & gmask); d.g0 = *(const f32x4*)gp * gmul; d.g1 = *(const f32x4*)(gp + 4) * gmul; }
}
__device__ __forceinline__ void cvt_load(const CvtItem& d, f32x4 (&v)[8]) {
#pragma unroll
    for (int i = 0; i < 8; ++i) v[i] = __builtin_nontemporal_load((const f32x4*)(d.wp + (size_t)(8 * i) * d.N));
}
__device__ __forceinline__ void cvt_lds_write(const f32x4 (&v)[8], LAS float* scr, int lane) {
    const int c = lane & 7;
#pragma unroll
    for (int i = 0; i < 8; ++i) { LAS float* p = scr + (8 * i + (lane >> 3)) * 33 + 4 * c; p[0] = v[i][0]; p[1] = v[i][1]; p[2] = v[i][2]; p[3] = v[i][3]; }
    LDS_WAIT(); asm volatile("" ::: "memory");
}
__device__ __forceinline__ void cvt_lds_read_store(const CvtItem& d, LAS float* scr, int lane) {
    const int c = lane & 7;
#pragma unroll
    for (int j = 0; j < 4; ++j) { const LAS float* s = scr + (8 * c) * 33 + (lane >> 3) + 8 * j;
        v4u o; o.x = pk2(s[0 * 33] * d.g0[0], s[1 * 33] * d.g0[1]); o.y = pk2(s[2 * 33] * d.g0[2], s[3 * 33] * d.g0[3]); o.z = pk2(s[4 * 33] * d.g1[0], s[5 * 33] * d.g1[1]); o.w = pk2(s[6 * 33] * d.g1[2], s[7 * 33] * d.g1[3]);
        *(GAS v4u*)(d.op + (size_t)(8 * j) * d.K) = o; }
    LDS_WAIT(); asm volatile("" ::: "memory");
}
__device__ __forceinline__ void convert_items(const Args& args, int lo, int hi, int gw, int NGW, int lane, LAS float* scr) {
    int it = lo + gw; if (it >= hi) return;
    CvtItem A, B, C; f32x4 va[8], vb[8];
    cvt_decode(args, it, lane, A); cvt_load(A, va);
    bool hb = (it + NGW) < hi; B = A;
#pragma unroll
    for (int i = 0; i < 8; ++i) vb[i] = va[i];
    if (hb) { cvt_decode(args, it + NGW, lane, B); cvt_load(B, vb); }
    for (;;) {
        cvt_lds_write(va, scr, lane);
        const bool hc = (it + 2 * NGW) < hi; C = A;
        if (hc) { cvt_decode(args, it + 2 * NGW, lane, C); cvt_load(C, va); }
        cvt_lds_read_store(A, scr, lane);
        if (!hb) break;
        cvt_lds_write(vb, scr, lane);
        const bool hd = (it + 3 * NGW) < hi; A = B;
        CvtItem D = B;
        if (hd) { cvt_decode(args, it + 3 * NGW, lane, D); cvt_load(D, vb); }
        cvt_lds_read_store(A, scr, lane);
        if (!hc) break;
        A = C; B = D; hb = hd; it += 2 * NGW;
    }
}
#define CONVERT_ITEMS(lo, hi) convert_items(args, (lo), (hi), gw, NGW, lane, scr);
__device__ __forceinline__ void xcd_barrier_work(const XcdBarrier& b, const Args& args, int lo, int hi, LAS unsigned char* ldsp) {
    asm volatile("s_waitcnt vmcnt(0)" ::: "memory");
    __syncthreads();
    int tid = threadIdx.x; asm volatile("" : "+v"(tid));
    const int wave = __builtin_amdgcn_readfirstlane(tid >> 6);
    if (wave == 0) { if (tid == 0) xcd_barrier_thread0(b); }
    else { int G = gridDim.x, bx = blockIdx.x; asm volatile("" : "+s"(G), "+s"(bx)); const int vcu = (G % 8 == 0) ? (bx % 8) * (G / 8) + bx / 8 : bx;
           convert_items(args, lo, hi, vcu * 7 + (wave - 1), G * 7, tid & 63, (LAS float*)(ldsp + wave * 16384)); }
    __syncthreads();
}
constexpr int I_W = (2 * I_L - I_IN) / 6;
#define WSLICE(k) (I_IN + (k) * I_W), (I_IN + ((k) + 1) * I_W)
static_assert((2 * I_L - I_IN) % 6 == 0 && I_IN + 1 * I_W >= I_IN + I_OUT && I_IN + 2 * I_W >= I_IN + I_OUT + I_UP && I_IN + 3 * I_W >= I_L && I_IN + 4 * I_W >= I_L + I_IN + I_OUT, "slice k is published by barrier k+1: out0 by 1, up0 by 2, down0 by 3, in1 by 4, out1 by 6, up1 by 7, down1 by 8");

__global__ void __launch_bounds__(NWAVES * 64, 2) mega_fwd(Args args) {
    extern __shared__ __attribute__((aligned(16))) unsigned char lds[];
    cg::grid_group grid = cg::this_grid();
    LAS unsigned char* ldsp = (LAS unsigned char*)lds;
    for (int u = threadIdx.x; u < (LDS_BYTES - LDSCTL_OFF) / 4; u += NWAVES * 64) ((LAS unsigned*)(ldsp + LDSCTL_OFF))[u] = 0u;
    __syncthreads();
    const XcdBarrier bar = xcd_barrier_post((unsigned*)(args.ws + WS_CTL) + CW_BAR, (volatile LAS unsigned*)(ldsp + MISC_OFF) + 8);
#define PHASE_IDS int tid = threadIdx.x; asm volatile("" : "+v"(tid)); const int lane = tid & 63, wave = __builtin_amdgcn_readfirstlane(tid >> 6); \
    int G = gridDim.x, bx = blockIdx.x; asm volatile("" : "+s"(G), "+s"(bx)); const int vcu = (G % 8 == 0) ? (bx % 8) * (G / 8) + bx / 8 : bx; \
    const int gw = vcu * NWAVES + wave, NGW = G * NWAVES; (void)lane; (void)gw; (void)NGW; (void)tid;
#define XIN   (args.in[0])
#define XRES  (args.out)
#define SSQ(i) ((float*)(args.ws + WS_SSQ) + (size_t)(i) * MTOK)
#define XBp   ((bf16*)(args.ws + WS_XB))
#define PROJp ((bf16*)(args.ws + WS_PROJ))
#define VTp   ((bf16*)(args.ws + WS_VT))
#define MIXp  ((bf16*)(args.ws + WS_MIX))
#define HBp   ((bf16*)(args.ws + WS_H))
#define WLp(l, off) ((bf16*)(args.ws + WS_W + (size_t)(l) * W_LAYER + (off)))

    {
        PHASE_IDS
        LAS float* scr = (LAS float*)(ldsp + wave * 16384);
        CONVERT_ITEMS(0, I_IN)
        for (int m = 2 * gw; m < MTOK; m += 2 * NGW) x_rows2_to_bf16(XIN + (size_t)m * 1024, XBp + (size_t)m * 1024, SSQ(0) + m, lane);
    }
    if (args.ws == nullptr) grid.sync();
    xcd_barrier_work(bar, args, WSLICE(0), ldsp);

    {
        { PHASE_IDS pg8::Gemm g{XBp, WLp(0, W_IN), MTOK, P0W, 1024}; pg8::StaticOrder S; S.init(MTOK, P0W, G, bx);
          pg8::EpiRow<0> E{PROJp, P0W, SSQ(0), 2, QSCALE};
          pg8::gemm_phase<pg8::EpiRow<0>, pg8::StaticOrder, PG8_ALIGN, PG8_SP2>(ldsp, g, S, E); }
        { PHASE_IDS pg8::Gemm g{WLp(0, W_IN) + (size_t)P0W * 1024, XBp, 512, MTOK, 1024}; pg8::StaticOrder S; S.init(512, MTOK, G, (bx + G / 2) % G);
          pg8::EpiColScale E{VTp, MTOK, SSQ(0)};
          pg8::gemm_phase<pg8::EpiColScale, pg8::StaticOrder, PG8_ALIGN, PG8_SP2>(ldsp, g, S, E); }
        xcd_barrier_work(bar, args, WSLICE(1), ldsp);
        { PHASE_IDS
          if (wave < 4) conv_items(PROJp, args.in[5], MIXp, vcu * 256 + tid, G * 256);
          else for (int u = vcu * 4 + (wave - 4); u < 2 * 8 * 256; u += G * 4) sb_unit(u >> 11, (u >> 8) & 7, u & 255, PROJp, VTp, MIXp, ldsp + wave * 16384 + 8704, lane); }
        xcd_barrier_work(bar, args, WSLICE(2), ldsp);
        LAYER_TAIL(0)
    }
    {
        { PHASE_IDS pg8::Gemm g{XBp, WLp(1, W_IN), MTOK, P1W, 1024}; pg8::StaticOrder S; S.init(MTOK, P1W, G, bx);
          pg8::EpiRow<0> E{PROJp, P1W, SSQ(2), 4, QSCALE};
          pg8::gemm_phase<pg8::EpiRow<0>, pg8::StaticOrder, PG8_ALIGN, PG8_SP2>(ldsp, g, S, E); }
        xcd_barrier(bar);
        { PHASE_IDS const dattn::DiffOrder S(vcu, G); dattn::diff_phase((char*)lds, PROJp, MIXp, S); }
        { PHASE_IDS float lam;
          { const float a = wave_sum(args.in[8][lane] * args.in[9][lane]), c = wave_sum(args.in[10][lane] * args.in[11][lane]); lam = __expf(a) - __expf(c) + LAMBDA_INIT1; }
          const dattn::DiffOrder S(vcu, G); dattn::diff_combine(PROJp, MIXp, S, lam); }
        xcd_barrier(bar);
        LAYER_TAIL(1)
    }
    if (gridDim.x != 256) { PHASE_IDS const float* ssq_f = SSQ(4);
      f32x4 gv[4];
#pragma unroll
      for (int j = 0; j < 4; ++j) gv[j] = ((const f32x4*)args.in[3])[lane + 64 * j];
      for (int m = 2 * gw; m < MTOK; m += 2 * NGW) { const float rs0 = pg8::rstd_of(ssq_f[m]), rs1 = pg8::rstd_of(ssq_f[m + 1]); f32x4* xr = (f32x4*)(XRES + (size_t)m * 1024) + lane;
          f32x4 v[8];
#pragma unroll
          for (int j = 0; j < 8; ++j) v[j] = xr[64 * j];
#pragma unroll
          for (int j = 0; j < 4; ++j) { xr[64 * j] = v[j] * rs0 * gv[j]; xr[256 + 64 * j] = v[4 + j] * rs1 * gv[j]; } } }
}

extern "C" void kernel_launch(void* const* d_in, const int* in_sizes, int n_in, void* d_out, int out_size, void* d_ws, size_t ws_size, hipStream_t stream) {
    static int grid = 0;
    if (grid == 0) {
        if (n_in != 16 || in_sizes[0] != MTOK * DMOD || out_size != MTOK * DMOD || ws_size < WS_END) { fprintf(stderr, "kernel_launch: unexpected shapes (n_in %d, in0 %d, out %d, ws %zu)\n", n_in, n_in > 0 ? in_sizes[0] : -1, out_size, ws_size); grid = -1; return; }
        int dev = 0, cus = 0, per_cu = 0;
        if (hipGetDevice(&dev) != hipSuccess || hipDeviceGetAttribute(&cus, hipDeviceAttributeMultiprocessorCount, dev) != hipSuccess) { grid = -1; return; }
        if (hipFuncSetAttribute((const void*)mega_fwd, hipFuncAttributeMaxDynamicSharedMemorySize, LDS_BYTES) != hipSuccess) { fprintf(stderr, "kernel_launch: hipFuncSetAttribute failed\n"); grid = -1; return; }
        if (hipOccupancyMaxActiveBlocksPerMultiprocessor(&per_cu, (const void*)mega_fwd, NWAVES * 64, LDS_BYTES) != hipSuccess || per_cu < 1) { fprintf(stderr, "kernel_launch: occupancy query says %d\n", per_cu); per_cu = 1; }
        (void)hipGetLastError();
        grid = cus;
    }
    if (grid < 0) return;
    (void)hipMemsetAsync((char*)d_ws + WS_CTL, 0, CTL_ZERO_BYTES, stream);
    Args a{};
    for (int i = 0; i < 16; ++i) a.in[i] = (const float*)d_in[i];
    a.out = (float*)d_out; a.ws = (unsigned char*)d_ws;
    void* kargs[] = {&a};
    hipError_t e = hipLaunchCooperativeKernel((const void*)mega_fwd, dim3(grid), dim3(NWAVES * 64), kargs, LDS_BYTES, stream);
    if (e != hipSuccess) fprintf(stderr, "kernel_launch: cooperative launch failed: %s (grid %d)\n", hipGetErrorString(e), grid);
}
```

```cpp
#include <hip/hip_runtime.h>
#include <cstdio>
#include <cstdint>
namespace pg8 {
#define PG8_LAS __attribute__((address_space(3)))
typedef unsigned short bf16_t;
typedef short bf16x8 __attribute__((ext_vector_type(8)));
typedef float f32x4 __attribute__((ext_vector_type(4)));
typedef unsigned u32x4 __attribute__((ext_vector_type(4)));
constexpr int BM = 256, BK = 64, HALF = 128, HTB = HALF * BK * 2  , STAGE_BYTES = 8 * HTB, NXCD = 8, WGM = 8;

__host__ __device__ __forceinline__ int lds_byte(int r, int c) { const int st = (r >> 4) * 2 + (c >> 5), rr = r & 15, cc = c & 31, ob = rr * 64 + cc * 2; return st * 1024 + (ob ^ (((ob >> 9) & 1) << 5)); }
__host__ __device__ __forceinline__ void stage_rc(int b, int& R, int& C) { const int st = b / 1024, sb = b % 1024, swz = sb ^ (((sb >> 9) & 1) << 5); R = (st >> 1) * 16 + swz / 64; C = (st & 1) * 32 + (swz % 64) / 2; }
__host__ __device__ __forceinline__ int perm32(int rho) { const int n = rho >> 4, i = rho & 15; return 8 * (i >> 2) + 4 * n + (i & 3); }

struct Unit { int pm, pn; };
struct Gemm { const bf16_t* A; const bf16_t* Bt; int M, N, K; };

struct StaticOrder {
    int nM, nN, nwg, G, c;
    __host__ __device__ void init(int M, int N, int G_, int c_) { nM = M / BM; nN = N / BM; nwg = nM * nN; G = G_; c = c_; }
    __host__ __device__ bool next(int i, Unit& u) const {
        const long L = (long)i * G + c; if (L >= nwg) return false;
        int wgid = (int)L; { const int q = nwg / NXCD, r = nwg % NXCD, xcd = wgid % NXCD, off = wgid / NXCD; wgid = (xcd < r ? xcd * (q + 1) : r * (q + 1) + (xcd - r) * q) + off; }
        const int nig = WGM * nN, gid = wgid / nig, fm = gid * WGM, gsz = (nM - fm) < WGM ? (nM - fm) : WGM;
        u.pm = fm + ((wgid % nig) % gsz); u.pn = (wgid % nig) / gsz; return true;
    }
    __device__ __forceinline__ void a_ready(const Unit&) const {}
    __device__ __forceinline__ void done(const Unit&) const {}
};

__device__ __forceinline__ unsigned cvt_pk_bf16(float lo, float hi) { unsigned r; asm volatile("v_cvt_pk_bf16_f32 %0, %1, %2" : "=v"(r) : "v"(lo), "v"(hi)); return r; }
typedef float f32x2 __attribute__((ext_vector_type(2)));
__device__ __forceinline__ float rstd_of(float ssq) { return __builtin_amdgcn_rsqf(ssq * (1.0f / 1024.0f) + 1e-6f); }
typedef unsigned u32x2 __attribute__((ext_vector_type(2)));
template <int ACT> struct EpiRow {
    static constexpr bool PERM = true, AFTER_DRAIN = false;
    bf16_t* O; int ldc; const float* ssq; int qtiles; float qscale;
    __device__ __forceinline__ void operator()(const f32x4 (&acc)[2][2][4][2], const Unit& u, int wr, int wc, int fr, int fq) const {
        const int row0 = u.pm * BM + wr * 64 + fr, col0 = u.pn * BM + wc * 32 + 8 * fq;
        const float sc = (u.pn < qtiles) ? qscale : 1.f;
        float rsv[2][4];
#pragma unroll
        for (int ai = 0; ai < 2; ++ai)
#pragma unroll
            for (int m = 0; m < 4; ++m) rsv[ai][m] = ssq[row0 + ai * HALF + m * 16];
#pragma unroll
        for (int ai = 0; ai < 2; ++ai)
#pragma unroll
            for (int m = 0; m < 4; ++m) { const int row = row0 + ai * HALF + m * 16; const float rs = rstd_of(rsv[ai][m]) * sc; bf16_t* rowp = O + (size_t)row * ldc + col0;
#pragma unroll
                for (int bj = 0; bj < 2; ++bj) { f32x4 v0 = acc[ai][bj][m][0], v1 = acc[ai][bj][m][1];
                    if (ACT == 1) { const f32x4 z = {0.f, 0.f, 0.f, 0.f}; v0 = __builtin_elementwise_max(v0, z) * rs; v1 = __builtin_elementwise_max(v1, z) * rs; v0 = v0 * v0; v1 = v1 * v1; }
                    else { v0 = v0 * rs; v1 = v1 * rs; }
                    u32x4 w; w.x = cvt_pk_bf16(v0[0], v0[1]); w.y = cvt_pk_bf16(v0[2], v0[3]); w.z = cvt_pk_bf16(v1[0], v1[1]); w.w = cvt_pk_bf16(v1[2], v1[3]);
                    *(u32x4*)(rowp + bj * HALF) = w; } }
    }
};
struct EpiColScale {
    static constexpr bool PERM = true, AFTER_DRAIN = false;
    bf16_t* O; int ldc; const float* ssq;
    __device__ __forceinline__ void operator()(const f32x4 (&acc)[2][2][4][2], const Unit& u, int wr, int wc, int fr, int fq) const {
        const int row0 = u.pm * BM + wr * 64 + fr, col0 = u.pn * BM + wc * 32 + 8 * fq;
        f32x4 sv[2][2];
#pragma unroll
        for (int bj = 0; bj < 2; ++bj)
#pragma unroll
            for (int n = 0; n < 2; ++n) { const f32x4 s = *(const f32x4*)(ssq + col0 + bj * HALF + 4 * n); sv[bj][n] = (f32x4){rstd_of(s[0]), rstd_of(s[1]), rstd_of(s[2]), rstd_of(s[3])}; }
#pragma unroll
        for (int ai = 0; ai < 2; ++ai)
#pragma unroll
            for (int m = 0; m < 4; ++m) { bf16_t* rowp = O + (size_t)(row0 + ai * HALF + m * 16) * ldc + col0;
#pragma unroll
                for (int bj = 0; bj < 2; ++bj) { const f32x4 v0 = acc[ai][bj][m][0] * sv[bj][0], v1 = acc[ai][bj][m][1] * sv[bj][1];
                    u32x4 w; w.x = cvt_pk_bf16(v0[0], v0[1]); w.y = cvt_pk_bf16(v0[2], v0[3]); w.z = cvt_pk_bf16(v1[0], v1[1]); w.w = cvt_pk_bf16(v1[2], v1[3]);
                    *(u32x4*)(rowp + bj * HALF) = w; } }
    }
};
struct EpiRes {
    static constexpr bool PERM = false, AFTER_DRAIN = false;
    const float* base; float* out; bf16_t* xb; float* ssq;
    __device__ __forceinline__ void operator()(const f32x4 (&acc)[2][2][4][2], const Unit& u, int wr, int wc, int fr, int fq) const {
        const int row0 = u.pm * BM + wr * 64 + fr, col0 = u.pn * BM + wc * 32 + 4 * fq;
#pragma unroll
        for (int ai = 0; ai < 2; ++ai) {
            f32x4 pre[4][2][2];
#pragma unroll
            for (int m = 0; m < 4; ++m) { const size_t off = (size_t)(row0 + ai * HALF + m * 16) * 1024 + col0;
#pragma unroll
                for (int bj = 0; bj < 2; ++bj)
#pragma unroll
                    for (int n = 0; n < 2; ++n) pre[m][bj][n] = __builtin_nontemporal_load((const f32x4*)(base + off + bj * HALF + n * 16)); }
            asm volatile("" ::: "memory");
#pragma unroll
            for (int m = 0; m < 4; ++m) { const int row = row0 + ai * HALF + m * 16; const size_t off = (size_t)row * 1024 + col0; float s = 0.f;
#pragma unroll
                for (int bj = 0; bj < 2; ++bj)
#pragma unroll
                    for (int n = 0; n < 2; ++n) { const f32x4 v = pre[m][bj][n] + acc[ai][bj][m][n];
                        __builtin_nontemporal_store(v, (f32x4*)(out + off + bj * HALF + n * 16)); s += (v[0] * v[0] + v[1] * v[1]) + (v[2] * v[2] + v[3] * v[3]);
                        u32x2 w; w.x = cvt_pk_bf16(v[0], v[1]); w.y = cvt_pk_bf16(v[2], v[3]); *(u32x2*)(xb + off + bj * HALF + n * 16) = w; }
                s += __shfl_xor(s, 16); s += __shfl_xor(s, 32);
                if (fq == 0) __hip_atomic_fetch_add(ssq + row, s, __ATOMIC_RELAXED, __HIP_MEMORY_SCOPE_AGENT); }
            asm volatile("" ::: "memory");
        }
    }
};

struct EpiResFinal {
    static constexpr bool PERM = false, AFTER_DRAIN = true;
    const float* base; float* out; float* ssq; unsigned* cnt; const float* gain;
    __device__ __forceinline__ void operator()(const f32x4 (&)[2][2][4][2], const Unit&, int, int, int, int) const {}
    __device__ __forceinline__ void fused(f32x4 (&acc)[2][2][4][2], const Unit& u, int wr, int wc, int fr, int fq, PG8_LAS unsigned char*, int, int lane) const {
        const int row0 = u.pm * BM + wr * 64 + fr, col0 = u.pn * BM + wc * 32 + 4 * fq;
#pragma unroll
        for (int ai = 0; ai < 2; ++ai) {
            f32x4 pre[4][2][2];
#pragma unroll
            for (int m = 0; m < 4; ++m) { const size_t off = (size_t)(row0 + ai * HALF + m * 16) * 1024 + col0;
#pragma unroll
                for (int bj = 0; bj < 2; ++bj)
#pragma unroll
                    for (int n = 0; n < 2; ++n) pre[m][bj][n] = __builtin_nontemporal_load((const f32x4*)(base + off + bj * HALF + n * 16)); }
            asm volatile("" ::: "memory");
#pragma unroll
            for (int m = 0; m < 4; ++m) { const int row = row0 + ai * HALF + m * 16; float s = 0.f;
#pragma unroll
                for (int bj = 0; bj < 2; ++bj)
#pragma unroll
                    for (int n = 0; n < 2; ++n) { const f32x4 v = pre[m][bj][n] + acc[ai][bj][m][n]; acc[ai][bj][m][n] = v; s += (v[0] * v[0] + v[1] * v[1]) + (v[2] * v[2] + v[3] * v[3]); }
                s += __shfl_xor(s, 16); s += __shfl_xor(s, 32);
                if (fq == 0) __hip_atomic_fetch_add(ssq + row, s, __ATOMIC_RELAXED, __HIP_MEMORY_SCOPE_AGENT); }
        }
        asm volatile("s_waitcnt vmcnt(0)" ::: "memory");
        unsigned* c = cnt + 64 * u.pm;
        if (lane == 0) __hip_atomic_fetch_add(c, 1u, __ATOMIC_RELAXED, __HIP_MEMORY_SCOPE_AGENT);
        { unsigned sp = 0; while ((unsigned)__builtin_amdgcn_readfirstlane(__hip_atomic_load(c, __ATOMIC_RELAXED, __HIP_MEMORY_SCOPE_AGENT)) < 32u) { __builtin_amdgcn_s_sleep(2); if (++sp > (1u << 22)) break; } }
        __builtin_amdgcn_fence(__ATOMIC_ACQUIRE, "agent");
        f32x4 gv[2][2];
#pragma unroll
        for (int bj = 0; bj < 2; ++bj)
#pragma unroll
            for (int n = 0; n < 2; ++n) gv[bj][n] = *(const f32x4*)(gain + col0 + bj * HALF + n * 16);
        float rsv[2][4];
#pragma unroll
        for (int ai = 0; ai < 2; ++ai)
#pragma unroll
            for (int m = 0; m < 4; ++m) rsv[ai][m] = __hip_atomic_load(ssq + row0 + ai * HALF + m * 16, __ATOMIC_RELAXED, __HIP_MEMORY_SCOPE_AGENT);
#pragma unroll
        for (int ai = 0; ai < 2; ++ai)
#pragma unroll
            for (int m = 0; m < 4; ++m) { const float rs = rstd_of(rsv[ai][m]); const size_t off = (size_t)(row0 + ai * HALF + m * 16) * 1024 + col0;
#pragma unroll
                for (int bj = 0; bj < 2; ++bj)
#pragma unroll
                    for (int n = 0; n < 2; ++n) __builtin_nontemporal_store(acc[ai][bj][m][n] * rs * gv[bj][n], (f32x4*)(out + off + bj * HALF + n * 16)); }
    }
};

template <class Epi, class Sched, bool ALIGN_EPI = false, bool SP2 = false>
__device__ __forceinline__ void gemm_phase(PG8_LAS unsigned char* lds, const Gemm g, const Sched& S, const Epi& E) {
    int tid_ = threadIdx.x; asm volatile("" : "+v"(tid_));
    const int tid = tid_, wid = __builtin_amdgcn_readfirstlane(tid >> 6), lane = tid & 63, wr = wid >> 2, wc = wid & 3, fr = lane & 15, fq = lane >> 4;
    const int K = g.K, nt = K / BK;
    unsigned voffA[2], voffB[2];
#pragma unroll
    for (int i = 0; i < 2; ++i) { int R, C; stage_rc(tid * 16 + i * 8192, R, C); const int Rb = Epi::PERM ? ((R & ~31) + perm32(R & 31)) : R;
        voffA[i] = (unsigned)(R * K + C) * 2u; voffB[i] = (unsigned)(Rb * K + C) * 2u; }
    const size_t kstep = (size_t)(BK * 2);
    const size_t hstep = (size_t)HALF * K * 2;
    const size_t tstep = 2 * hstep;
    const unsigned ldsw = (unsigned)wid * 1024u;
    const int aoff = lds_byte(wr * 64 + fr, fq * 8), boff = lds_byte(wc * 32 + fr, fq * 8);
#define PG8_SA(b, h) (((b) * 2 + (h)) * HTB)
#define PG8_SB(b, h) ((4 + (b) * 2 + (h)) * HTB)
#define PG8_STAGE(bufoff, gbase, voff) do { _Pragma("unroll") for (int _i = 0; _i < 2; ++_i) \
        __builtin_amdgcn_global_load_lds((const unsigned*)((const char*)(gbase) + (voff)[_i]), (PG8_LAS unsigned*)(lds + (bufoff) + ldsw + _i * 8192), 16, 0, 0); } while (0)
#define PG8_LDA(dst, b, h) do { _Pragma("unroll") for (int m = 0; m < 4; ++m) _Pragma("unroll") for (int k = 0; k < 2; ++k) dst[m][k] = *(const PG8_LAS bf16x8*)(lds + PG8_SA(b, h) + aoff + m * 2048 + k * 1024); } while (0)
#define PG8_LDB(dst, b, h) do { _Pragma("unroll") for (int n = 0; n < 2; ++n) _Pragma("unroll") for (int k = 0; k < 2; ++k) dst[n][k] = *(const PG8_LAS bf16x8*)(lds + PG8_SB(b, h) + boff + n * 2048 + k * 1024); } while (0)
#define PG8_MMA(ai, bj, At, Bt) do { __builtin_amdgcn_s_setprio(1); _Pragma("unroll") for (int m = 0; m < 4; ++m) _Pragma("unroll") for (int n = 0; n < 2; ++n) _Pragma("unroll") for (int k = 0; k < 2; ++k) \
        acc[ai][bj][m][n] = __builtin_amdgcn_mfma_f32_16x16x32_bf16(Bt[n][k], At[m][k], acc[ai][bj][m][n], 0, 0, 0); __builtin_amdgcn_s_setprio(0); } while (0)
#define PG8_WAIT_V(n) asm volatile("s_waitcnt vmcnt(" #n ")" ::: "memory")
#define PG8_WAIT_L(n) asm volatile("s_waitcnt lgkmcnt(" #n ")" ::: "memory")
#define PG8_BAR __builtin_amdgcn_s_barrier()
#define PG8_SCHED __builtin_amdgcn_sched_barrier(0)
    Unit cur, nxt; int ui = 0;
    if (!S.next(0, cur)) return;
    f32x4 acc[2][2][4][2];
#pragma unroll
    for (int a = 0; a < 2; ++a)
#pragma unroll
        for (int b = 0; b < 2; ++b)
#pragma unroll
            for (int m = 0; m < 4; ++m)
#pragma unroll
                for (int n = 0; n < 2; ++n) acc[a][b][m][n] = (f32x4){0.f, 0.f, 0.f, 0.f};
    bf16x8 At[4][2], B0[2][2], B1[2][2];
    const char* cA = (const char*)g.A + (size_t)cur.pm * tstep; const char* cB = (const char*)g.Bt + (size_t)cur.pn * tstep;
    S.a_ready(cur);
    if constexpr (SP2) {
        PG8_STAGE(PG8_SB(0, 0), cB, voffB); PG8_STAGE(PG8_SB(0, 1), cB + hstep, voffB); PG8_STAGE(PG8_SA(0, 0), cA, voffA); PG8_STAGE(PG8_SA(0, 1), cA + hstep, voffA);
        if (wr == 1) PG8_BAR;
        PG8_WAIT_V(2); PG8_BAR;
        PG8_STAGE(PG8_SB(1, 0), cB + kstep, voffB); PG8_STAGE(PG8_SA(1, 0), cA + kstep, voffA); PG8_STAGE(PG8_SB(1, 1), cB + hstep + kstep, voffB);
        PG8_WAIT_V(6); PG8_BAR;
    } else {
        PG8_STAGE(PG8_SB(0, 0), cB, voffB); PG8_STAGE(PG8_SA(0, 0), cA, voffA); PG8_STAGE(PG8_SB(0, 1), cB + hstep, voffB); PG8_STAGE(PG8_SA(0, 1), cA + hstep, voffA);
        if (wr == 1) PG8_BAR;
        PG8_WAIT_V(4); PG8_BAR;
        PG8_STAGE(PG8_SB(1, 0), cB + kstep, voffB); PG8_STAGE(PG8_SA(1, 0), cA + kstep, voffA); PG8_STAGE(PG8_SB(1, 1), cB + hstep + kstep, voffB);
        PG8_WAIT_V(6); PG8_BAR;
    }
    for (;;) {
        const bool has_next = S.next(ui + 1, nxt);
        const char* nA = has_next ? (const char*)g.A + (size_t)nxt.pm * tstep : cA; const char* nB = has_next ? (const char*)g.Bt + (size_t)nxt.pn * tstep : cB;
        for (int t = 0; t < nt; t += 2) {
            const bool last = (t == nt - 2);
            const char* a1 = cA + (size_t)(t + 1) * kstep;
            const char* a2 = last ? nA : cA + (size_t)(t + 2) * kstep; const char* b2 = last ? nB : cB + (size_t)(t + 2) * kstep;
            const char* a3 = a2 + kstep; const char* b3 = b2 + kstep;
            if (last && has_next) S.a_ready(nxt);
            if constexpr (SP2) {
            PG8_LDB(B0, 0, 0); PG8_LDB(B1, 0, 1); PG8_SCHED; PG8_LDA(At, 0, 0); PG8_STAGE(PG8_SA(1, 1), a1 + hstep, voffA);
            PG8_WAIT_V(8); PG8_WAIT_L(0); PG8_BAR; PG8_MMA(0, 0, At, B0); PG8_MMA(0, 1, At, B1); PG8_BAR; PG8_SCHED;
            PG8_LDA(At, 0, 1); PG8_STAGE(PG8_SB(0, 0), b2, voffB); PG8_STAGE(PG8_SB(0, 1), b2 + hstep, voffB); PG8_STAGE(PG8_SA(0, 0), a2, voffA);
            PG8_WAIT_V(8); PG8_WAIT_L(0); PG8_BAR; PG8_MMA(1, 0, At, B0); PG8_MMA(1, 1, At, B1); PG8_BAR; PG8_SCHED;
            PG8_LDB(B0, 1, 0); PG8_LDB(B1, 1, 1); PG8_SCHED; PG8_LDA(At, 1, 0); PG8_STAGE(PG8_SA(0, 1), a2 + hstep, voffA);
            PG8_WAIT_V(8); PG8_WAIT_L(0); PG8_BAR; PG8_MMA(0, 0, At, B0); PG8_MMA(0, 1, At, B1); PG8_BAR; PG8_SCHED;
            PG8_LDA(At, 1, 1); PG8_STAGE(PG8_SB(1, 0), b3, voffB); PG8_STAGE(PG8_SB(1, 1), b3 + hstep, voffB); PG8_STAGE(PG8_SA(1, 0), a3, voffA);
            PG8_WAIT_V(8); PG8_WAIT_L(0); PG8_BAR; PG8_MMA(1, 0, At, B0); PG8_MMA(1, 1, At, B1); PG8_BAR; PG8_SCHED;
            } else {
            PG8_LDB(B0, 0, 0); PG8_SCHED; PG8_LDA(At, 0, 0); PG8_STAGE(PG8_SA(1, 1), a1 + hstep, voffA);
            PG8_WAIT_L(8); PG8_BAR; PG8_WAIT_L(0); PG8_MMA(0, 0, At, B0); PG8_BAR; PG8_SCHED;
            PG8_LDB(B1, 0, 1); PG8_STAGE(PG8_SB(0, 0), b2, voffB);
            PG8_BAR; PG8_WAIT_L(0); PG8_MMA(0, 1, At, B1); PG8_BAR;
            PG8_LDA(At, 0, 1); PG8_STAGE(PG8_SA(0, 0), a2, voffA);
            PG8_BAR; PG8_WAIT_L(0); PG8_MMA(1, 0, At, B0); PG8_BAR; PG8_SCHED;
            PG8_STAGE(PG8_SB(0, 1), b2 + hstep, voffB);
            PG8_WAIT_V(6); PG8_BAR; PG8_MMA(1, 1, At, B1); PG8_BAR;
            PG8_LDB(B0, 1, 0); PG8_SCHED; PG8_LDA(At, 1, 0); PG8_STAGE(PG8_SA(0, 1), a2 + hstep, voffA);
            PG8_WAIT_L(8); PG8_BAR; PG8_WAIT_L(0); PG8_MMA(0, 0, At, B0); PG8_BAR; PG8_SCHED;
            PG8_LDB(B1, 1, 1); PG8_STAGE(PG8_SB(1, 0), b3, voffB);
            PG8_BAR; PG8_WAIT_L(0); PG8_MMA(0, 1, At, B1); PG8_BAR;
            PG8_LDA(At, 1, 1); PG8_STAGE(PG8_SA(1, 0), a3, voffA);
            PG8_BAR; PG8_WAIT_L(0); PG8_MMA(1, 0, At, B0); PG8_BAR; PG8_SCHED;
            PG8_STAGE(PG8_SB(1, 1), b3 + hstep, voffB);
            PG8_WAIT_V(6); PG8_BAR; PG8_MMA(1, 1, At, B1); PG8_BAR;
            }
        }
        if constexpr (ALIGN_EPI) { if (wr == 0) PG8_BAR; }
        if constexpr (!Epi::AFTER_DRAIN) { E(acc, cur, wr, wc, fr, fq); S.done(cur); }
        if (!has_next) break;
#pragma unroll
        for (int a = 0; a < 2; ++a)
#pragma unroll
            for (int b = 0; b < 2; ++b)
#pragma unroll
                for (int m = 0; m < 4; ++m)
#pragma unroll
                    for (int n = 0; n < 2; ++n) acc[a][b][m][n] = (f32x4){0.f, 0.f, 0.f, 0.f};
        cur = nxt; cA = nA; cB = nB; ++ui;
        if constexpr (ALIGN_EPI) { if (wr == 1) PG8_BAR; }
    }
    PG8_WAIT_V(0);
    if constexpr (!ALIGN_EPI) { if (wr == 0) PG8_BAR; }
    PG8_BAR;
    if constexpr (Epi::AFTER_DRAIN) { E.fused(acc, cur, wr, wc, fr, fq, lds, wid, lane); S.done(cur); }
#undef PG8_SA
#undef PG8_SB
#undef PG8_STAGE
#undef PG8_LDA
#undef PG8_LDB
#undef PG8_MMA
#undef PG8_WAIT_V
#undef PG8_WAIT_L
#undef PG8_BAR
#undef PG8_SCHED
}
}

#ifndef PG8_SP2
#define PG8_SP2 true
#endif
#ifndef PG8_ALIGN
#define PG8_ALIGN true
#endif
#include <hip/hip_bf16.h>
#include <cmath>
namespace dattn {
using bf16=__hip_bfloat16;
using bf16x8=__attribute__((ext_vector_type(8)))short;
using s16x4=__attribute__((ext_vector_type(4)))short;
using f32x16=__attribute__((ext_vector_type(16)))float;
using u32x4=__attribute__((ext_vector_type(4)))unsigned;
using u32x2=__attribute__((ext_vector_type(2)))unsigned;
constexpr int SEQ=8192,DM=3072,QB=256,NSLOT=4,KSLOT=8192,VSLOT=16384;
constexpr int LDS_K=0,LDS_V=NSLOT*KSLOT,LDS_END=LDS_V+NSLOT*VSLOT;
constexpr int OST_ROW=272,OST_WAVE=32*OST_ROW;
static_assert(8*OST_WAVE<=LDS_END,"O staging fits over the rings");
typedef __attribute__((address_space(3))) const char* lds_cptr;
typedef __attribute__((address_space(3))) char* lds_ptr;
typedef short v4i16_t __attribute__((ext_vector_type(4)));
__device__ __forceinline__ void glds16(const void*gsrc,unsigned lds_dst){unsigned keep;
  asm volatile("s_mov_b32 %0, m0\n\ts_mov_b32 m0, %2\n\ts_nop 0\n\tglobal_load_lds_dwordx4 %1, off\n\ts_mov_b32 m0, %0":"=&s"(keep):"v"(gsrc),"s"(lds_dst):"memory");}
__device__ __forceinline__ s16x4 vtr(lds_cptr p){ return __builtin_bit_cast(s16x4,__builtin_amdgcn_ds_read_tr16_b64_v4i16((__attribute__((address_space(3))) v4i16_t*)p)); }
typedef float f32x2_t __attribute__((ext_vector_type(2))); typedef __bf16 bf16x2_t __attribute__((ext_vector_type(2)));
__device__ __forceinline__ unsigned cvtpk_s(float lo,float hi){f32x2_t v={lo,hi};bf16x2_t b=__builtin_convertvector(v,bf16x2_t);return __builtin_bit_cast(unsigned,b);}
#define DWAIT_BAR(N) asm volatile("s_waitcnt vmcnt(" #N ") lgkmcnt(0)\n\ts_barrier":::"memory")
__device__ __forceinline__ void unit(int b,int qb,const bf16*Q,const bf16*__restrict__ K,const bf16*__restrict__ V,bf16*O,int opitch,char*shm){
  const int tid=threadIdx.x,lane=tid&63,r32=lane&31,hi=lane>>5; const int wid=__builtin_amdgcn_readfirstlane(tid>>6);
  const long rowbase=(long)b*SEQ; const int q0=qb*QB;
  const bf16*Qw=Q+(rowbase+q0+wid*32)*DM;
  const unsigned lds0=(unsigned)(uintptr_t)shm;
  const bf16*ksrc=K+rowbase*DM+(long)lane*DM+wid*8;
  const bf16*vsrc=V+rowbase*DM+(long)(16*(wid&3)+(lane>>2))*DM+(wid>>2)*32+(lane&3)*8;
  const unsigned kdst=lds0+LDS_K+wid*1024,vdst=lds0+LDS_V+wid*1024;
  #define DDMA(t,sl) do{ glds16(ksrc+(long)(t)*64*DM,(unsigned)__builtin_amdgcn_readfirstlane(kdst+(sl)*KSLOT)); \
      glds16(vsrc+(long)(t)*64*DM,(unsigned)__builtin_amdgcn_readfirstlane(vdst+(sl)*VSLOT)); \
      glds16(vsrc+(long)(t)*64*DM+64,(unsigned)__builtin_amdgcn_readfirstlane(vdst+(sl)*VSLOT+8192)); }while(0)
  #define SBARR() do{}while(0)
  #define DVRD(dst,vp_,cb_) do{ _Pragma("unroll") for(int c_=0;c_<4;++c_){ dst[2*c_]=vtr((vp_)+((cb_)>>1)*8192+((cb_)&1)*4096+c_*1024); dst[2*c_+1]=vtr((vp_)+((cb_)>>1)*8192+((cb_)&1)*4096+c_*1024+512); } }while(0)
  #define DVF(src,c_) (bf16x8){src[2*(c_)][0],src[2*(c_)][1],src[2*(c_)][2],src[2*(c_)][3],src[2*(c_)+1][0],src[2*(c_)+1][1],src[2*(c_)+1][2],src[2*(c_)+1][3]}
  #define DPV(src,cb_) do{ o[cb_]=__builtin_amdgcn_mfma_f32_32x32x16_bf16(DVF(src,0),pw[0],o[cb_],0,0,0); o[cb_]=__builtin_amdgcn_mfma_f32_32x32x16_bf16(DVF(src,1),pw[1],o[cb_],0,0,0); \
      o[cb_]=__builtin_amdgcn_mfma_f32_32x32x16_bf16(DVF(src,2),pw[2],o[cb_],0,0,0); o[cb_]=__builtin_amdgcn_mfma_f32_32x32x16_bf16(DVF(src,3),pw[3],o[cb_],0,0,0); }while(0)
  #define PV_PLAIN(vp_) do{ DPV(va,0); DVRD(va,vp_,2); DPV(vb,1); DVRD(vb,vp_,3); DPV(va,2); DPV(vb,3); }while(0)
  #define EXPS_PLAIN() do{ float ls0=0.f,ls1=0.f; \
      _Pragma("unroll") for(int r=0;r<16;++r){ p0[r]=__builtin_amdgcn_exp2f(p0[r]-mref); ls0+=p0[r]; p1[r]=__builtin_amdgcn_exp2f(p1[r]-mref); ls1+=p1[r]; } l+=ls0+ls1; \
      u32x4 w0,w1,w2,w3; w0.x=cvtpk_s(p0[0],p0[1]);w0.y=cvtpk_s(p0[2],p0[3]);w0.z=cvtpk_s(p0[4],p0[5]);w0.w=cvtpk_s(p0[6],p0[7]); \
      w1.x=cvtpk_s(p0[8],p0[9]);w1.y=cvtpk_s(p0[10],p0[11]);w1.z=cvtpk_s(p0[12],p0[13]);w1.w=cvtpk_s(p0[14],p0[15]); \
      w2.x=cvtpk_s(p1[0],p1[1]);w2.y=cvtpk_s(p1[2],p1[3]);w2.z=cvtpk_s(p1[4],p1[5]);w2.w=cvtpk_s(p1[6],p1[7]); \
      w3.x=cvtpk_s(p1[8],p1[9]);w3.y=cvtpk_s(p1[10],p1[11]);w3.z=cvtpk_s(p1[12],p1[13]);w3.w=cvtpk_s(p1[14],p1[15]); \
      pw[0]=__builtin_bit_cast(bf16x8,w0);pw[1]=__builtin_bit_cast(bf16x8,w1);pw[2]=__builtin_bit_cast(bf16x8,w2);pw[3]=__builtin_bit_cast(bf16x8,w3); }while(0)
  const int NT=(q0+QB)/64;
  DDMA(0,0); DDMA(1,1);
  bf16x8 qr[4];
  #pragma unroll
  for(int d0=0;d0<4;++d0)qr[d0]=*reinterpret_cast<const bf16x8*>(&Qw[(long)r32*DM+d0*16+hi*8]);
  asm volatile("":"+v"(qr[0]),"+v"(qr[1]),"+v"(qr[2]),"+v"(qr[3]));
  const lds_cptr shm3=(lds_cptr)shm;
  const lds_cptr kp0=shm3+LDS_K+hi*1024+r32*16;
  const lds_cptr vp0=shm3+LDS_V+((lane>>4)&1)*32+(lane&3)*8+(4*hi+((lane&15)>>2))*64;
  f32x16 o[4]; o[0]=f32x16{};o[1]=f32x16{};o[2]=f32x16{};o[3]=f32x16{};
  float mref=-1e30f,l=0.f;
  const int qfirst=q0+wid*32, qme=qfirst+r32;
  const int TI=(qfirst+1)>>6;
  int t=0;
  bf16x8 pw[4]; pw[0]=bf16x8{};pw[1]=bf16x8{};pw[2]=bf16x8{};pw[3]=bf16x8{};
  for(;t<TI;++t){
    const int slot=t&3;
    if(t+1<NT){DWAIT_BAR(3);}else{DWAIT_BAR(0);}
    if(t+2<NT){ DDMA(t+2,(t+2)&3); }
    const lds_cptr kp=kp0+slot*KSLOT; const lds_cptr vpp=vp0+((t?t-1:0)&3)*VSLOT;
    bf16x8 kf[8];
    #pragma unroll
    for(int d0=0;d0<4;++d0){ kf[2*d0]=*(const __attribute__((address_space(3))) bf16x8*)(kp+d0*2048); kf[2*d0+1]=*(const __attribute__((address_space(3))) bf16x8*)(kp+d0*2048+512); }
    s16x4 va[8],vb[8];
    f32x16 p0=f32x16{},p1=f32x16{};
    #pragma unroll
    for(int d0=0;d0<4;++d0){ p0=__builtin_amdgcn_mfma_f32_32x32x16_bf16(kf[2*d0],qr[d0],p0,0,0,0); p1=__builtin_amdgcn_mfma_f32_32x32x16_bf16(kf[2*d0+1],qr[d0],p1,0,0,0); }
    DVRD(va,vpp,0); DVRD(vb,vpp,1);
    float mt=__builtin_fmaxf(__builtin_fmaxf(p0[0],p0[1]),__builtin_fmaxf(p1[0],p1[1]));
    #pragma unroll
    for(int r=2;r<16;r+=2){ mt=__builtin_fmaxf(mt,__builtin_fmaxf(p0[r],p0[r+1])); mt=__builtin_fmaxf(mt,__builtin_fmaxf(p1[r],p1[r+1])); }
    { auto rr=__builtin_amdgcn_permlane32_swap(__float_as_uint(mt),__float_as_uint(mt),false,false); mt=__builtin_fmaxf(__uint_as_float(rr[0]),__uint_as_float(rr[1])); }
    if(__any(mt>mref+8.0f)){
      PV_PLAIN(vpp);
      const float mnew=__builtin_fmaxf(mref,mt); const float alpha=__builtin_amdgcn_exp2f(mref-mnew);
      #pragma unroll
      for(int cb=0;cb<4;++cb)o[cb]=o[cb]*alpha;
      l*=alpha; mref=mnew;
      pw[0]=bf16x8{};pw[1]=bf16x8{};pw[2]=bf16x8{};pw[3]=bf16x8{};
      DVRD(va,vpp,0); DVRD(vb,vpp,1);
    }
    {
      SBARR();
        float ls0=0.f,ls1=0.f;
        o[0]=__builtin_amdgcn_mfma_f32_32x32x16_bf16(DVF(va,0),pw[0],o[0],0,0,0);
        p0[0]=__builtin_amdgcn_exp2f(p0[0]-mref); p0[1]=__builtin_amdgcn_exp2f(p0[1]-mref); ls0+=p0[0]+p0[1];
        SBARR();
        o[0]=__builtin_amdgcn_mfma_f32_32x32x16_bf16(DVF(va,1),pw[1],o[0],0,0,0);
        p0[2]=__builtin_amdgcn_exp2f(p0[2]-mref); p0[3]=__builtin_amdgcn_exp2f(p0[3]-mref); ls0+=p0[2]+p0[3];
        SBARR();
        o[0]=__builtin_amdgcn_mfma_f32_32x32x16_bf16(DVF(va,2),pw[2],o[0],0,0,0);
        p0[4]=__builtin_amdgcn_exp2f(p0[4]-mref); p0[5]=__builtin_amdgcn_exp2f(p0[5]-mref); ls0+=p0[4]+p0[5];
        SBARR();
        o[0]=__builtin_amdgcn_mfma_f32_32x32x16_bf16(DVF(va,3),pw[3],o[0],0,0,0);
        p0[6]=__builtin_amdgcn_exp2f(p0[6]-mref); p0[7]=__builtin_amdgcn_exp2f(p0[7]-mref); ls0+=p0[6]+p0[7];
        DVRD(va,vpp,2);
        SBARR();
        o[1]=__builtin_amdgcn_mfma_f32_32x32x16_bf16(DVF(vb,0),pw[0],o[1],0,0,0);
        p0[8]=__builtin_amdgcn_exp2f(p0[8]-mref); p0[9]=__builtin_amdgcn_exp2f(p0[9]-mref); ls0+=p0[8]+p0[9];
        SBARR();
        o[1]=__builtin_amdgcn_mfma_f32_32x32x16_bf16(DVF(vb,1),pw[1],o[1],0,0,0);
        p0[10]=__builtin_amdgcn_exp2f(p0[10]-mref); p0[11]=__builtin_amdgcn_exp2f(p0[11]-mref); ls0+=p0[10]+p0[11];
        SBARR();
        o[1]=__builtin_amdgcn_mfma_f32_32x32x16_bf16(DVF(vb,2),pw[2],o[1],0,0,0);
        p0[12]=__builtin_amdgcn_exp2f(p0[12]-mref); p0[13]=__builtin_amdgcn_exp2f(p0[13]-mref); ls0+=p0[12]+p0[13];
        SBARR();
        o[1]=__builtin_amdgcn_mfma_f32_32x32x16_bf16(DVF(vb,3),pw[3],o[1],0,0,0);
        p0[14]=__builtin_amdgcn_exp2f(p0[14]-mref); p0[15]=__builtin_amdgcn_exp2f(p0[15]-mref); ls0+=p0[14]+p0[15];
        DVRD(vb,vpp,3);
        SBARR();
        o[2]=__builtin_amdgcn_mfma_f32_32x32x16_bf16(DVF(va,0),pw[0],o[2],0,0,0);
        p1[0]=__builtin_amdgcn_exp2f(p1[0]-mref); p1[1]=__builtin_amdgcn_exp2f(p1[1]-mref); ls1+=p1[0]+p1[1];
        SBARR();
        o[2]=__builtin_amdgcn_mfma_f32_32x32x16_bf16(DVF(va,1),pw[1],o[2],0,0,0);
        p1[2]=__builtin_amdgcn_exp2f(p1[2]-mref); p1[3]=__builtin_amdgcn_exp2f(p1[3]-mref); ls1+=p1[2]+p1[3];
        SBARR();
        o[2]=__builtin_amdgcn_mfma_f32_32x32x16_bf16(DVF(va,2),pw[2],o[2],0,0,0);
        p1[4]=__builtin_amdgcn_exp2f(p1[4]-mref); p1[5]=__builtin_amdgcn_exp2f(p1[5]-mref); ls1+=p1[4]+p1[5];
        SBARR();
        o[2]=__builtin_amdgcn_mfma_f32_32x32x16_bf16(DVF(va,3),pw[3],o[2],0,0,0);
        p1[6]=__builtin_amdgcn_exp2f(p1[6]-mref); p1[7]=__builtin_amdgcn_exp2f(p1[7]-mref); ls1+=p1[6]+p1[7];
        SBARR();
        o[3]=__builtin_amdgcn_mfma_f32_32x32x16_bf16(DVF(vb,0),pw[0],o[3],0,0,0);
        p1[8]=__builtin_amdgcn_exp2f(p1[8]-mref); p1[9]=__builtin_amdgcn_exp2f(p1[9]-mref); ls1+=p1[8]+p1[9];
        SBARR();
        o[3]=__builtin_amdgcn_mfma_f32_32x32x16_bf16(DVF(vb,1),pw[1],o[3],0,0,0);
        p1[10]=__builtin_amdgcn_exp2f(p1[10]-mref); p1[11]=__builtin_amdgcn_exp2f(p1[11]-mref); ls1+=p1[10]+p1[11];
        SBARR();
        o[3]=__builtin_amdgcn_mfma_f32_32x32x16_bf16(DVF(vb,2),pw[2],o[3],0,0,0);
        p1[12]=__builtin_amdgcn_exp2f(p1[12]-mref); p1[13]=__builtin_amdgcn_exp2f(p1[13]-mref); ls1+=p1[12]+p1[13];
        SBARR();
        o[3]=__builtin_amdgcn_mfma_f32_32x32x16_bf16(DVF(vb,3),pw[3],o[3],0,0,0);
        p1[14]=__builtin_amdgcn_exp2f(p1[14]-mref); p1[15]=__builtin_amdgcn_exp2f(p1[15]-mref); ls1+=p1[14]+p1[15];
        SBARR();
        l+=ls0+ls1;
        { u32x4 w0,w1,w2,w3; w0.x=cvtpk_s(p0[0],p0[1]);w0.y=cvtpk_s(p0[2],p0[3]);w0.z=cvtpk_s(p0[4],p0[5]);w0.w=cvtpk_s(p0[6],p0[7]);
          w1.x=cvtpk_s(p0[8],p0[9]);w1.y=cvtpk_s(p0[10],p0[11]);w1.z=cvtpk_s(p0[12],p0[13]);w1.w=cvtpk_s(p0[14],p0[15]);
          w2.x=cvtpk_s(p1[0],p1[1]);w2.y=cvtpk_s(p1[2],p1[3]);w2.z=cvtpk_s(p1[4],p1[5]);w2.w=cvtpk_s(p1[6],p1[7]);
          w3.x=cvtpk_s(p1[8],p1[9]);w3.y=cvtpk_s(p1[10],p1[11]);w3.z=cvtpk_s(p1[12],p1[13]);w3.w=cvtpk_s(p1[14],p1[15]);
          pw[0]=__builtin_bit_cast(bf16x8,w0);pw[1]=__builtin_bit_cast(bf16x8,w1);pw[2]=__builtin_bit_cast(bf16x8,w2);pw[3]=__builtin_bit_cast(bf16x8,w3); }
    }
  }
  if(TI>0){ const lds_cptr vpp=vp0+((t+3)&3)*VSLOT; s16x4 va[8],vb[8]; DVRD(va,vpp,0); DVRD(vb,vpp,1); PV_PLAIN(vpp); }
  for(;t<NT;++t){
    const int slot=t&3;
    if(t+1<NT){DWAIT_BAR(3);}else{DWAIT_BAR(0);}
    if(t+2<NT){ DDMA(t+2,(t+2)&3); }
    const lds_cptr kp=kp0+slot*KSLOT; const lds_cptr vp=vp0+slot*VSLOT;
    #pragma unroll
    for(int s=0;s<2;++s){
      const int key0=64*t+32*s;
      if(key0>qfirst+31)continue;
      f32x16 p=f32x16{};
      #pragma unroll
      for(int d0=0;d0<4;++d0){ const bf16x8 kf=*(const __attribute__((address_space(3))) bf16x8*)(kp+d0*2048+s*512); p=__builtin_amdgcn_mfma_f32_32x32x16_bf16(kf,qr[d0],p,0,0,0); }
      if(key0+31>qfirst){
        #pragma unroll
        for(int r=0;r<16;++r){ const int kv=key0+(r&3)+8*(r>>2)+4*hi; if(kv>qme)p[r]=-INFINITY; } }
      float mt=__builtin_fmaxf(p[0],p[1]);
      #pragma unroll
      for(int r=2;r<16;++r)mt=__builtin_fmaxf(mt,p[r]);
      { auto rr=__builtin_amdgcn_permlane32_swap(__float_as_uint(mt),__float_as_uint(mt),false,false); mt=__builtin_fmaxf(__uint_as_float(rr[0]),__uint_as_float(rr[1])); }
      if(__any(mt>mref+8.0f)){
        const float mnew=__builtin_fmaxf(mref,mt); const float alpha=__builtin_amdgcn_exp2f(mref-mnew);
        #pragma unroll
        for(int cb=0;cb<4;++cb)o[cb]=o[cb]*alpha;
        l*=alpha; mref=mnew; }
      float ls=0.f;
      #pragma unroll
      for(int r=0;r<16;++r){ p[r]=__builtin_amdgcn_exp2f(p[r]-mref); ls+=p[r]; }
      l+=ls;
      u32x4 w0,w1; w0.x=cvtpk_s(p[0],p[1]);w0.y=cvtpk_s(p[2],p[3]);w0.z=cvtpk_s(p[4],p[5]);w0.w=cvtpk_s(p[6],p[7]);
      w1.x=cvtpk_s(p[8],p[9]);w1.y=cvtpk_s(p[10],p[11]);w1.z=cvtpk_s(p[12],p[13]);w1.w=cvtpk_s(p[14],p[15]);
      const bf16x8 pb0=__builtin_bit_cast(bf16x8,w0),pb1=__builtin_bit_cast(bf16x8,w1);
      #pragma unroll
      for(int cb=0;cb<4;++cb){
        const int off=(cb>>1)*8192+(cb&1)*4096+(2*s)*1024;
        const s16x4 a0=vtr(vp+off),a1=vtr(vp+off+512),c0=vtr(vp+off+1024),c1=vtr(vp+off+1536);
        const bf16x8 v0=(bf16x8){a0[0],a0[1],a0[2],a0[3],a1[0],a1[1],a1[2],a1[3]},v1=(bf16x8){c0[0],c0[1],c0[2],c0[3],c1[0],c1[1],c1[2],c1[3]};
        o[cb]=__builtin_amdgcn_mfma_f32_32x32x16_bf16(v0,pb0,o[cb],0,0,0);
        o[cb]=__builtin_amdgcn_mfma_f32_32x32x16_bf16(v1,pb1,o[cb],0,0,0); }
    }

  }
  { auto rr=__builtin_amdgcn_permlane32_swap(__float_as_uint(l),__float_as_uint(l),false,false); l=__uint_as_float(rr[0])+__uint_as_float(rr[1]); }
  const float inv=__builtin_amdgcn_rcpf(l);
  DWAIT_BAR(0);
  const lds_ptr stg=(lds_ptr)shm+wid*OST_WAVE;
  #pragma unroll
  for(int cb=0;cb<4;++cb)
    #pragma unroll
    for(int g=0;g<4;++g){ u32x2 w; w.x=cvtpk_s(o[cb][4*g]*inv,o[cb][4*g+1]*inv); w.y=cvtpk_s(o[cb][4*g+2]*inv,o[cb][4*g+3]*inv);
      *(__attribute__((address_space(3))) u32x2*)(stg+r32*OST_ROW+(32*cb+8*g+4*hi)*2)=w; }
  asm volatile("s_waitcnt lgkmcnt(0)":::"memory");
  bf16*Ow=O+(rowbase+q0+wid*32)*(long)opitch;
  #pragma unroll
  for(int i=0;i<8;++i){ const int row=i*4+(lane>>4),ch=lane&15; const u32x4 v=*(const __attribute__((address_space(3))) u32x4*)(stg+row*OST_ROW+ch*16); *(u32x4*)(Ow+(long)row*opitch+ch*8)=v; }
  asm volatile("s_waitcnt lgkmcnt(0)\n\ts_barrier":::"memory");
  #undef DDMA
  #undef SBARR
  #undef DVRD
  #undef DVF
  #undef DPV
  #undef PV_PLAIN
  #undef EXPS_PLAIN
}
struct DiffUnit { int bh; int qb; int m; };
struct DiffOrder {
  int vcu, G;
  __device__ __forceinline__ DiffOrder(int vcu_,int G_):vcu(vcu_),G(G_){}
  __device__ __forceinline__ bool next(int i,DiffUnit&u)const{
    const int ii=i>>1; u.m=i&1;
    if(G==256){ if(i>=4)return false; const int s=vcu&15; u.bh=vcu>>4; u.qb=ii?31-s:s; return true; }
    const int un=vcu+ii*G; if(un>=512)return false; u.bh=un>>5; u.qb=un&31; return true; }
};
__device__ __forceinline__ void diff_phase(char*shm,const unsigned short*PROJ,unsigned short*OA,const DiffOrder&S){
  DiffUnit u;
  for(int i=0;S.next(i,u);++i){
    const int h=u.bh&7;
    const bf16*Qp=(const bf16*)PROJ+h*128+u.m*64;
    unit(u.bh>>3,u.qb,Qp,Qp+1024,(const bf16*)PROJ+2048+h*128,u.m?((bf16*)PROJ+h*128):((bf16*)OA+h*128),u.m?DM:1024,shm);
  }
}
__device__ __forceinline__ float bflo(unsigned w){return __builtin_bit_cast(float,w<<16);}
__device__ __forceinline__ float bfhi(unsigned w){return __builtin_bit_cast(float,w&0xffff0000u);}
__device__ __forceinline__ void diff_combine(const unsigned short*PROJ,unsigned short*OA,const DiffOrder&S,float lam){
  asm volatile("s_waitcnt vmcnt(0)":::"memory");
  int tid_=threadIdx.x; asm volatile("":"+v"(tid_));
  const int lane=tid_&63; const int wid=__builtin_amdgcn_readfirstlane(tid_>>6); const int c8=(lane&7)*8;
  DiffUnit u;
  for(int i=0;S.next(i,u);i+=2){
    const int h=u.bh&7; const long row0=(long)(u.bh>>3)*SEQ+u.qb*QB+wid*32+(lane>>3);
    #pragma unroll 1
    for(int it=0;it<4;++it){
      unsigned short*ma=OA+(row0+it*8)*1024+h*128+c8; const unsigned short*pb=PROJ+(row0+it*8)*DM+h*128+c8;
      const u32x4 a0=*(const u32x4*)ma,a1=*(const u32x4*)(ma+64),b0=*(const u32x4*)pb,b1=*(const u32x4*)(pb+64);
      float o0[8],o1[8]; float ss=0.f;
      #pragma unroll
      for(int k=0;k<4;++k){ o0[2*k]=bflo(a0[k])-lam*bflo(b0[k]); o0[2*k+1]=bfhi(a0[k])-lam*bfhi(b0[k]); o1[2*k]=bflo(a1[k])-lam*bflo(b1[k]); o1[2*k+1]=bfhi(a1[k])-lam*bfhi(b1[k]); }
      #pragma unroll
      for(int k=0;k<8;++k)ss+=o0[k]*o0[k]+o1[k]*o1[k];
      ss+=__shfl_xor(ss,1); ss+=__shfl_xor(ss,2); ss+=__shfl_xor(ss,4);
      const float rs=__builtin_amdgcn_rsqf(ss*(1.0f/128.0f)+1e-6f);
      u32x4 w0,w1;
      #pragma unroll
      for(int k=0;k<4;++k){ w0[k]=cvtpk_s(o0[2*k]*rs,o0[2*k+1]*rs); w1[k]=cvtpk_s(o1[2*k]*rs,o1[2*k+1]*rs); }
      *(u32x4*)ma=w0; *(u32x4*)(ma+64)=w1;
    }
  }
}
#undef DWAIT_BAR
}
#include <hip/hip_cooperative_groups.h>
namespace cg = cooperative_groups;
constexpr int NWAVES = 8;
constexpr int SEQ = 8192, DMOD = 1024, MTOK = 2 * SEQ, FF = 4096;
constexpr int P0W = 2560;
constexpr int P1W = 3072;
constexpr float QSCALE = 0.125f * 1.4426950408889634f;
constexpr float LAMBDA_INIT1 = 0.35550906f;
constexpr size_t MiB = 1u << 20;
constexpr size_t WS_CTL = 0, CTL_ZERO_BYTES = 1 * MiB;
constexpr size_t WS_SSQ = 65536;
constexpr size_t WS_W = 2 * MiB;
constexpr size_t W_IN = 0, W_OUT = 6 * MiB, W_UP = 8 * MiB, W_DOWN = 16 * MiB, W_LAYER = 24 * MiB;
constexpr size_t WS_XB = 50 * MiB;
constexpr size_t WS_PROJ = 82 * MiB;
constexpr size_t WS_VT = WS_PROJ + 80 * MiB;
constexpr size_t WS_MIX = 178 * MiB;
constexpr size_t WS_H = WS_PROJ;
constexpr size_t WS_END = 210 * MiB;
constexpr int RING_BYTES = 131072, LDS_BYTES = 147456;

#define GAS __attribute__((address_space(1)))
#define LAS __attribute__((address_space(3)))
typedef unsigned short bf16;
typedef unsigned v4u __attribute__((ext_vector_type(4)));
typedef float f32x4 __attribute__((ext_vector_type(4)));
typedef short bf16x8 __attribute__((ext_vector_type(8)));
typedef float f32x16 __attribute__((ext_vector_type(16)));
#define LDS_WAIT() asm volatile("s_waitcnt lgkmcnt(0)" ::: "memory")
__device__ __forceinline__ unsigned f2bf(float f) { unsigned u = __builtin_bit_cast(unsigned, f); return (u + 0x7fffu + ((u >> 16) & 1u)) >> 16; }
__device__ __forceinline__ unsigned pk2(float lo, float hi) { return f2bf(lo) | (f2bf(hi) << 16); }
__device__ __forceinline__ float bf_lo(unsigned w) { return __builtin_bit_cast(float, w << 16); }
__device__ __forceinline__ float bf_hi(unsigned w) { return __builtin_bit_cast(float, w & 0xffff0000u); }
__device__ __forceinline__ float wave_sum(float v) {
#pragma unroll
    for (int o = 1; o < 64; o <<= 1) v += __shfl_xor(v, o);
    return v;
}
__device__ __forceinline__ void x_rows2_to_bf16(const float* xrow, bf16* orow, float* ssq, int lane) {
    const GAS f32x4* xr = (const GAS f32x4*)xrow + lane;
    f32x4 v[8]; float s0 = 0.f, s1 = 0.f;
#pragma unroll
    for (int j = 0; j < 8; ++j) v[j] = __builtin_nontemporal_load(xr + 64 * j);
#pragma unroll
    for (int j = 0; j < 4; ++j) { s0 += (v[j].x * v[j].x + v[j].y * v[j].y) + (v[j].z * v[j].z + v[j].w * v[j].w); s1 += (v[4 + j].x * v[4 + j].x + v[4 + j].y * v[4 + j].y) + (v[4 + j].z * v[4 + j].z + v[4 + j].w * v[4 + j].w); }
    s0 = wave_sum(s0); s1 = wave_sum(s1); if (lane == 0) { ssq[0] = s0; ssq[1] = s1; }
    GAS unsigned long long* o8 = (GAS unsigned long long*)orow + lane;
#pragma unroll
    for (int j = 0; j < 8; ++j) o8[64 * j] = (unsigned long long)pk2(v[j].x, v[j].y) | ((unsigned long long)pk2(v[j].z, v[j].w) << 32);
}

__device__ __forceinline__ int swap23(int i) { return (i & ~12) | ((i & 4) << 1) | ((i & 8) >> 1); }
__device__ __forceinline__ unsigned cvtpk2(float lo, float hi) { typedef float f2 __attribute__((ext_vector_type(2))); typedef __bf16 b2 __attribute__((ext_vector_type(2))); f2 v = {lo, hi}; b2 b = __builtin_convertvector(v, b2); return __builtin_bit_cast(unsigned, b); }
__device__ __forceinline__ void sb_unit(int b, int h, int qb, const bf16* __restrict__ proj, const bf16* __restrict__ Vt, bf16* __restrict__ mix, LAS unsigned char* stage, int lane) {
    const int r32 = lane & 31, hi = lane >> 5;
    const size_t rowbase = (size_t)b * SEQ; const int t0 = qb * 32;
    const bf16* qp = proj + (rowbase + t0 + r32) * P0W + h * 64 + hi * 8;
    bf16x8 qr[4];
#pragma unroll
    for (int d0 = 0; d0 < 4; ++d0) qr[d0] = *(const bf16x8*)(qp + d0 * 16);
    const bf16* kbase = proj + (rowbase + swap23(r32)) * P0W + 512 + h * 64 + hi * 8;
    const bf16* vbase = Vt + (size_t)(h * 64 + r32) * MTOK + rowbase + hi * 8;
    f32x16 o0 = {}, o1 = {};
    float R = 0.f;
#define SB_LOAD(KF, VF, kt_) do { const bf16* kp = kbase + (size_t)(kt_) * 32 * P0W; const bf16* vp = vbase + (kt_) * 32; \
        _Pragma("unroll") for (int d0 = 0; d0 < 4; ++d0) KF[d0] = *(const bf16x8*)(kp + d0 * 16); \
        VF[0] = *(const bf16x8*)(vp); VF[1] = *(const bf16x8*)(vp + 16); VF[2] = *(const bf16x8*)(vp + (size_t)32 * MTOK); VF[3] = *(const bf16x8*)(vp + (size_t)32 * MTOK + 16); } while (0)
#define SB_COMPUTE(KF, VF, kt_) do { \
        f32x16 p = {}; \
        _Pragma("unroll") for (int d0 = 0; d0 < 4; ++d0) p = __builtin_amdgcn_mfma_f32_32x32x16_bf16(KF[d0], qr[d0], p, 0, 0, 0); \
        const bool diag = ((kt_) == qb); \
        float sp[16], lb[16]; \
        _Pragma("unroll") for (int r = 0; r < 16; ++r) { const float z = p[r]; const float e = __builtin_amdgcn_exp2f(-__builtin_fabsf(z)); const float l = __builtin_amdgcn_logf(1.0f + e); \
            sp[r] = __builtin_fmaxf(z, 0.f) + l; lb[r] = __builtin_fminf(z, 0.f) - l; \
            if (diag) { const int koff = (r & 7) + 8 * hi + 16 * (r >> 3); if (koff >= r32) { sp[r] = 0.f; lb[r] = -INFINITY; } } } \
        float ex[16], G0, G1; \
        { float run = 0.f; \
          _Pragma("unroll") for (int j = 7; j >= 0; --j) { ex[j] = run; run += sp[j]; } G0 = run; run = 0.f; \
          _Pragma("unroll") for (int j = 7; j >= 0; --j) { ex[8 + j] = run; run += sp[8 + j]; } G1 = run; } \
        const float Gp0 = __shfl_xor(G0, 32), Gp1 = __shfl_xor(G1, 32); \
        const float base1 = R + (hi ? 0.f : Gp1), base0 = R + G1 + Gp1 + (hi ? 0.f : Gp0); \
        float w[16]; \
        _Pragma("unroll") for (int r = 0; r < 16; ++r) w[r] = __builtin_amdgcn_exp2f(lb[r] - ((r < 8) ? base0 : base1) - ex[r]); \
        R += (G0 + G1) + (Gp0 + Gp1); \
        v4u a0, a1; a0.x = cvtpk2(w[0], w[1]); a0.y = cvtpk2(w[2], w[3]); a0.z = cvtpk2(w[4], w[5]); a0.w = cvtpk2(w[6], w[7]); \
        a1.x = cvtpk2(w[8], w[9]); a1.y = cvtpk2(w[10], w[11]); a1.z = cvtpk2(w[12], w[13]); a1.w = cvtpk2(w[14], w[15]); \
        const bf16x8 pa0 = __builtin_bit_cast(bf16x8, a0), pa1 = __builtin_bit_cast(bf16x8, a1); \
        o0 = __builtin_amdgcn_mfma_f32_32x32x16_bf16(pa0, VF[0], o0, 0, 0, 0); o0 = __builtin_amdgcn_mfma_f32_32x32x16_bf16(pa1, VF[1], o0, 0, 0, 0); \
        o1 = __builtin_amdgcn_mfma_f32_32x32x16_bf16(pa0, VF[2], o1, 0, 0, 0); o1 = __builtin_amdgcn_mfma_f32_32x32x16_bf16(pa1, VF[3], o1, 0, 0, 0); \
        done = __all(R > 151.0f) != 0; } while (0)
    bf16x8 kA[4], vA[4], kB[4], vB[4];
    SB_LOAD(kA, vA, qb);
#pragma unroll
    for (int d0 = 0; d0 < 4; ++d0) { kB[d0] = kA[d0]; vB[d0] = vA[d0]; }
    if (qb > 0) SB_LOAD(kB, vB, qb - 1);
    bool done = false;
    for (int kt = qb;; kt -= 2) {
        SB_COMPUTE(kA, vA, kt);
        if (done || kt < 1) break;
        if (kt >= 2) SB_LOAD(kA, vA, kt - 2);
        SB_COMPUTE(kB, vB, kt - 1);
        if (done || kt < 2) break;
        if (kt >= 3) SB_LOAD(kB, vB, kt - 3);
    }
#undef SB_LOAD
#undef SB_COMPUTE
    LAS bf16* stg = (LAS bf16*)stage;
#pragma unroll
    for (int r = 0; r < 16; ++r) { const int orow = (r & 3) + 8 * (r >> 2) + 4 * hi; stg[orow * 64 + r32] = (bf16)f2bf(o0[r]); stg[orow * 64 + 32 + r32] = (bf16)f2bf(o1[r]); }
    LDS_WAIT(); asm volatile("" ::: "memory");
    bf16* op = mix + (rowbase + t0) * 1024 + h * 64;
#pragma unroll
    for (int i = 0; i < 4; ++i) { const int row = i * 8 + (lane >> 3), ch = lane & 7; const v4u v = *(const LAS v4u*)(stg + row * 64 + ch * 8); *(v4u*)(op + (size_t)row * 1024 + ch * 8) = v; }
    LDS_WAIT(); asm volatile("" ::: "memory");
}
__device__ __forceinline__ void conv_items(const bf16* __restrict__ proj, const float* __restrict__ cw, bf16* __restrict__ mix, int gtid, int nthreads) {
    for (int it = gtid; it < (MTOK / 8) * 64; it += nthreads) {
        const int rb = it >> 6, ch = (it & 63) * 8, m0 = rb * 8;
        float w0[8], w1[8], w2[8], c2[8], c1[8];
#pragma unroll
        for (int i = 0; i < 8; ++i) { w0[i] = cw[ch + i]; w1[i] = cw[512 + ch + i]; w2[i] = cw[1024 + ch + i]; c2[i] = 0.f; c1[i] = 0.f; }
        if ((m0 & (SEQ - 1)) != 0) {
            const v4u Ca = *(const v4u*)(proj + (size_t)(m0 - 2) * P0W + 1536 + ch), Ua = *(const v4u*)(proj + (size_t)(m0 - 2) * P0W + 2048 + ch);
            const v4u Cb = *(const v4u*)(proj + (size_t)(m0 - 1) * P0W + 1536 + ch), Ub = *(const v4u*)(proj + (size_t)(m0 - 1) * P0W + 2048 + ch);
#pragma unroll
            for (int i = 0; i < 4; ++i) { c2[2 * i] = bf_lo(Ca[i]) * bf_lo(Ua[i]); c2[2 * i + 1] = bf_hi(Ca[i]) * bf_hi(Ua[i]); c1[2 * i] = bf_lo(Cb[i]) * bf_lo(Ub[i]); c1[2 * i + 1] = bf_hi(Cb[i]) * bf_hi(Ub[i]); }
        }
#pragma unroll
        for (int r = 0; r < 8; ++r) { const bf16* rp = proj + (size_t)(m0 + r) * P0W + ch;
            const v4u Bv = __builtin_nontemporal_load((const v4u*)(rp + 1024)), Cv = __builtin_nontemporal_load((const v4u*)(rp + 1536)), Uv = __builtin_nontemporal_load((const v4u*)(rp + 2048));
            float c0[8], y[8];
#pragma unroll
            for (int i = 0; i < 4; ++i) { c0[2 * i] = bf_lo(Cv[i]) * bf_lo(Uv[i]); c0[2 * i + 1] = bf_hi(Cv[i]) * bf_hi(Uv[i]); }
#pragma unroll
            for (int i = 0; i < 8; ++i) y[i] = w0[i] * c2[i] + w1[i] * c1[i] + w2[i] * c0[i];
            v4u o;
#pragma unroll
            for (int i = 0; i < 4; ++i) o[i] = pk2(bf_lo(Bv[i]) * y[2 * i], bf_hi(Bv[i]) * y[2 * i + 1]);
            *(v4u*)(mix + (size_t)(m0 + r) * 1024 + 512 + ch) = o;
#pragma unroll
            for (int i = 0; i < 8; ++i) { c2[i] = c1[i]; c1[i] = c0[i]; } }
    }
}

typedef GAS unsigned gu32;
#define RLX_AGENT __ATOMIC_RELAXED, __HIP_MEMORY_SCOPE_AGENT
constexpr int CW_PANEL = 8192;
constexpr int CW_BAR = 4096;
constexpr int LDSCTL_OFF = RING_BYTES, MISC_OFF = LDSCTL_OFF + 320;
#define XB_TMO      128
#define XB_XCNT(j)  (256  + 64 * (j))
#define XB_XSUB(j)  (1280 + 64 * (j))
#define XB_XGEN(j)  (2304 + 64 * (j))
#define XB_TOP      3328
#define XB_TOPGEN   3392
#define XCD_BAR_WORDS 3456
#define XB_SPIN_CAP (1u << 18)

__device__ __forceinline__ unsigned xb_ld(unsigned* p)              { return __hip_atomic_load(p, __ATOMIC_RELAXED, __HIP_MEMORY_SCOPE_AGENT); }
__device__ __forceinline__ unsigned xb_add(unsigned* p, unsigned v) { return __hip_atomic_fetch_add(p, v, __ATOMIC_RELAXED, __HIP_MEMORY_SCOPE_AGENT); }
__device__ __forceinline__ unsigned xb_xcc_id() { return (unsigned)__builtin_amdgcn_s_getreg((3 << 11) | 20) & 0xFu; }
#define XB_SPIN(cond, bar) do { unsigned _sp = 0; while (cond) { __builtin_amdgcn_s_sleep(1); \
    if ((++_sp & 255u) == 0u) { if (xb_ld(&(bar)[XB_TMO])) break; if (_sp > XB_SPIN_CAP) { atomicAdd(&(bar)[XB_TMO], 1u); break; } } } } while (0)

struct XcdBarrier {
    unsigned* bar; unsigned x;
    volatile LAS unsigned* st;
};

__device__ __forceinline__ XcdBarrier xcd_barrier_post(unsigned* bar, volatile LAS unsigned* st) {
    XcdBarrier b; b.bar = bar; b.x = xb_xcc_id(); b.st = st;
    if (threadIdx.x == 0) (void)xb_add(&bar[XB_XCNT(b.x)], 1u);
    return b;
}
__device__ __forceinline__ void xcd_barrier_complete(unsigned* bar, unsigned x, unsigned& nloc, unsigned& nx) {
    const unsigned G = gridDim.x * gridDim.y * gridDim.z;
    unsigned sum, cnt, mine, sp = 0u;
    for (;;) {
        sum = 0u; cnt = 0u; mine = 0u;
#pragma unroll
        for (unsigned j = 0; j < 16; ++j) { const unsigned c = xb_ld(&bar[XB_XCNT(j)]); sum += c; cnt += (c > 0u) ? 1u : 0u; mine = (j == x) ? c : mine; }
        if (sum == G) break;
        __builtin_amdgcn_s_sleep(1);
        if ((++sp & 255u) == 0u) { if (xb_ld(&bar[XB_TMO])) break; if (sp > XB_SPIN_CAP) { atomicAdd(&bar[XB_TMO], 1u); break; } }
    }
    nloc = mine > 0u ? mine : 1u; nx = cnt > 0u ? cnt : 1u;
}

__device__ __forceinline__ void xcd_barrier_thread0(const XcdBarrier& b) {
    {
        unsigned* bar = b.bar;
        __builtin_amdgcn_s_waitcnt(0);
        unsigned nloc = b.st[0], nx = b.st[1];
        if (nloc == 0u) { xcd_barrier_complete(bar, b.x, nloc, nx); b.st[0] = nloc; b.st[1] = nx; }
        const unsigned old = xb_add(&bar[XB_XSUB(b.x)], 1u);
        const unsigned gen = old / nloc;
        if (old + 1u == (gen + 1u) * nloc) {
            __builtin_amdgcn_fence(__ATOMIC_RELEASE, "agent");
            asm volatile("s_waitcnt vmcnt(0)" ::: "memory");
            const unsigned og = xb_add(&bar[XB_TOP], 1u);
            const unsigned tg = og / nx;
            if (og + 1u == (tg + 1u) * nx) xb_add(&bar[XB_TOPGEN], 1u);
            else XB_SPIN(xb_ld(&bar[XB_TOPGEN]) == tg, bar);
            __builtin_amdgcn_fence(__ATOMIC_ACQUIRE, "agent");
            xb_add(&bar[XB_XGEN(b.x)], 1u);
            asm volatile("s_waitcnt vmcnt(0)" ::: "memory");
        } else {
            XB_SPIN(xb_ld(&bar[XB_XGEN(b.x)]) == gen, bar);
            __builtin_amdgcn_fence(__ATOMIC_ACQUIRE, "agent");
            asm volatile("s_waitcnt vmcnt(0)" ::: "memory");
        }
    }
}
__device__ __forceinline__ void xcd_barrier(const XcdBarrier& b) {
    asm volatile("s_waitcnt vmcnt(0)" ::: "memory");
    __syncthreads();
    if (threadIdx.x == 0) xcd_barrier_thread0(b);
    __syncthreads();
}
#define LAYER_TAIL(layer) \
        { PHASE_IDS pg8::Gemm g{MIXp, WLp(layer, W_OUT), MTOK, 1024, 1024}; pg8::StaticOrder S; S.init(MTOK, 1024, G, bx); \
          pg8::EpiRes E{layer ? (const float*)XRES : XIN, XRES, XBp, SSQ(2 * layer + 1)}; \
          pg8::gemm_phase<pg8::EpiRes, pg8::StaticOrder, PG8_ALIGN, PG8_SP2>(ldsp, g, S, E); } \
        if (layer == 0) xcd_barrier_work(bar, args, WSLICE(3), ldsp); else xcd_barrier(bar); \
        { PHASE_IDS pg8::Gemm g{XBp, WLp(layer, W_UP), MTOK, FF, 1024}; pg8::StaticOrder S; S.init(MTOK, FF, G, bx); \
          pg8::EpiRow<1> E{HBp, FF, SSQ(2 * layer + 1), 0, 1.f}; \
          pg8::gemm_phase<pg8::EpiRow<1>, pg8::StaticOrder, PG8_ALIGN, PG8_SP2>(ldsp, g, S, E); } \
        if (layer == 0) xcd_barrier_work(bar, args, WSLICE(4), ldsp); else xcd_barrier(bar); \
        if (layer == 1 && gridDim.x == 256) {     \
          PHASE_IDS pg8::Gemm g{HBp, WLp(layer, W_DOWN), MTOK, 1024, FF}; pg8::StaticOrder S; S.init(MTOK, 1024, G, bx); \
          pg8::EpiResFinal E{XRES, XRES, SSQ(4), (unsigned*)(args.ws + WS_CTL) + CW_PANEL, args.in[3]}; \
          pg8::gemm_phase<pg8::EpiResFinal, pg8::StaticOrder, false, PG8_SP2>(ldsp, g, S, E); \
        } else { \
        { PHASE_IDS pg8::Gemm g{HBp, WLp(layer, W_DOWN), MTOK, 1024, FF}; pg8::StaticOrder S; S.init(MTOK, 1024, G, bx); \
          pg8::EpiRes E{XRES, XRES, XBp, SSQ(2 * layer + 2)}; \
          pg8::gemm_phase<pg8::EpiRes, pg8::StaticOrder, PG8_ALIGN, PG8_SP2>(ldsp, g, S, E); } \
        if (layer == 0) xcd_barrier_work(bar, args, WSLICE(5), ldsp); else xcd_barrier(bar); }
constexpr int I_IN = 16 * 96, I_OUT = 16 * 32, I_UP = 16 * 128, I_DN = 64 * 32, I_L = I_IN + I_OUT + I_UP + I_DN;
struct Args { const float* in[16]; float* out; unsigned char* ws; };
struct CvtItem { const float* wp; bf16* op; int N, K; f32x4 g0, g1; };
__device__ __forceinline__ void cvt_decode(const Args& args, int it, int lane, CvtItem& d) {
    const int l = it / I_L; int r = it % I_L;
    const float* W; bf16* WT; int K = 1024, N; const float* gs = nullptr; int gmask = 1023; float gmul = 1.f; bool remap = false;
    if (r < I_IN) { W = l ? args.in[7] : args.in[4]; N = 3072; WT = (bf16*)(args.ws + WS_W + (size_t)l * W_LAYER + W_IN); gs = args.in[1] + l * 1024; remap = (l == 0); }
    else if ((r -= I_IN) < I_OUT) { W = l ? args.in[13] : args.in[6]; N = 1024; WT = (bf16*)(args.ws + WS_W + (size_t)l * W_LAYER + W_OUT); gs = l ? args.in[12] : nullptr; gmask = 127; gmul = 1.0f - LAMBDA_INIT1; }
    else if ((r -= I_OUT) < I_UP) { W = args.in[14] + (size_t)l * 1024 * 4096; N = 4096; WT = (bf16*)(args.ws + WS_W + (size_t)l * W_LAYER + W_UP); gs = args.in[2] + l * 1024; }
    else { r -= I_UP; W = args.in[15] + (size_t)l * 4096 * 1024; K = 4096; N = 1024; WT = (bf16*)(args.ws + WS_W + (size_t)l * W_LAYER + W_DOWN); }
    const int nblk = N / 32, kb = r / nblk, nb = r % nblk, k0 = 64 * kb, n0 = 32 * nb, c = lane & 7;
    int r0 = n0; if (remap) r0 = n0 < 1024 ? n0 : (n0 < 1536 ? n0 + 1536 : n0 - 512);
    d.N = N; d.K = K; d.wp = W + (size_t)(k0 + (lane >> 3)) * N + n0 + 4 * c; d.op = WT + (size_t)(r0 + (lane >> 3)) * K + k0 + 8 * c;
    d.g0 = (f32x4){1.f, 1.f, 1.f, 1.f}; d.g1 = d.g0;
    if (gs) { const float* gp = gs + ((k0 + 8 * c) & gmask); d.g0 = *(const f32x4*)gp * gmul; d.g1 = *(const f32x4*)(gp + 4) * gmul; }
}
__device__ __forceinline__ void cvt_load(const CvtItem& d, f32x4 (&v)[8]) {
#pragma unroll
    for (int i = 0; i < 8; ++i) v[i] = __builtin_nontemporal_load((const f32x4*)(d.wp + (size_t)(8 * i) * d.N));
}
__device__ __forceinline__ void cvt_lds_write(const f32x4 (&v)[8], LAS float* scr, int lane) {
    const int c = lane & 7;
#pragma unroll
    for (int i = 0; i < 8; ++i) { LAS float* p = scr + (8 * i + (lane >> 3)) * 33 + 4 * c; p[0] = v[i][0]; p[1] = v[i][1]; p[2] = v[i][2]; p[3] = v[i][3]; }
    LDS_WAIT(); asm volatile("" ::: "memory");
}
__device__ __forceinline__ void cvt_lds_read_store(const CvtItem& d, LAS float* scr, int lane) {
    const int c = lane & 7;
#pragma unroll
    for (int j = 0; j < 4; ++j) { const LAS float* s = scr + (8 * c) * 33 + (lane >> 3) + 8 * j;
        v4u o; o.x = pk2(s[0 * 33] * d.g0[0], s[1 * 33] * d.g0[1]); o.y = pk2(s[2 * 33] * d.g0[2], s[3 * 33] * d.g0[3]); o.z = pk2(s[4 * 33] * d.g1[0], s[5 * 33] * d.g1[1]); o.w = pk2(s[6 * 33] * d.g1[2], s[7 * 33] * d.g1[3]);
        *(GAS v4u*)(d.op + (size_t)(8 * j) * d.K) = o; }
    LDS_WAIT(); asm volatile("" ::: "memory");
}
__device__ __forceinline__ void convert_items(const Args& args, int lo, int hi, int gw, int NGW, int lane, LAS float* scr) {
    int it = lo + gw; if (it >= hi) return;
    CvtItem A, B, C; f32x4 va[8], vb[8];
    cvt_decode(args, it, lane, A); cvt_load(A, va);
    bool hb = (it + NGW) < hi; B = A;
#pragma unroll
    for (int i = 0; i < 8; ++i) vb[i] = va[i];
    if (hb) { cvt_decode(args, it + NGW, lane, B); cvt_load(B, vb); }
    for (;;) {
        cvt_lds_write(va, scr, lane);
        const bool hc = (it + 2 * NGW) < hi; C = A;
        if (hc) { cvt_decode(args, it + 2 * NGW, lane, C); cvt_load(C, va); }
        cvt_lds_read_store(A, scr, lane);
        if (!hb) break;
        cvt_lds_write(vb, scr, lane);
        const bool hd = (it + 3 * NGW) < hi; A = B;
        CvtItem D = B;
        if (hd) { cvt_decode(args, it + 3 * NGW, lane, D); cvt_load(D, vb); }
        cvt_lds_read_store(A, scr, lane);
        if (!hc) break;
        A = C; B = D; hb = hd; it += 2 * NGW;
    }
}
#define CONVERT_ITEMS(lo, hi) convert_items(args, (lo), (hi), gw, NGW, lane, scr);
__device__ __forceinline__ void xcd_barrier_work(const XcdBarrier& b, const Args& args, int lo, int hi, LAS unsigned char* ldsp) {
    asm volatile("s_waitcnt vmcnt(0)" ::: "memory");
    __syncthreads();
    int tid = threadIdx.x; asm volatile("" : "+v"(tid));
    const int wave = __builtin_amdgcn_readfirstlane(tid >> 6);
    if (wave == 0) { if (tid == 0) xcd_barrier_thread0(b); }
    else { int G = gridDim.x, bx = blockIdx.x; asm volatile("" : "+s"(G), "+s"(bx)); const int vcu = (G % 8 == 0) ? (bx % 8) * (G / 8) + bx / 8 : bx;
           convert_items(args, lo, hi, vcu * 7 + (wave - 1), G * 7, tid & 63, (LAS float*)(ldsp + wave * 16384)); }
    __syncthreads();
}
constexpr int I_W = (2 * I_L - I_IN) / 6;
#define WSLICE(k) (I_IN + (k) * I_W), (I_IN + ((k) + 1) * I_W)
static_assert((2 * I_L - I_IN) % 6 == 0 && I_IN + 1 * I_W >= I_IN + I_OUT && I_IN + 2 * I_W >= I_IN + I_OUT + I_UP && I_IN + 3 * I_W >= I_L && I_IN + 4 * I_W >= I_L + I_IN + I_OUT, "slice k is published by barrier k+1: out0 by 1, up0 by 2, down0 by 3, in1 by 4, out1 by 6, up1 by 7, down1 by 8");

__global__ void __launch_bounds__(NWAVES * 64, 2) mega_fwd(Args args) {
    extern __shared__ __attribute__((aligned(16))) unsigned char lds[];
    cg::grid_group grid = cg::this_grid();
    LAS unsigned char* ldsp = (LAS unsigned char*)lds;
    for (int u = threadIdx.x; u < (LDS_BYTES - LDSCTL_OFF) / 4; u += NWAVES * 64) ((LAS unsigned*)(ldsp + LDSCTL_OFF))[u] = 0u;
    __syncthreads();
    const XcdBarrier bar = xcd_barrier_post((unsigned*)(args.ws + WS_CTL) + CW_BAR, (volatile LAS unsigned*)(ldsp + MISC_OFF) + 8);
#define PHASE_IDS int tid = threadIdx.x; asm volatile("" : "+v"(tid)); const int lane = tid & 63, wave = __builtin_amdgcn_readfirstlane(tid >> 6); \
    int G = gridDim.x, bx = blockIdx.x; asm volatile("" : "+s"(G), "+s"(bx)); const int vcu = (G % 8 == 0) ? (bx % 8) * (G / 8) + bx / 8 : bx; \
    const int gw = vcu * NWAVES + wave, NGW = G * NWAVES; (void)lane; (void)gw; (void)NGW; (void)tid;
#define XIN   (args.in[0])
#define XRES  (args.out)
#define SSQ(i) ((float*)(args.ws + WS_SSQ) + (size_t)(i) * MTOK)
#define XBp   ((bf16*)(args.ws + WS_XB))
#define PROJp ((bf16*)(args.ws + WS_PROJ))
#define VTp   ((bf16*)(args.ws + WS_VT))
#define MIXp  ((bf16*)(args.ws + WS_MIX))
#define HBp   ((bf16*)(args.ws + WS_H))
#define WLp(l, off) ((bf16*)(args.ws + WS_W + (size_t)(l) * W_LAYER + (off)))

    {
        PHASE_IDS
        LAS float* scr = (LAS float*)(ldsp + wave * 16384);
        CONVERT_ITEMS(0, I_IN)
        for (int m = 2 * gw; m < MTOK; m += 2 * NGW) x_rows2_to_bf16(XIN + (size_t)m * 1024, XBp + (size_t)m * 1024, SSQ(0) + m, lane);
    }
    if (args.ws == nullptr) grid.sync();
    xcd_barrier_work(bar, args, WSLICE(0), ldsp);

    {
        { PHASE_IDS pg8::Gemm g{XBp, WLp(0, W_IN), MTOK, P0W, 1024}; pg8::StaticOrder S; S.init(MTOK, P0W, G, bx);
          pg8::EpiRow<0> E{PROJp, P0W, SSQ(0), 2, QSCALE};
          pg8::gemm_phase<pg8::EpiRow<0>, pg8::StaticOrder, PG8_ALIGN, PG8_SP2>(ldsp, g, S, E); }
        { PHASE_IDS pg8::Gemm g{WLp(0, W_IN) + (size_t)P0W * 1024, XBp, 512, MTOK, 1024}; pg8::StaticOrder S; S.init(512, MTOK, G, (bx + G / 2) % G);
          pg8::EpiColScale E{VTp, MTOK, SSQ(0)};
          pg8::gemm_phase<pg8::EpiColScale, pg8::StaticOrder, PG8_ALIGN, PG8_SP2>(ldsp, g, S, E); }
        xcd_barrier_work(bar, args, WSLICE(1), ldsp);
        { PHASE_IDS
          conv_items(PROJp, args.in[5], MIXp, vcu * (NWAVES * 64) + tid, G * NWAVES * 64);
          LAS float* scr = (LAS float*)(ldsp + wave * 16384);
          for (int u = gw; u < 2 * 8 * 256; u += NGW) sb_unit(u >> 11, (u >> 8) & 7, u & 255, PROJp, VTp, MIXp, ldsp + wave * 16384 + 8704, lane);
          (void)scr; }
        xcd_barrier_work(bar, args, WSLICE(2), ldsp);
        LAYER_TAIL(0)
    }
    {
        { PHASE_IDS pg8::Gemm g{XBp, WLp(1, W_IN), MTOK, P1W, 1024}; pg8::StaticOrder S; S.init(MTOK, P1W, G, bx);
          pg8::EpiRow<0> E{PROJp, P1W, SSQ(2), 4, QSCALE};
          pg8::gemm_phase<pg8::EpiRow<0>, pg8::StaticOrder, PG8_ALIGN, PG8_SP2>(ldsp, g, S, E); }
        xcd_barrier(bar);
        { PHASE_IDS const dattn::DiffOrder S(vcu, G); dattn::diff_phase((char*)lds, PROJp, MIXp, S); }
        { PHASE_IDS float lam;
          { const float a = wave_sum(args.in[8][lane] * args.in[9][lane]), c = wave_sum(args.in[10][lane] * args.in[11][lane]); lam = __expf(a) - __expf(c) + LAMBDA_INIT1; }
          const dattn::DiffOrder S(vcu, G); dattn::diff_combine(PROJp, MIXp, S, lam); }
        xcd_barrier(bar);
        LAYER_TAIL(1)
    }
    if (gridDim.x != 256) { PHASE_IDS const float* ssq_f = SSQ(4);
      f32x4 gv[4];
#pragma unroll
      for (int j = 0; j < 4; ++j) gv[j] = ((const f32x4*)args.in[3])[lane + 64 * j];
      for (int m = 2 * gw; m < MTOK; m += 2 * NGW) { const float rs0 = pg8::rstd_of(ssq_f[m]), rs1 = pg8::rstd_of(ssq_f[m + 1]); f32x4* xr = (f32x4*)(XRES + (size_t)m * 1024) + lane;
          f32x4 v[8];
#pragma unroll
          for (int j = 0; j < 8; ++j) v[j] = xr[64 * j];
#pragma unroll
          for (int j = 0; j < 4; ++j) { xr[64 * j] = v[j] * rs0 * gv[j]; xr[256 + 64 * j] = v[4 + j] * rs1 * gv[j]; } } }
}

extern "C" void kernel_launch(void* const* d_in, const int* in_sizes, int n_in, void* d_out, int out_size, void* d_ws, size_t ws_size, hipStream_t stream) {
    static int grid = 0;
    if (grid == 0) {
        if (n_in != 16 || in_sizes[0] != MTOK * DMOD || out_size != MTOK * DMOD || ws_size < WS_END) { fprintf(stderr, "kernel_launch: unexpected shapes (n_in %d, in0 %d, out %d, ws %zu)\n", n_in, n_in > 0 ? in_sizes[0] : -1, out_size, ws_size); grid = -1; return; }
        int dev = 0, cus = 0, per_cu = 0;
        if (hipGetDevice(&dev) != hipSuccess || hipDeviceGetAttribute(&cus, hipDeviceAttributeMultiprocessorCount, dev) != hipSuccess) { grid = -1; return; }
        if (hipFuncSetAttribute((const void*)mega_fwd, hipFuncAttributeMaxDynamicSharedMemorySize, LDS_BYTES) != hipSuccess) { fprintf(stderr, "kernel_launch: hipFuncSetAttribute failed\n"); grid = -1; return; }
        if (hipOccupancyMaxActiveBlocksPerMultiprocessor(&per_cu, (const void*)mega_fwd, NWAVES * 64, LDS_BYTES) != hipSuccess || per_cu < 1) { fprintf(stderr, "kernel_launch: occupancy query says %d\n", per_cu); per_cu = 1; }
        (void)hipGetLastError();
        grid = cus;
    }
    if (grid < 0) return;
    (void)hipMemsetAsync((char*)d_ws + WS_CTL, 0, CTL_ZERO_BYTES, stream);
    Args a{};
    for (int i = 0; i < 16; ++i) a.in[i] = (const float*)d_in[i];
    a.out = (float*)d_out; a.ws = (unsigned char*)d_ws;
    void* kargs[] = {&a};
    hipError_t e = hipLaunchCooperativeKernel((const void*)mega_fwd, dim3(grid), dim3(NWAVES * 64), kargs, LDS_BYTES, stream);
    if (e != hipSuccess) fprintf(stderr, "kernel_launch: cooperative launch failed: %s (grid %d)\n", hipGetErrorString(e), grid);
}
```

```cpp
#include <hip/hip_runtime.h>
#include <cstdio>
#include <cstdint>
namespace pg8 {
#define PG8_LAS __attribute__((address_space(3)))
typedef unsigned short bf16_t;
typedef short bf16x8 __attribute__((ext_vector_type(8)));
typedef float f32x4 __attribute__((ext_vector_type(4)));
typedef unsigned u32x4 __attribute__((ext_vector_type(4)));
constexpr int BM = 256, BK = 64, HALF = 128, HTB = HALF * BK * 2  , STAGE_BYTES = 8 * HTB, NXCD = 8, WGM = 8;

__host__ __device__ __forceinline__ int lds_byte(int r, int c) { const int st = (r >> 4) * 2 + (c >> 5), rr = r & 15, cc = c & 31, ob = rr * 64 + cc * 2; return st * 1024 + (ob ^ (((ob >> 9) & 1) << 5)); }
__host__ __device__ __forceinline__ void stage_rc(int b, int& R, int& C) { const int st = b / 1024, sb = b % 1024, swz = sb ^ (((sb >> 9) & 1) << 5); R = (st >> 1) * 16 + swz / 64; C = (st & 1) * 32 + (swz % 64) / 2; }
__host__ __device__ __forceinline__ int perm32(int rho) { const int n = rho >> 4, i = rho & 15; return 8 * (i >> 2) + 4 * n + (i & 3); }

struct Unit { int pm, pn; };
struct Gemm { const bf16_t* A; const bf16_t* Bt; int M, N, K; };

struct StaticOrder {
    int nM, nN, nwg, G, c;
    __host__ __device__ void init(int M, int N, int G_, int c_) { nM = M / BM; nN = N / BM; nwg = nM * nN; G = G_; c = c_; }
    __host__ __device__ bool next(int i, Unit& u) const {
        const long L = (long)i * G + c; if (L >= nwg) return false;
        int wgid = (int)L; { const int q = nwg / NXCD, r = nwg % NXCD, xcd = wgid % NXCD, off = wgid / NXCD; wgid = (xcd < r ? xcd * (q + 1) : r * (q + 1) + (xcd - r) * q) + off; }
        const int nig = WGM * nN, gid = wgid / nig, fm = gid * WGM, gsz = (nM - fm) < WGM ? (nM - fm) : WGM;
        u.pm = fm + ((wgid % nig) % gsz); u.pn = (wgid % nig) / gsz; return true;
    }
    __device__ __forceinline__ void a_ready(const Unit&) const {}
    __device__ __forceinline__ void done(const Unit&) const {}
};

__device__ __forceinline__ unsigned cvt_pk_bf16(float lo, float hi) { unsigned r; asm volatile("v_cvt_pk_bf16_f32 %0, %1, %2" : "=v"(r) : "v"(lo), "v"(hi)); return r; }
typedef float f32x2 __attribute__((ext_vector_type(2)));
__device__ __forceinline__ float rstd_of(float ssq) { return __builtin_amdgcn_rsqf(ssq * (1.0f / 1024.0f) + 1e-6f); }
typedef unsigned u32x2 __attribute__((ext_vector_type(2)));
template <int ACT> struct EpiRow {
    static constexpr bool PERM = true, AFTER_DRAIN = false;
    bf16_t* O; int ldc; const float* ssq; int qtiles; float qscale;
    __device__ __forceinline__ void operator()(const f32x4 (&acc)[2][2][4][2], const Unit& u, int wr, int wc, int fr, int fq) const {
        const int row0 = u.pm * BM + wr * 64 + fr, col0 = u.pn * BM + wc * 32 + 8 * fq;
        const float sc = (u.pn < qtiles) ? qscale : 1.f;
        float rsv[2][4];
#pragma unroll
        for (int ai = 0; ai < 2; ++ai)
#pragma unroll
            for (int m = 0; m < 4; ++m) rsv[ai][m] = ssq[row0 + ai * HALF + m * 16];
#pragma unroll
        for (int ai = 0; ai < 2; ++ai)
#pragma unroll
            for (int m = 0; m < 4; ++m) { const int row = row0 + ai * HALF + m * 16; const float rs = rstd_of(rsv[ai][m]) * sc; bf16_t* rowp = O + (size_t)row * ldc + col0;
#pragma unroll
                for (int bj = 0; bj < 2; ++bj) { f32x4 v0 = acc[ai][bj][m][0], v1 = acc[ai][bj][m][1];
                    if (ACT == 1) { const f32x4 z = {0.f, 0.f, 0.f, 0.f}; v0 = __builtin_elementwise_max(v0, z) * rs; v1 = __builtin_elementwise_max(v1, z) * rs; v0 = v0 * v0; v1 = v1 * v1; }
                    else { v0 = v0 * rs; v1 = v1 * rs; }
                    u32x4 w; w.x = cvt_pk_bf16(v0[0], v0[1]); w.y = cvt_pk_bf16(v0[2], v0[3]); w.z = cvt_pk_bf16(v1[0], v1[1]); w.w = cvt_pk_bf16(v1[2], v1[3]);
                    *(u32x4*)(rowp + bj * HALF) = w; } }
    }
};
struct EpiColScale {
    static constexpr bool PERM = true, AFTER_DRAIN = false;
    bf16_t* O; int ldc; const float* ssq;
    __device__ __forceinline__ void operator()(const f32x4 (&acc)[2][2][4][2], const Unit& u, int wr, int wc, int fr, int fq) const {
        const int row0 = u.pm * BM + wr * 64 + fr, col0 = u.pn * BM + wc * 32 + 8 * fq;
        f32x4 sv[2][2];
#pragma unroll
        for (int bj = 0; bj < 2; ++bj)
#pragma unroll
            for (int n = 0; n < 2; ++n) { const f32x4 s = *(const f32x4*)(ssq + col0 + bj * HALF + 4 * n); sv[bj][n] = (f32x4){rstd_of(s[0]), rstd_of(s[1]), rstd_of(s[2]), rstd_of(s[3])}; }
#pragma unroll
        for (int ai = 0; ai < 2; ++ai)
#pragma unroll
            for (int m = 0; m < 4; ++m) { bf16_t* rowp = O + (size_t)(row0 + ai * HALF + m * 16) * ldc + col0;
#pragma unroll
                for (int bj = 0; bj < 2; ++bj) { const f32x4 v0 = acc[ai][bj][m][0] * sv[bj][0], v1 = acc[ai][bj][m][1] * sv[bj][1];
                    u32x4 w; w.x = cvt_pk_bf16(v0[0], v0[1]); w.y = cvt_pk_bf16(v0[2], v0[3]); w.z = cvt_pk_bf16(v1[0], v1[1]); w.w = cvt_pk_bf16(v1[2], v1[3]);
                    *(u32x4*)(rowp + bj * HALF) = w; } }
    }
};
struct EpiRes {
    static constexpr bool PERM = false, AFTER_DRAIN = false;
    const float* base; float* out; bf16_t* xb; float* ssq;
    __device__ __forceinline__ void operator()(const f32x4 (&acc)[2][2][4][2], const Unit& u, int wr, int wc, int fr, int fq) const {
        const int row0 = u.pm * BM + wr * 64 + fr, col0 = u.pn * BM + wc * 32 + 4 * fq;
#pragma unroll
        for (int ai = 0; ai < 2; ++ai) {
            f32x4 pre[4][2][2];
#pragma unroll
            for (int m = 0; m < 4; ++m) { const size_t off = (size_t)(row0 + ai * HALF + m * 16) * 1024 + col0;
#pragma unroll
                for (int bj = 0; bj < 2; ++bj)
#pragma unroll
                    for (int n = 0; n < 2; ++n) pre[m][bj][n] = __builtin_nontemporal_load((const f32x4*)(base + off + bj * HALF + n * 16)); }
            asm volatile("" ::: "memory");
#pragma unroll
            for (int m = 0; m < 4; ++m) { const int row = row0 + ai * HALF + m * 16; const size_t off = (size_t)row * 1024 + col0; float s = 0.f;
#pragma unroll
                for (int bj = 0; bj < 2; ++bj)
#pragma unroll
                    for (int n = 0; n < 2; ++n) { const f32x4 v = pre[m][bj][n] + acc[ai][bj][m][n];
                        __builtin_nontemporal_store(v, (f32x4*)(out + off + bj * HALF + n * 16)); s += (v[0] * v[0] + v[1] * v[1]) + (v[2] * v[2] + v[3] * v[3]);
                        u32x2 w; w.x = cvt_pk_bf16(v[0], v[1]); w.y = cvt_pk_bf16(v[2], v[3]); *(u32x2*)(xb + off + bj * HALF + n * 16) = w; }
                s += __shfl_xor(s, 16); s += __shfl_xor(s, 32);
                if (fq == 0) __hip_atomic_fetch_add(ssq + row, s, __ATOMIC_RELAXED, __HIP_MEMORY_SCOPE_AGENT); }
            asm volatile("" ::: "memory");
        }
    }
};

struct EpiResFinal {
    static constexpr bool PERM = false, AFTER_DRAIN = true;
    const float* base; float* out; float* ssq; unsigned* cnt; const float* gain;
    __device__ __forceinline__ void operator()(const f32x4 (&)[2][2][4][2], const Unit&, int, int, int, int) const {}
    __device__ __forceinline__ void fused(f32x4 (&acc)[2][2][4][2], const Unit& u, int wr, int wc, int fr, int fq, PG8_LAS unsigned char*, int, int lane) const {
        const int row0 = u.pm * BM + wr * 64 + fr, col0 = u.pn * BM + wc * 32 + 4 * fq;
#pragma unroll
        for (int ai = 0; ai < 2; ++ai) {
            f32x4 pre[4][2][2];
#pragma unroll
            for (int m = 0; m < 4; ++m) { const size_t off = (size_t)(row0 + ai * HALF + m * 16) * 1024 + col0;
#pragma unroll
                for (int bj = 0; bj < 2; ++bj)
#pragma unroll
                    for (int n = 0; n < 2; ++n) pre[m][bj][n] = __builtin_nontemporal_load((const f32x4*)(base + off + bj * HALF + n * 16)); }
            asm volatile("" ::: "memory");
#pragma unroll
            for (int m = 0; m < 4; ++m) { const int row = row0 + ai * HALF + m * 16; float s = 0.f;
#pragma unroll
                for (int bj = 0; bj < 2; ++bj)
#pragma unroll
                    for (int n = 0; n < 2; ++n) { const f32x4 v = pre[m][bj][n] + acc[ai][bj][m][n]; acc[ai][bj][m][n] = v; s += (v[0] * v[0] + v[1] * v[1]) + (v[2] * v[2] + v[3] * v[3]); }
                s += __shfl_xor(s, 16); s += __shfl_xor(s, 32);
                if (fq == 0) __hip_atomic_fetch_add(ssq + row, s, __ATOMIC_RELAXED, __HIP_MEMORY_SCOPE_AGENT); }
        }
        asm volatile("s_waitcnt vmcnt(0)" ::: "memory");
        unsigned* c = cnt + 64 * u.pm;
        if (lane == 0) __hip_atomic_fetch_add(c, 1u, __ATOMIC_RELAXED, __HIP_MEMORY_SCOPE_AGENT);
        { unsigned sp = 0; while ((unsigned)__builtin_amdgcn_readfirstlane(__hip_atomic_load(c, __ATOMIC_RELAXED, __HIP_MEMORY_SCOPE_AGENT)) < 32u) { __builtin_amdgcn_s_sleep(2); if (++sp > (1u << 22)) break; } }
        __builtin_amdgcn_fence(__ATOMIC_ACQUIRE, "agent");
        f32x4 gv[2][2];
#pragma unroll
        for (int bj = 0; bj < 2; ++bj)
#pragma unroll
            for (int n = 0; n < 2; ++n) gv[bj][n] = *(const f32x4*)(gain + col0 + bj * HALF + n * 16);
        float rsv[2][4];
#pragma unroll
        for (int ai = 0; ai < 2; ++ai)
#pragma unroll
            for (int m = 0; m < 4; ++m) rsv[ai][m] = __hip_atomic_load(ssq + row0 + ai * HALF + m * 16, __ATOMIC_RELAXED, __HIP_MEMORY_SCOPE_AGENT);
#pragma unroll
        for (int ai = 0; ai < 2; ++ai)
#pragma unroll
            for (int m = 0; m < 4; ++m) { const float rs = rstd_of(rsv[ai][m]); const size_t off = (size_t)(row0 + ai * HALF + m * 16) * 1024 + col0;
#pragma unroll
                for (int bj = 0; bj < 2; ++bj)
#pragma unroll
                    for (int n = 0; n < 2; ++n) __builtin_nontemporal_store(acc[ai][bj][m][n] * rs * gv[bj][n], (f32x4*)(out + off + bj * HALF + n * 16)); }
    }
};

template <class Epi, class Sched, bool ALIGN_EPI = false, bool SP2 = false>
__device__ __forceinline__ void gemm_phase(PG8_LAS unsigned char* lds, const Gemm g, const Sched& S, const Epi& E) {
    int tid_ = threadIdx.x; asm volatile("" : "+v"(tid_));
    const int tid = tid_, wid = __builtin_amdgcn_readfirstlane(tid >> 6), lane = tid & 63, wr = wid >> 2, wc = wid & 3, fr = lane & 15, fq = lane >> 4;
    const int K = g.K, nt = K / BK;
    unsigned voffA[2], voffB[2];
#pragma unroll
    for (int i = 0; i < 2; ++i) { int R, C; stage_rc(tid * 16 + i * 8192, R, C); const int Rb = Epi::PERM ? ((R & ~31) + perm32(R & 31)) : R;
        voffA[i] = (unsigned)(R * K + C) * 2u; voffB[i] = (unsigned)(Rb * K + C) * 2u; }
    const size_t kstep = (size_t)(BK * 2);
    const size_t hstep = (size_t)HALF * K * 2;
    const size_t tstep = 2 * hstep;
    const unsigned ldsw = (unsigned)wid * 1024u;
    const int aoff = lds_byte(wr * 64 + fr, fq * 8), boff = lds_byte(wc * 32 + fr, fq * 8);
#define PG8_SA(b, h) (((b) * 2 + (h)) * HTB)
#define PG8_SB(b, h) ((4 + (b) * 2 + (h)) * HTB)
#define PG8_STAGE(bufoff, gbase, voff) do { _Pragma("unroll") for (int _i = 0; _i < 2; ++_i) \
        __builtin_amdgcn_global_load_lds((const unsigned*)((const char*)(gbase) + (voff)[_i]), (PG8_LAS unsigned*)(lds + (bufoff) + ldsw + _i * 8192), 16, 0, 0); } while (0)
#define PG8_LDA(dst, b, h) do { _Pragma("unroll") for (int m = 0; m < 4; ++m) _Pragma("unroll") for (int k = 0; k < 2; ++k) dst[m][k] = *(const PG8_LAS bf16x8*)(lds + PG8_SA(b, h) + aoff + m * 2048 + k * 1024); } while (0)
#define PG8_LDB(dst, b, h) do { _Pragma("unroll") for (int n = 0; n < 2; ++n) _Pragma("unroll") for (int k = 0; k < 2; ++k) dst[n][k] = *(const PG8_LAS bf16x8*)(lds + PG8_SB(b, h) + boff + n * 2048 + k * 1024); } while (0)
#define PG8_MMA(ai, bj, At, Bt) do { __builtin_amdgcn_s_setprio(1); _Pragma("unroll") for (int m = 0; m < 4; ++m) _Pragma("unroll") for (int n = 0; n < 2; ++n) _Pragma("unroll") for (int k = 0; k < 2; ++k) \
        acc[ai][bj][m][n] = __builtin_amdgcn_mfma_f32_16x16x32_bf16(Bt[n][k], At[m][k], acc[ai][bj][m][n], 0, 0, 0); __builtin_amdgcn_s_setprio(0); } while (0)
#define PG8_WAIT_V(n) asm volatile("s_waitcnt vmcnt(" #n ")" ::: "memory")
#define PG8_WAIT_L(n) asm volatile("s_waitcnt lgkmcnt(" #n ")" ::: "memory")
#define PG8_BAR __builtin_amdgcn_s_barrier()
#define PG8_SCHED __builtin_amdgcn_sched_barrier(0)
    Unit cur, nxt; int ui = 0;
    if (!S.next(0, cur)) return;
    f32x4 acc[2][2][4][2];
#pragma unroll
    for (int a = 0; a < 2; ++a)
#pragma unroll
        for (int b = 0; b < 2; ++b)
#pragma unroll
            for (int m = 0; m < 4; ++m)
#pragma unroll
                for (int n = 0; n < 2; ++n) acc[a][b][m][n] = (f32x4){0.f, 0.f, 0.f, 0.f};
    bf16x8 At[4][2], B0[2][2], B1[2][2];
    const char* cA = (const char*)g.A + (size_t)cur.pm * tstep; const char* cB = (const char*)g.Bt + (size_t)cur.pn * tstep;
    S.a_ready(cur);
    if constexpr (SP2) {
        PG8_STAGE(PG8_SB(0, 0), cB, voffB); PG8_STAGE(PG8_SB(0, 1), cB + hstep, voffB); PG8_STAGE(PG8_SA(0, 0), cA, voffA); PG8_STAGE(PG8_SA(0, 1), cA + hstep, voffA);
        if (wr == 1) PG8_BAR;
        PG8_WAIT_V(2); PG8_BAR;
        PG8_STAGE(PG8_SB(1, 0), cB + kstep, voffB); PG8_STAGE(PG8_SA(1, 0), cA + kstep, voffA); PG8_STAGE(PG8_SB(1, 1), cB + hstep + kstep, voffB);
        PG8_WAIT_V(6); PG8_BAR;
    } else {
        PG8_STAGE(PG8_SB(0, 0), cB, voffB); PG8_STAGE(PG8_SA(0, 0), cA, voffA); PG8_STAGE(PG8_SB(0, 1), cB + hstep, voffB); PG8_STAGE(PG8_SA(0, 1), cA + hstep, voffA);
        if (wr == 1) PG8_BAR;
        PG8_WAIT_V(4); PG8_BAR;
        PG8_STAGE(PG8_SB(1, 0), cB + kstep, voffB); PG8_STAGE(PG8_SA(1, 0), cA + kstep, voffA); PG8_STAGE(PG8_SB(1, 1), cB + hstep + kstep, voffB);
        PG8_WAIT_V(6); PG8_BAR;
    }
    for (;;) {
        const bool has_next = S.next(ui + 1, nxt);
        const char* nA = has_next ? (const char*)g.A + (size_t)nxt.pm * tstep : cA; const char* nB = has_next ? (const char*)g.Bt + (size_t)nxt.pn * tstep : cB;
        for (int t = 0; t < nt; t += 2) {
            const bool last = (t == nt - 2);
            const char* a1 = cA + (size_t)(t + 1) * kstep;
            const char* a2 = last ? nA : cA + (size_t)(t + 2) * kstep; const char* b2 = last ? nB : cB + (size_t)(t + 2) * kstep;
            const char* a3 = a2 + kstep; const char* b3 = b2 + kstep;
            if (last && has_next) S.a_ready(nxt);
            if constexpr (SP2) {
            PG8_LDB(B0, 0, 0); PG8_LDB(B1, 0, 1); PG8_SCHED; PG8_LDA(At, 0, 0); PG8_STAGE(PG8_SA(1, 1), a1 + hstep, voffA);
            PG8_WAIT_V(8); PG8_WAIT_L(0); PG8_BAR; PG8_MMA(0, 0, At, B0); PG8_MMA(0, 1, At, B1); PG8_BAR; PG8_SCHED;
            PG8_LDA(At, 0, 1); PG8_STAGE(PG8_SB(0, 0), b2, voffB); PG8_STAGE(PG8_SB(0, 1), b2 + hstep, voffB); PG8_STAGE(PG8_SA(0, 0), a2, voffA);
            PG8_WAIT_V(8); PG8_WAIT_L(0); PG8_BAR; PG8_MMA(1, 0, At, B0); PG8_MMA(1, 1, At, B1); PG8_BAR; PG8_SCHED;
            PG8_LDB(B0, 1, 0); PG8_LDB(B1, 1, 1); PG8_SCHED; PG8_LDA(At, 1, 0); PG8_STAGE(PG8_SA(0, 1), a2 + hstep, voffA);
            PG8_WAIT_V(8); PG8_WAIT_L(0); PG8_BAR; PG8_MMA(0, 0, At, B0); PG8_MMA(0, 1, At, B1); PG8_BAR; PG8_SCHED;
            PG8_LDA(At, 1, 1); PG8_STAGE(PG8_SB(1, 0), b3, voffB); PG8_STAGE(PG8_SB(1, 1), b3 + hstep, voffB); PG8_STAGE(PG8_SA(1, 0), a3, voffA);
            PG8_WAIT_V(8); PG8_WAIT_L(0); PG8_BAR; PG8_MMA(1, 0, At, B0); PG8_MMA(1, 1, At, B1); PG8_BAR; PG8_SCHED;
            } else {
            PG8_LDB(B0, 0, 0); PG8_SCHED; PG8_LDA(At, 0, 0); PG8_STAGE(PG8_SA(1, 1), a1 + hstep, voffA);
            PG8_WAIT_L(8); PG8_BAR; PG8_WAIT_L(0); PG8_MMA(0, 0, At, B0); PG8_BAR; PG8_SCHED;
            PG8_LDB(B1, 0, 1); PG8_STAGE(PG8_SB(0, 0), b2, voffB);
            PG8_BAR; PG8_WAIT_L(0); PG8_MMA(0, 1, At, B1); PG8_BAR;
            PG8_LDA(At, 0, 1); PG8_STAGE(PG8_SA(0, 0), a2, voffA);
            PG8_BAR; PG8_WAIT_L(0); PG8_MMA(1, 0, At, B0); PG8_BAR; PG8_SCHED;
            PG8_STAGE(PG8_SB(0, 1), b2 + hstep, voffB);
            PG8_WAIT_V(6); PG8_BAR; PG8_MMA(1, 1, At, B1); PG8_BAR;
            PG8_LDB(B0, 1, 0); PG8_SCHED; PG8_LDA(At, 1, 0); PG8_STAGE(PG8_SA(0, 1), a2 + hstep, voffA);
            PG8_WAIT_L(8); PG8_BAR; PG8_WAIT_L(0); PG8_MMA(0, 0, At, B0); PG8_BAR; PG8_SCHED;
            PG8_LDB(B1, 1, 1); PG8_STAGE(PG8_SB(1, 0), b3, voffB);
            PG8_BAR; PG8_WAIT_L(0); PG8_MMA(0, 1, At, B1); PG8_BAR;
            PG8_LDA(At, 1, 1); PG8_STAGE(PG8_SA(1, 0), a3, voffA);
            PG8_BAR; PG8_WAIT_L(0); PG8_MMA(1, 0, At, B0); PG8_BAR; PG8_SCHED;
            PG8_STAGE(PG8_SB(1, 1), b3 + hstep, voffB);
            PG8_WAIT_V(6); PG8_BAR; PG8_MMA(1, 1, At, B1); PG8_BAR;
            }
        }
        if constexpr (ALIGN_EPI) { if (wr == 0) PG8_BAR; }
        if constexpr (!Epi::AFTER_DRAIN) { E(acc, cur, wr, wc, fr, fq); S.done(cur); }
        if (!has_next) break;
#pragma unroll
        for (int a = 0; a < 2; ++a)
#pragma unroll
            for (int b = 0; b < 2; ++b)
#pragma unroll
                for (int m = 0; m < 4; ++m)
#pragma unroll
                    for (int n = 0; n < 2; ++n) acc[a][b][m][n] = (f32x4){0.f, 0.f, 0.f, 0.f};
        cur = nxt; cA = nA; cB = nB; ++ui;
        if constexpr (ALIGN_EPI) { if (wr == 1) PG8_BAR; }
    }
    PG8_WAIT_V(0);
    if constexpr (!ALIGN_EPI) { if (wr == 0) PG8_BAR; }
    PG8_BAR;
    if constexpr (Epi::AFTER_DRAIN) { E.fused(acc, cur, wr, wc, fr, fq, lds, wid, lane); S.done(cur); }
#undef PG8_SA
#undef PG8_SB
#undef PG8_STAGE
#undef PG8_LDA
#undef PG8_LDB
#undef PG8_MMA
#undef PG8_WAIT_V
#undef PG8_WAIT_L
#undef PG8_BAR
#undef PG8_SCHED
}
}

#ifndef PG8_SP2
#define PG8_SP2 true
#endif
#ifndef PG8_ALIGN
#define PG8_ALIGN true
#endif
#include <hip/hip_bf16.h>
#include <cmath>
namespace dattn {
using bf16=__hip_bfloat16;
using bf16x8=__attribute__((ext_vector_type(8)))short;
using s16x4=__attribute__((ext_vector_type(4)))short;
using f32x16=__attribute__((ext_vector_type(16)))float;
using u32x4=__attribute__((ext_vector_type(4)))unsigned;
using u32x2=__attribute__((ext_vector_type(2)))unsigned;
constexpr int SEQ=8192,DM=3072,QB=256,NSLOT=4,KSLOT=8192,VSLOT=16384;
constexpr int LDS_K=0,LDS_V=NSLOT*KSLOT,LDS_END=LDS_V+NSLOT*VSLOT;
constexpr int OST_ROW=272,OST_WAVE=32*OST_ROW;
static_assert(8*OST_WAVE<=LDS_END,"O staging fits over the rings");
typedef __attribute__((address_space(3))) const char* lds_cptr;
typedef __attribute__((address_space(3))) char* lds_ptr;
typedef short v4i16_t __attribute__((ext_vector_type(4)));
__device__ __forceinline__ void glds16(const void*gsrc,unsigned lds_dst){unsigned keep;
  asm volatile("s_mov_b32 %0, m0\n\ts_mov_b32 m0, %2\n\ts_nop 0\n\tglobal_load_lds_dwordx4 %1, off\n\ts_mov_b32 m0, %0":"=&s"(keep):"v"(gsrc),"s"(lds_dst):"memory");}
__device__ __forceinline__ s16x4 vtr(lds_cptr p){ return __builtin_bit_cast(s16x4,__builtin_amdgcn_ds_read_tr16_b64_v4i16((__attribute__((address_space(3))) v4i16_t*)p)); }
typedef float f32x2_t __attribute__((ext_vector_type(2))); typedef __bf16 bf16x2_t __attribute__((ext_vector_type(2)));
__device__ __forceinline__ unsigned cvtpk_s(float lo,float hi){f32x2_t v={lo,hi};bf16x2_t b=__builtin_convertvector(v,bf16x2_t);return __builtin_bit_cast(unsigned,b);}
#define DWAIT_BAR(N) asm volatile("s_waitcnt vmcnt(" #N ") lgkmcnt(0)\n\ts_barrier":::"memory")
__device__ __forceinline__ void unit(int b,int qb,const bf16*Q,const bf16*__restrict__ K,const bf16*__restrict__ V,bf16*O,int opitch,char*shm){
  const int tid=threadIdx.x,lane=tid&63,r32=lane&31,hi=lane>>5; const int wid=__builtin_amdgcn_readfirstlane(tid>>6);
  const long rowbase=(long)b*SEQ; const int q0=qb*QB;
  const bf16*Qw=Q+(rowbase+q0+wid*32)*DM;
  const unsigned lds0=(unsigned)(uintptr_t)shm;
  const bf16*ksrc=K+rowbase*DM+(long)lane*DM+wid*8;
  const bf16*vsrc=V+rowbase*DM+(long)(16*(wid&3)+(lane>>2))*DM+(wid>>2)*32+(lane&3)*8;
  const unsigned kdst=lds0+LDS_K+wid*1024,vdst=lds0+LDS_V+wid*1024;
  #define DDMA(t,sl) do{ glds16(ksrc+(long)(t)*64*DM,(unsigned)__builtin_amdgcn_readfirstlane(kdst+(sl)*KSLOT)); \
      glds16(vsrc+(long)(t)*64*DM,(unsigned)__builtin_amdgcn_readfirstlane(vdst+(sl)*VSLOT)); \
      glds16(vsrc+(long)(t)*64*DM+64,(unsigned)__builtin_amdgcn_readfirstlane(vdst+(sl)*VSLOT+8192)); }while(0)
  #define SBARR() do{}while(0)
  #define DVRD(dst,vp_,cb_) do{ _Pragma("unroll") for(int c_=0;c_<4;++c_){ dst[2*c_]=vtr((vp_)+((cb_)>>1)*8192+((cb_)&1)*4096+c_*1024); dst[2*c_+1]=vtr((vp_)+((cb_)>>1)*8192+((cb_)&1)*4096+c_*1024+512); } }while(0)
  #define DVF(src,c_) (bf16x8){src[2*(c_)][0],src[2*(c_)][1],src[2*(c_)][2],src[2*(c_)][3],src[2*(c_)+1][0],src[2*(c_)+1][1],src[2*(c_)+1][2],src[2*(c_)+1][3]}
  #define DVRDC(dst,vp_,c_) do{ _Pragma("unroll") for(int b_=0;b_<4;++b_){ dst[2*b_]=vtr((vp_)+(b_>>1)*8192+(b_&1)*4096+(c_)*1024); dst[2*b_+1]=vtr((vp_)+(b_>>1)*8192+(b_&1)*4096+(c_)*1024+512); } }while(0)
  #define DPVC(src,c_) do{ _Pragma("unroll") for(int b_=0;b_<4;++b_) o[b_]=__builtin_amdgcn_mfma_f32_32x32x16_bf16(DVF(src,b_),pw[c_],o[b_],0,0,0); }while(0)
  #define DPV(src,cb_) do{ o[cb_]=__builtin_amdgcn_mfma_f32_32x32x16_bf16(DVF(src,0),pw[0],o[cb_],0,0,0); o[cb_]=__builtin_amdgcn_mfma_f32_32x32x16_bf16(DVF(src,1),pw[1],o[cb_],0,0,0); \
      o[cb_]=__builtin_amdgcn_mfma_f32_32x32x16_bf16(DVF(src,2),pw[2],o[cb_],0,0,0); o[cb_]=__builtin_amdgcn_mfma_f32_32x32x16_bf16(DVF(src,3),pw[3],o[cb_],0,0,0); }while(0)
  #define PV_PLAIN(vp_) do{ DPVC(va,0); DVRDC(va,vp_,2); DPVC(vb,1); DVRDC(vb,vp_,3); DPVC(va,2); DPVC(vb,3); }while(0)
  #define EXPS_PLAIN() do{ float ls0=0.f,ls1=0.f; \
      _Pragma("unroll") for(int r=0;r<16;++r){ p0[r]=__builtin_amdgcn_exp2f(p0[r]-mref); ls0+=p0[r]; p1[r]=__builtin_amdgcn_exp2f(p1[r]-mref); ls1+=p1[r]; } l+=ls0+ls1; \
      u32x4 w0,w1,w2,w3; w0.x=cvtpk_s(p0[0],p0[1]);w0.y=cvtpk_s(p0[2],p0[3]);w0.z=cvtpk_s(p0[4],p0[5]);w0.w=cvtpk_s(p0[6],p0[7]); \
      w1.x=cvtpk_s(p0[8],p0[9]);w1.y=cvtpk_s(p0[10],p0[11]);w1.z=cvtpk_s(p0[12],p0[13]);w1.w=cvtpk_s(p0[14],p0[15]); \
      w2.x=cvtpk_s(p1[0],p1[1]);w2.y=cvtpk_s(p1[2],p1[3]);w2.z=cvtpk_s(p1[4],p1[5]);w2.w=cvtpk_s(p1[6],p1[7]); \
      w3.x=cvtpk_s(p1[8],p1[9]);w3.y=cvtpk_s(p1[10],p1[11]);w3.z=cvtpk_s(p1[12],p1[13]);w3.w=cvtpk_s(p1[14],p1[15]); \
      pw[0]=__builtin_bit_cast(bf16x8,w0);pw[1]=__builtin_bit_cast(bf16x8,w1);pw[2]=__builtin_bit_cast(bf16x8,w2);pw[3]=__builtin_bit_cast(bf16x8,w3); }while(0)
  const int NT=(q0+QB)/64;
  DDMA(0,0); DDMA(1,1);
  bf16x8 qr[4];
  #pragma unroll
  for(int d0=0;d0<4;++d0)qr[d0]=*reinterpret_cast<const bf16x8*>(&Qw[(long)r32*DM+d0*16+hi*8]);
  asm volatile("":"+v"(qr[0]),"+v"(qr[1]),"+v"(qr[2]),"+v"(qr[3]));
  const lds_cptr shm3=(lds_cptr)shm;
  const lds_cptr kp0=shm3+LDS_K+hi*1024+r32*16;
  const lds_cptr vp0=shm3+LDS_V+((lane>>4)&1)*32+(lane&3)*8+(4*hi+((lane&15)>>2))*64;
  f32x16 o[4]; o[0]=f32x16{};o[1]=f32x16{};o[2]=f32x16{};o[3]=f32x16{};
  float mref=0.f,l=0.f;
  f32x16 negm=f32x16{};
  const int qfirst=q0+wid*32, qme=qfirst+r32;
  const int TI=(qfirst+1)>>6;
  int t=0;
  bf16x8 pw[4]; pw[0]=bf16x8{};pw[1]=bf16x8{};pw[2]=bf16x8{};pw[3]=bf16x8{};
  for(;t<TI;++t){
    const int slot=t&3;
    if(t+1<NT){DWAIT_BAR(3);}else{DWAIT_BAR(0);}
    if(t+2<NT){ DDMA(t+2,(t+2)&3); }
    const lds_cptr kp=kp0+slot*KSLOT; const lds_cptr vpp=vp0+((t?t-1:0)&3)*VSLOT;
    bf16x8 kf[8];
    #pragma unroll
    for(int d0=0;d0<4;++d0){ kf[2*d0]=*(const __attribute__((address_space(3))) bf16x8*)(kp+d0*2048); kf[2*d0+1]=*(const __attribute__((address_space(3))) bf16x8*)(kp+d0*2048+512); }
    s16x4 va[8],vb[8];
    f32x16 p0=__builtin_amdgcn_mfma_f32_32x32x16_bf16(kf[0],qr[0],negm,0,0,0),p1=__builtin_amdgcn_mfma_f32_32x32x16_bf16(kf[1],qr[0],negm,0,0,0);
    #pragma unroll
    for(int d0=1;d0<4;++d0){ p0=__builtin_amdgcn_mfma_f32_32x32x16_bf16(kf[2*d0],qr[d0],p0,0,0,0); p1=__builtin_amdgcn_mfma_f32_32x32x16_bf16(kf[2*d0+1],qr[d0],p1,0,0,0); }
    DVRDC(va,vpp,0); DVRDC(vb,vpp,1);
    float mt=__builtin_fmaxf(__builtin_fmaxf(p0[0],p0[1]),__builtin_fmaxf(p1[0],p1[1]));
    #pragma unroll
    for(int r=2;r<16;r+=2){ mt=__builtin_fmaxf(mt,__builtin_fmaxf(p0[r],p0[r+1])); mt=__builtin_fmaxf(mt,__builtin_fmaxf(p1[r],p1[r+1])); }
    { auto rr=__builtin_amdgcn_permlane32_swap(__float_as_uint(mt),__float_as_uint(mt),false,false); mt=__builtin_fmaxf(__uint_as_float(rr[0]),__uint_as_float(rr[1])); }
    if(t==0||__any(mt>8.0f)){
      PV_PLAIN(vpp);
      const float delta=t?__builtin_fmaxf(mt,0.f):mt; const float alpha=t?__builtin_amdgcn_exp2f(-delta):1.0f;
      #pragma unroll
      for(int cb=0;cb<4;++cb)o[cb]=o[cb]*alpha;
      l*=alpha; mref+=delta;
      #pragma unroll
      for(int r=0;r<16;++r){ p0[r]-=delta; p1[r]-=delta; negm[r]=-mref; }
      pw[0]=bf16x8{};pw[1]=bf16x8{};pw[2]=bf16x8{};pw[3]=bf16x8{};
      DVRDC(va,vpp,0); DVRDC(vb,vpp,1);
    }
    {
      float ls0=0.f,ls1=0.f; u32x4 wq;
      o[0]=__builtin_amdgcn_mfma_f32_32x32x16_bf16(DVF(va,0),pw[0],o[0],0,0,0);
      p0[0]=__builtin_amdgcn_exp2f(p0[0]); p0[1]=__builtin_amdgcn_exp2f(p0[1]); ls0+=p0[0]+p0[1];
      o[1]=__builtin_amdgcn_mfma_f32_32x32x16_bf16(DVF(va,1),pw[0],o[1],0,0,0);
      p0[2]=__builtin_amdgcn_exp2f(p0[2]); p0[3]=__builtin_amdgcn_exp2f(p0[3]); ls0+=p0[2]+p0[3];
      o[2]=__builtin_amdgcn_mfma_f32_32x32x16_bf16(DVF(va,2),pw[0],o[2],0,0,0);
      p0[4]=__builtin_amdgcn_exp2f(p0[4]); p0[5]=__builtin_amdgcn_exp2f(p0[5]); ls0+=p0[4]+p0[5];
      o[3]=__builtin_amdgcn_mfma_f32_32x32x16_bf16(DVF(va,3),pw[0],o[3],0,0,0);
      p0[6]=__builtin_amdgcn_exp2f(p0[6]); p0[7]=__builtin_amdgcn_exp2f(p0[7]); ls0+=p0[6]+p0[7];
      DVRDC(va,vpp,2);
      o[0]=__builtin_amdgcn_mfma_f32_32x32x16_bf16(DVF(vb,0),pw[1],o[0],0,0,0);
      p0[8]=__builtin_amdgcn_exp2f(p0[8]); p0[9]=__builtin_amdgcn_exp2f(p0[9]); ls0+=p0[8]+p0[9];
      wq.x=cvtpk_s(p0[0],p0[1]);
      o[1]=__builtin_amdgcn_mfma_f32_32x32x16_bf16(DVF(vb,1),pw[1],o[1],0,0,0);
      p0[10]=__builtin_amdgcn_exp2f(p0[10]); p0[11]=__builtin_amdgcn_exp2f(p0[11]); ls0+=p0[10]+p0[11];
      wq.y=cvtpk_s(p0[2],p0[3]);
      o[2]=__builtin_amdgcn_mfma_f32_32x32x16_bf16(DVF(vb,2),pw[1],o[2],0,0,0);
      p0[12]=__builtin_amdgcn_exp2f(p0[12]); p0[13]=__builtin_amdgcn_exp2f(p0[13]); ls0+=p0[12]+p0[13];
      wq.z=cvtpk_s(p0[4],p0[5]);
      o[3]=__builtin_amdgcn_mfma_f32_32x32x16_bf16(DVF(vb,3),pw[1],o[3],0,0,0);
      p0[14]=__builtin_amdgcn_exp2f(p0[14]); p0[15]=__builtin_amdgcn_exp2f(p0[15]); ls0+=p0[14]+p0[15];
      wq.w=cvtpk_s(p0[6],p0[7]);
      pw[0]=__builtin_bit_cast(bf16x8,wq);
      DVRDC(vb,vpp,3);
      o[0]=__builtin_amdgcn_mfma_f32_32x32x16_bf16(DVF(va,0),pw[2],o[0],0,0,0);
      p1[0]=__builtin_amdgcn_exp2f(p1[0]); p1[1]=__builtin_amdgcn_exp2f(p1[1]); ls1+=p1[0]+p1[1];
      wq.x=cvtpk_s(p0[8],p0[9]);
      o[1]=__builtin_amdgcn_mfma_f32_32x32x16_bf16(DVF(va,1),pw[2],o[1],0,0,0);
      p1[2]=__builtin_amdgcn_exp2f(p1[2]); p1[3]=__builtin_amdgcn_exp2f(p1[3]); ls1+=p1[2]+p1[3];
      wq.y=cvtpk_s(p0[10],p0[11]);
      o[2]=__builtin_amdgcn_mfma_f32_32x32x16_bf16(DVF(va,2),pw[2],o[2],0,0,0);
      p1[4]=__builtin_amdgcn_exp2f(p1[4]); p1[5]=__builtin_amdgcn_exp2f(p1[5]); ls1+=p1[4]+p1[5];
      wq.z=cvtpk_s(p0[12],p0[13]);
      o[3]=__builtin_amdgcn_mfma_f32_32x32x16_bf16(DVF(va,3),pw[2],o[3],0,0,0);
      p1[6]=__builtin_amdgcn_exp2f(p1[6]); p1[7]=__builtin_amdgcn_exp2f(p1[7]); ls1+=p1[6]+p1[7];
      wq.w=cvtpk_s(p0[14],p0[15]);
      pw[1]=__builtin_bit_cast(bf16x8,wq);
      o[0]=__builtin_amdgcn_mfma_f32_32x32x16_bf16(DVF(vb,0),pw[3],o[0],0,0,0);
      p1[8]=__builtin_amdgcn_exp2f(p1[8]); p1[9]=__builtin_amdgcn_exp2f(p1[9]); ls1+=p1[8]+p1[9];
      wq.x=cvtpk_s(p1[0],p1[1]);
      o[1]=__builtin_amdgcn_mfma_f32_32x32x16_bf16(DVF(vb,1),pw[3],o[1],0,0,0);
      p1[10]=__builtin_amdgcn_exp2f(p1[10]); p1[11]=__builtin_amdgcn_exp2f(p1[11]); ls1+=p1[10]+p1[11];
      wq.y=cvtpk_s(p1[2],p1[3]);
      o[2]=__builtin_amdgcn_mfma_f32_32x32x16_bf16(DVF(vb,2),pw[3],o[2],0,0,0);
      p1[12]=__builtin_amdgcn_exp2f(p1[12]); p1[13]=__builtin_amdgcn_exp2f(p1[13]); ls1+=p1[12]+p1[13];
      wq.z=cvtpk_s(p1[4],p1[5]);
      o[3]=__builtin_amdgcn_mfma_f32_32x32x16_bf16(DVF(vb,3),pw[3],o[3],0,0,0);
      p1[14]=__builtin_amdgcn_exp2f(p1[14]); p1[15]=__builtin_amdgcn_exp2f(p1[15]); ls1+=p1[14]+p1[15];
      wq.w=cvtpk_s(p1[6],p1[7]);
      pw[2]=__builtin_bit_cast(bf16x8,wq);
      wq.x=cvtpk_s(p1[8],p1[9]); wq.y=cvtpk_s(p1[10],p1[11]); wq.z=cvtpk_s(p1[12],p1[13]); wq.w=cvtpk_s(p1[14],p1[15]); pw[3]=__builtin_bit_cast(bf16x8,wq);
      l+=ls0+ls1;
    }
  }
  if(TI>0){ const lds_cptr vpp=vp0+((t+3)&3)*VSLOT; s16x4 va[8],vb[8]; DVRDC(va,vpp,0); DVRDC(vb,vpp,1); PV_PLAIN(vpp); }
  for(;t<NT;++t){
    const int slot=t&3;
    if(t+1<NT){DWAIT_BAR(3);}else{DWAIT_BAR(0);}
    if(t+2<NT){ DDMA(t+2,(t+2)&3); }
    const lds_cptr kp=kp0+slot*KSLOT; const lds_cptr vp=vp0+slot*VSLOT;
    #pragma unroll
    for(int s=0;s<2;++s){
      const int key0=64*t+32*s;
      if(key0>qfirst+31)continue;
      f32x16 p=f32x16{};
      #pragma unroll
      for(int d0=0;d0<4;++d0){ const bf16x8 kf=*(const __attribute__((address_space(3))) bf16x8*)(kp+d0*2048+s*512); p=__builtin_amdgcn_mfma_f32_32x32x16_bf16(kf,qr[d0],p,0,0,0); }
      if(key0+31>qfirst){
        #pragma unroll
        for(int r=0;r<16;++r){ const int kv=key0+(r&3)+8*(r>>2)+4*hi; if(kv>qme)p[r]=-INFINITY; } }
      float mt=__builtin_fmaxf(p[0],p[1]);
      #pragma unroll
      for(int r=2;r<16;++r)mt=__builtin_fmaxf(mt,p[r]);
      { auto rr=__builtin_amdgcn_permlane32_swap(__float_as_uint(mt),__float_as_uint(mt),false,false); mt=__builtin_fmaxf(__uint_as_float(rr[0]),__uint_as_float(rr[1])); }
      const bool first=(t==0&&s==0);
      if(first||__any(mt>mref+8.0f)){
        const float mnew=first?mt:__builtin_fmaxf(mref,mt); const float alpha=first?1.0f:__builtin_amdgcn_exp2f(mref-mnew);
        #pragma unroll
        for(int cb=0;cb<4;++cb)o[cb]=o[cb]*alpha;
        l*=alpha; mref=mnew; }
      float ls=0.f;
      #pragma unroll
      for(int r=0;r<16;++r){ p[r]=__builtin_amdgcn_exp2f(p[r]-mref); ls+=p[r]; }
      l+=ls;
      u32x4 w0,w1; w0.x=cvtpk_s(p[0],p[1]);w0.y=cvtpk_s(p[2],p[3]);w0.z=cvtpk_s(p[4],p[5]);w0.w=cvtpk_s(p[6],p[7]);
      w1.x=cvtpk_s(p[8],p[9]);w1.y=cvtpk_s(p[10],p[11]);w1.z=cvtpk_s(p[12],p[13]);w1.w=cvtpk_s(p[14],p[15]);
      const bf16x8 pb0=__builtin_bit_cast(bf16x8,w0),pb1=__builtin_bit_cast(bf16x8,w1);
      #pragma unroll
      for(int cb=0;cb<4;++cb){
        const int off=(cb>>1)*8192+(cb&1)*4096+(2*s)*1024;
        const s16x4 a0=vtr(vp+off),a1=vtr(vp+off+512),c0=vtr(vp+off+1024),c1=vtr(vp+off+1536);
        const bf16x8 v0=(bf16x8){a0[0],a0[1],a0[2],a0[3],a1[0],a1[1],a1[2],a1[3]},v1=(bf16x8){c0[0],c0[1],c0[2],c0[3],c1[0],c1[1],c1[2],c1[3]};
        o[cb]=__builtin_amdgcn_mfma_f32_32x32x16_bf16(v0,pb0,o[cb],0,0,0);
        o[cb]=__builtin_amdgcn_mfma_f32_32x32x16_bf16(v1,pb1,o[cb],0,0,0); }
    }

  }
  { auto rr=__builtin_amdgcn_permlane32_swap(__float_as_uint(l),__float_as_uint(l),false,false); l=__uint_as_float(rr[0])+__uint_as_float(rr[1]); }
  const float inv=__builtin_amdgcn_rcpf(l);
  DWAIT_BAR(0);
  const lds_ptr stg=(lds_ptr)shm+wid*OST_WAVE;
  #pragma unroll
  for(int cb=0;cb<4;++cb)
    #pragma unroll
    for(int g=0;g<4;++g){ u32x2 w; w.x=cvtpk_s(o[cb][4*g]*inv,o[cb][4*g+1]*inv); w.y=cvtpk_s(o[cb][4*g+2]*inv,o[cb][4*g+3]*inv);
      *(__attribute__((address_space(3))) u32x2*)(stg+r32*OST_ROW+(32*cb+8*g+4*hi)*2)=w; }
  asm volatile("s_waitcnt lgkmcnt(0)":::"memory");
  bf16*Ow=O+(rowbase+q0+wid*32)*(long)opitch;
  #pragma unroll
  for(int i=0;i<8;++i){ const int row=i*4+(lane>>4),ch=lane&15; const u32x4 v=*(const __attribute__((address_space(3))) u32x4*)(stg+row*OST_ROW+ch*16); *(u32x4*)(Ow+(long)row*opitch+ch*8)=v; }
  asm volatile("s_waitcnt lgkmcnt(0)\n\ts_barrier":::"memory");
  #undef DDMA
  #undef SBARR
  #undef DVRD
  #undef DVF
  #undef DPV
  #undef PV_PLAIN
  #undef DVRDC
  #undef DPVC
  #undef EXPS_PLAIN
}
struct DiffUnit { int bh; int qb; int m; };
struct DiffOrder {
  int vcu, G;
  __device__ __forceinline__ DiffOrder(int vcu_,int G_):vcu(vcu_),G(G_){}
  __device__ __forceinline__ bool next(int i,DiffUnit&u)const{
    const int ii=i>>1; u.m=i&1;
    if(G==256){ if(i>=4)return false; const int s=vcu&15; u.bh=vcu>>4; u.qb=ii?31-s:s; return true; }
    const int un=vcu+ii*G; if(un>=512)return false; u.bh=un>>5; u.qb=un&31; return true; }
};
__device__ __forceinline__ void diff_phase(char*shm,const unsigned short*PROJ,unsigned short*OA,const DiffOrder&S){
  DiffUnit u;
  for(int i=0;S.next(i,u);++i){
    const int h=u.bh&7;
    const bf16*Qp=(const bf16*)PROJ+h*128+u.m*64;
    unit(u.bh>>3,u.qb,Qp,Qp+1024,(const bf16*)PROJ+2048+h*128,u.m?((bf16*)PROJ+h*128):((bf16*)OA+h*128),u.m?DM:1024,shm);
  }
}
__device__ __forceinline__ float bflo(unsigned w){return __builtin_bit_cast(float,w<<16);}
__device__ __forceinline__ float bfhi(unsigned w){return __builtin_bit_cast(float,w&0xffff0000u);}
__device__ __forceinline__ void diff_combine(const unsigned short*PROJ,unsigned short*OA,const DiffOrder&S,float lam){
  asm volatile("s_waitcnt vmcnt(0)":::"memory");
  int tid_=threadIdx.x; asm volatile("":"+v"(tid_));
  const int lane=tid_&63; const int wid=__builtin_amdgcn_readfirstlane(tid_>>6); const int c8=(lane&7)*8;
  DiffUnit u;
  for(int i=0;S.next(i,u);i+=2){
    const int h=u.bh&7; const long row0=(long)(u.bh>>3)*SEQ+u.qb*QB+wid*32+(lane>>3);
    #pragma unroll 1
    for(int it=0;it<4;++it){
      unsigned short*ma=OA+(row0+it*8)*1024+h*128+c8; const unsigned short*pb=PROJ+(row0+it*8)*DM+h*128+c8;
      const u32x4 a0=*(const u32x4*)ma,a1=*(const u32x4*)(ma+64),b0=*(const u32x4*)pb,b1=*(const u32x4*)(pb+64);
      float o0[8],o1[8]; float ss=0.f;
      #pragma unroll
      for(int k=0;k<4;++k){ o0[2*k]=bflo(a0[k])-lam*bflo(b0[k]); o0[2*k+1]=bfhi(a0[k])-lam*bfhi(b0[k]); o1[2*k]=bflo(a1[k])-lam*bflo(b1[k]); o1[2*k+1]=bfhi(a1[k])-lam*bfhi(b1[k]); }
      #pragma unroll
      for(int k=0;k<8;++k)ss+=o0[k]*o0[k]+o1[k]*o1[k];
      ss+=__shfl_xor(ss,1); ss+=__shfl_xor(ss,2); ss+=__shfl_xor(ss,4);
      const float rs=__builtin_amdgcn_rsqf(ss*(1.0f/128.0f)+1e-6f);
      u32x4 w0,w1;
      #pragma unroll
      for(int k=0;k<4;++k){ w0[k]=cvtpk_s(o0[2*k]*rs,o0[2*k+1]*rs); w1[k]=cvtpk_s(o1[2*k]*rs,o1[2*k+1]*rs); }
      *(u32x4*)ma=w0; *(u32x4*)(ma+64)=w1;
    }
  }
}
#undef DWAIT_BAR
}
#include <hip/hip_cooperative_groups.h>
namespace cg = cooperative_groups;
constexpr int NWAVES = 8;
constexpr int SEQ = 8192, DMOD = 1024, MTOK = 2 * SEQ, FF = 4096;
constexpr int P0W = 2560;
constexpr int P1W = 3072;
constexpr float QSCALE = 0.125f * 1.4426950408889634f;
constexpr float LAMBDA_INIT1 = 0.35550906f;
constexpr size_t MiB = 1u << 20;
constexpr size_t WS_CTL = 0, CTL_ZERO_BYTES = 1 * MiB;
constexpr size_t WS_SSQ = 65536;
constexpr size_t WS_W = 2 * MiB;
constexpr size_t W_IN = 0, W_OUT = 6 * MiB, W_UP = 8 * MiB, W_DOWN = 16 * MiB, W_LAYER = 24 * MiB;
constexpr size_t WS_XB = 50 * MiB;
constexpr size_t WS_PROJ = 82 * MiB;
constexpr size_t WS_VT = WS_PROJ + 80 * MiB;
constexpr size_t WS_MIX = 178 * MiB;
constexpr size_t WS_H = WS_PROJ;
constexpr size_t WS_END = 210 * MiB;
constexpr int RING_BYTES = 131072, LDS_BYTES = 147456;

#define GAS __attribute__((address_space(1)))
#define LAS __attribute__((address_space(3)))
typedef unsigned short bf16;
typedef unsigned v4u __attribute__((ext_vector_type(4)));
typedef float f32x4 __attribute__((ext_vector_type(4)));
typedef short bf16x8 __attribute__((ext_vector_type(8)));
typedef float f32x16 __attribute__((ext_vector_type(16)));
#define LDS_WAIT() asm volatile("s_waitcnt lgkmcnt(0)" ::: "memory")
__device__ __forceinline__ unsigned f2bf(float f) { unsigned u = __builtin_bit_cast(unsigned, f); return (u + 0x7fffu + ((u >> 16) & 1u)) >> 16; }
__device__ __forceinline__ unsigned pk2(float lo, float hi) { return f2bf(lo) | (f2bf(hi) << 16); }
__device__ __forceinline__ float bf_lo(unsigned w) { return __builtin_bit_cast(float, w << 16); }
__device__ __forceinline__ float bf_hi(unsigned w) { return __builtin_bit_cast(float, w & 0xffff0000u); }
__device__ __forceinline__ float wave_sum(float v) {
#pragma unroll
    for (int o = 1; o < 64; o <<= 1) v += __shfl_xor(v, o);
    return v;
}
__device__ __forceinline__ void x_rows2_to_bf16(const float* xrow, bf16* orow, float* ssq, int lane) {
    const GAS f32x4* xr = (const GAS f32x4*)xrow + lane;
    f32x4 v[8]; float s0 = 0.f, s1 = 0.f;
#pragma unroll
    for (int j = 0; j < 8; ++j) v[j] = __builtin_nontemporal_load(xr + 64 * j);
#pragma unroll
    for (int j = 0; j < 4; ++j) { s0 += (v[j].x * v[j].x + v[j].y * v[j].y) + (v[j].z * v[j].z + v[j].w * v[j].w); s1 += (v[4 + j].x * v[4 + j].x + v[4 + j].y * v[4 + j].y) + (v[4 + j].z * v[4 + j].z + v[4 + j].w * v[4 + j].w); }
    s0 = wave_sum(s0); s1 = wave_sum(s1); if (lane == 0) { ssq[0] = s0; ssq[1] = s1; }
    GAS unsigned long long* o8 = (GAS unsigned long long*)orow + lane;
#pragma unroll
    for (int j = 0; j < 8; ++j) o8[64 * j] = (unsigned long long)pk2(v[j].x, v[j].y) | ((unsigned long long)pk2(v[j].z, v[j].w) << 32);
}

__device__ __forceinline__ int swap23(int i) { return (i & ~12) | ((i & 4) << 1) | ((i & 8) >> 1); }
__device__ __forceinline__ unsigned cvtpk2(float lo, float hi) { typedef float f2 __attribute__((ext_vector_type(2))); typedef __bf16 b2 __attribute__((ext_vector_type(2))); f2 v = {lo, hi}; b2 b = __builtin_convertvector(v, b2); return __builtin_bit_cast(unsigned, b); }
__device__ __forceinline__ void sb_unit(int b, int h, int qb, const bf16* __restrict__ proj, const bf16* __restrict__ Vt, bf16* __restrict__ mix, LAS unsigned char* stage, int lane) {
    const int r32 = lane & 31, hi = lane >> 5;
    const size_t rowbase = (size_t)b * SEQ; const int t0 = qb * 32;
    const bf16* qp = proj + (rowbase + t0 + r32) * P0W + h * 64 + hi * 8;
    bf16x8 qr[4];
#pragma unroll
    for (int d0 = 0; d0 < 4; ++d0) qr[d0] = *(const bf16x8*)(qp + d0 * 16);
    const bf16* kbase = proj + (rowbase + swap23(r32)) * P0W + 512 + h * 64 + hi * 8;
    const bf16* vbase = Vt + (size_t)(h * 64 + r32) * MTOK + rowbase + hi * 8;
    f32x16 o0 = {}, o1 = {};
    float R = 0.f;
#define SB_LOAD(KF, VF, kt_) do { const bf16* kp = kbase + (size_t)(kt_) * 32 * P0W; const bf16* vp = vbase + (kt_) * 32; \
        _Pragma("unroll") for (int d0 = 0; d0 < 4; ++d0) KF[d0] = *(const bf16x8*)(kp + d0 * 16); \
        VF[0] = *(const bf16x8*)(vp); VF[1] = *(const bf16x8*)(vp + 16); VF[2] = *(const bf16x8*)(vp + (size_t)32 * MTOK); VF[3] = *(const bf16x8*)(vp + (size_t)32 * MTOK + 16); } while (0)
#define SB_COMPUTE(KF, VF, kt_) do { \
        f32x16 p = {}; \
        _Pragma("unroll") for (int d0 = 0; d0 < 4; ++d0) p = __builtin_amdgcn_mfma_f32_32x32x16_bf16(KF[d0], qr[d0], p, 0, 0, 0); \
        const bool diag = ((kt_) == qb); \
        float sp[16], lb[16]; \
        _Pragma("unroll") for (int r = 0; r < 16; ++r) { const float z = p[r]; const float e = __builtin_amdgcn_exp2f(-__builtin_fabsf(z)); const float l = __builtin_amdgcn_logf(1.0f + e); \
            sp[r] = __builtin_fmaxf(z, 0.f) + l; lb[r] = __builtin_fminf(z, 0.f) - l; \
            if (diag) { const int koff = (r & 7) + 8 * hi + 16 * (r >> 3); if (koff >= r32) { sp[r] = 0.f; lb[r] = -INFINITY; } } } \
        float ex[16], G0, G1; \
        { float run = 0.f; \
          _Pragma("unroll") for (int j = 7; j >= 0; --j) { ex[j] = run; run += sp[j]; } G0 = run; run = 0.f; \
          _Pragma("unroll") for (int j = 7; j >= 0; --j) { ex[8 + j] = run; run += sp[8 + j]; } G1 = run; } \
        const float Gp0 = __shfl_xor(G0, 32), Gp1 = __shfl_xor(G1, 32); \
        const float base1 = R + (hi ? 0.f : Gp1), base0 = R + G1 + Gp1 + (hi ? 0.f : Gp0); \
        float w[16]; \
        _Pragma("unroll") for (int r = 0; r < 16; ++r) w[r] = __builtin_amdgcn_exp2f(lb[r] - ((r < 8) ? base0 : base1) - ex[r]); \
        R += (G0 + G1) + (Gp0 + Gp1); \
        v4u a0, a1; a0.x = cvtpk2(w[0], w[1]); a0.y = cvtpk2(w[2], w[3]); a0.z = cvtpk2(w[4], w[5]); a0.w = cvtpk2(w[6], w[7]); \
        a1.x = cvtpk2(w[8], w[9]); a1.y = cvtpk2(w[10], w[11]); a1.z = cvtpk2(w[12], w[13]); a1.w = cvtpk2(w[14], w[15]); \
        const bf16x8 pa0 = __builtin_bit_cast(bf16x8, a0), pa1 = __builtin_bit_cast(bf16x8, a1); \
        o0 = __builtin_amdgcn_mfma_f32_32x32x16_bf16(pa0, VF[0], o0, 0, 0, 0); o0 = __builtin_amdgcn_mfma_f32_32x32x16_bf16(pa1, VF[1], o0, 0, 0, 0); \
        o1 = __builtin_amdgcn_mfma_f32_32x32x16_bf16(pa0, VF[2], o1, 0, 0, 0); o1 = __builtin_amdgcn_mfma_f32_32x32x16_bf16(pa1, VF[3], o1, 0, 0, 0); \
        done = __all(R > 151.0f) != 0; } while (0)
    bf16x8 kA[4], vA[4], kB[4], vB[4];
    SB_LOAD(kA, vA, qb);
#pragma unroll
    for (int d0 = 0; d0 < 4; ++d0) { kB[d0] = kA[d0]; vB[d0] = vA[d0]; }
    if (qb > 0) SB_LOAD(kB, vB, qb - 1);
    bool done = false;
    for (int kt = qb;; kt -= 2) {
        SB_COMPUTE(kA, vA, kt);
        if (done || kt < 1) break;
        if (kt >= 2) SB_LOAD(kA, vA, kt - 2);
        SB_COMPUTE(kB, vB, kt - 1);
        if (done || kt < 2) break;
        if (kt >= 3) SB_LOAD(kB, vB, kt - 3);
    }
#undef SB_LOAD
#undef SB_COMPUTE
    LAS bf16* stg = (LAS bf16*)stage;
#pragma unroll
    for (int r = 0; r < 16; ++r) { const int orow = (r & 3) + 8 * (r >> 2) + 4 * hi; stg[orow * 64 + r32] = (bf16)f2bf(o0[r]); stg[orow * 64 + 32 + r32] = (bf16)f2bf(o1[r]); }
    LDS_WAIT(); asm volatile("" ::: "memory");
    bf16* op = mix + (rowbase + t0) * 1024 + h * 64;
#pragma unroll
    for (int i = 0; i < 4; ++i) { const int row = i * 8 + (lane >> 3), ch = lane & 7; const v4u v = *(const LAS v4u*)(stg + row * 64 + ch * 8); *(v4u*)(op + (size_t)row * 1024 + ch * 8) = v; }
    LDS_WAIT(); asm volatile("" ::: "memory");
}
__device__ __forceinline__ void conv_items(const bf16* __restrict__ proj, const float* __restrict__ cw, bf16* __restrict__ mix, int gtid, int nthreads) {
    for (int it = gtid; it < (MTOK / 8) * 64; it += nthreads) {
        const int rb = it >> 6, ch = (it & 63) * 8, m0 = rb * 8;
        float w0[8], w1[8], w2[8], c2[8], c1[8];
#pragma unroll
        for (int i = 0; i < 8; ++i) { w0[i] = cw[ch + i]; w1[i] = cw[512 + ch + i]; w2[i] = cw[1024 + ch + i]; c2[i] = 0.f; c1[i] = 0.f; }
        if ((m0 & (SEQ - 1)) != 0) {
            const v4u Ca = *(const v4u*)(proj + (size_t)(m0 - 2) * P0W + 1536 + ch), Ua = *(const v4u*)(proj + (size_t)(m0 - 2) * P0W + 2048 + ch);
            const v4u Cb = *(const v4u*)(proj + (size_t)(m0 - 1) * P0W + 1536 + ch), Ub = *(const v4u*)(proj + (size_t)(m0 - 1) * P0W + 2048 + ch);
#pragma unroll
            for (int i = 0; i < 4; ++i) { c2[2 * i] = bf_lo(Ca[i]) * bf_lo(Ua[i]); c2[2 * i + 1] = bf_hi(Ca[i]) * bf_hi(Ua[i]); c1[2 * i] = bf_lo(Cb[i]) * bf_lo(Ub[i]); c1[2 * i + 1] = bf_hi(Cb[i]) * bf_hi(Ub[i]); }
        }
#pragma unroll
        for (int r = 0; r < 8; ++r) { const bf16* rp = proj + (size_t)(m0 + r) * P0W + ch;
            const v4u Bv = __builtin_nontemporal_load((const v4u*)(rp + 1024)), Cv = __builtin_nontemporal_load((const v4u*)(rp + 1536)), Uv = __builtin_nontemporal_load((const v4u*)(rp + 2048));
            float c0[8], y[8];
#pragma unroll
            for (int i = 0; i < 4; ++i) { c0[2 * i] = bf_lo(Cv[i]) * bf_lo(Uv[i]); c0[2 * i + 1] = bf_hi(Cv[i]) * bf_hi(Uv[i]); }
#pragma unroll
            for (int i = 0; i < 8; ++i) y[i] = w0[i] * c2[i] + w1[i] * c1[i] + w2[i] * c0[i];
            v4u o;
#pragma unroll
            for (int i = 0; i < 4; ++i) o[i] = pk2(bf_lo(Bv[i]) * y[2 * i], bf_hi(Bv[i]) * y[2 * i + 1]);
            *(v4u*)(mix + (size_t)(m0 + r) * 1024 + 512 + ch) = o;
#pragma unroll
            for (int i = 0; i < 8; ++i) { c2[i] = c1[i]; c1[i] = c0[i]; } }
    }
}

typedef GAS unsigned gu32;
#define RLX_AGENT __ATOMIC_RELAXED, __HIP_MEMORY_SCOPE_AGENT
constexpr int CW_PANEL = 8192;
constexpr int CW_BAR = 4096;
constexpr int LDSCTL_OFF = RING_BYTES, MISC_OFF = LDSCTL_OFF + 320;
#define XB_TMO      128
#define XB_XCNT(j)  (256  + 64 * (j))
#define XB_XSUB(j)  (1280 + 64 * (j))
#define XB_XGEN(j)  (2304 + 64 * (j))
#define XB_TOP      3328
#define XB_TOPGEN   3392
#define XCD_BAR_WORDS 3456
#define XB_SPIN_CAP (1u << 18)

__device__ __forceinline__ unsigned xb_ld(unsigned* p)              { return __hip_atomic_load(p, __ATOMIC_RELAXED, __HIP_MEMORY_SCOPE_AGENT); }
__device__ __forceinline__ unsigned xb_add(unsigned* p, unsigned v) { return __hip_atomic_fetch_add(p, v, __ATOMIC_RELAXED, __HIP_MEMORY_SCOPE_AGENT); }
__device__ __forceinline__ unsigned xb_xcc_id() { return (unsigned)__builtin_amdgcn_s_getreg((3 << 11) | 20) & 0xFu; }
#define XB_SPIN(cond, bar) do { unsigned _sp = 0; while (cond) { __builtin_amdgcn_s_sleep(1); \
    if ((++_sp & 255u) == 0u) { if (xb_ld(&(bar)[XB_TMO])) break; if (_sp > XB_SPIN_CAP) { atomicAdd(&(bar)[XB_TMO], 1u); break; } } } } while (0)

struct XcdBarrier {
    unsigned* bar; unsigned x;
    volatile LAS unsigned* st;
};

__device__ __forceinline__ XcdBarrier xcd_barrier_post(unsigned* bar, volatile LAS unsigned* st) {
    XcdBarrier b; b.bar = bar; b.x = xb_xcc_id(); b.st = st;
    if (threadIdx.x == 0) (void)xb_add(&bar[XB_XCNT(b.x)], 1u);
    return b;
}
__device__ __forceinline__ void xcd_barrier_complete(unsigned* bar, unsigned x, unsigned& nloc, unsigned& nx) {
    const unsigned G = gridDim.x * gridDim.y * gridDim.z;
    unsigned sum, cnt, mine, sp = 0u;
    for (;;) {
        sum = 0u; cnt = 0u; mine = 0u;
#pragma unroll
        for (unsigned j = 0; j < 16; ++j) { const unsigned c = xb_ld(&bar[XB_XCNT(j)]); sum += c; cnt += (c > 0u) ? 1u : 0u; mine = (j == x) ? c : mine; }
        if (sum == G) break;
        __builtin_amdgcn_s_sleep(1);
        if ((++sp & 255u) == 0u) { if (xb_ld(&bar[XB_TMO])) break; if (sp > XB_SPIN_CAP) { atomicAdd(&bar[XB_TMO], 1u); break; } }
    }
    nloc = mine > 0u ? mine : 1u; nx = cnt > 0u ? cnt : 1u;
}

__device__ __forceinline__ void xcd_barrier_thread0(const XcdBarrier& b) {
    {
        unsigned* bar = b.bar;
        __builtin_amdgcn_s_waitcnt(0);
        unsigned nloc = b.st[0], nx = b.st[1];
        if (nloc == 0u) { xcd_barrier_complete(bar, b.x, nloc, nx); b.st[0] = nloc; b.st[1] = nx; }
        const unsigned old = xb_add(&bar[XB_XSUB(b.x)], 1u);
        const unsigned gen = old / nloc;
        if (old + 1u == (gen + 1u) * nloc) {
            __builtin_amdgcn_fence(__ATOMIC_RELEASE, "agent");
            asm volatile("s_waitcnt vmcnt(0)" ::: "memory");
            const unsigned og = xb_add(&bar[XB_TOP], 1u);
            const unsigned tg = og / nx;
            if (og + 1u == (tg + 1u) * nx) xb_add(&bar[XB_TOPGEN], 1u);
            else XB_SPIN(xb_ld(&bar[XB_TOPGEN]) == tg, bar);
            __builtin_amdgcn_fence(__ATOMIC_ACQUIRE, "agent");
            xb_add(&bar[XB_XGEN(b.x)], 1u);
            asm volatile("s_waitcnt vmcnt(0)" ::: "memory");
        } else {
            XB_SPIN(xb_ld(&bar[XB_XGEN(b.x)]) == gen, bar);
            __builtin_amdgcn_fence(__ATOMIC_ACQUIRE, "agent");
            asm volatile("s_waitcnt vmcnt(0)" ::: "memory");
        }
    }
}
__device__ __forceinline__ void xcd_barrier(const XcdBarrier& b) {
    asm volatile("s_waitcnt vmcnt(0)" ::: "memory");
    __syncthreads();
    if (threadIdx.x == 0) xcd_barrier_thread0(b);
    __syncthreads();
}
#define LAYER_TAIL(layer) \
        { PHASE_IDS pg8::Gemm g{MIXp, WLp(layer, W_OUT), MTOK, 1024, 1024}; pg8::StaticOrder S; S.init(MTOK, 1024, G, bx); \
          pg8::EpiRes E{layer ? (const float*)XRES : XIN, XRES, XBp, SSQ(2 * layer + 1)}; \
          pg8::gemm_phase<pg8::EpiRes, pg8::StaticOrder, PG8_ALIGN, PG8_SP2>(ldsp, g, S, E); } \
        if (layer == 0) xcd_barrier_work(bar, args, WSLICE(3), ldsp); else xcd_barrier(bar); \
        { PHASE_IDS pg8::Gemm g{XBp, WLp(layer, W_UP), MTOK, FF, 1024}; pg8::StaticOrder S; S.init(MTOK, FF, G, bx); \
          pg8::EpiRow<1> E{HBp, FF, SSQ(2 * layer + 1), 0, 1.f}; \
          pg8::gemm_phase<pg8::EpiRow<1>, pg8::StaticOrder, PG8_ALIGN, PG8_SP2>(ldsp, g, S, E); } \
        if (layer == 0) xcd_barrier_work(bar, args, WSLICE(4), ldsp); else xcd_barrier(bar); \
        if (layer == 1 && gridDim.x == 256) {     \
          PHASE_IDS pg8::Gemm g{HBp, WLp(layer, W_DOWN), MTOK, 1024, FF}; pg8::StaticOrder S; S.init(MTOK, 1024, G, bx); \
          pg8::EpiResFinal E{XRES, XRES, SSQ(4), (unsigned*)(args.ws + WS_CTL) + CW_PANEL, args.in[3]}; \
          pg8::gemm_phase<pg8::EpiResFinal, pg8::StaticOrder, false, PG8_SP2>(ldsp, g, S, E); \
        } else { \
        { PHASE_IDS pg8::Gemm g{HBp, WLp(layer, W_DOWN), MTOK, 1024, FF}; pg8::StaticOrder S; S.init(MTOK, 1024, G, bx); \
          pg8::EpiRes E{XRES, XRES, XBp, SSQ(2 * layer + 2)}; \
          pg8::gemm_phase<pg8::EpiRes, pg8::StaticOrder, PG8_ALIGN, PG8_SP2>(ldsp, g, S, E); } \
        if (layer == 0) xcd_barrier_work(bar, args, WSLICE(5), ldsp); else xcd_barrier(bar); }
constexpr int I_IN = 16 * 96, I_OUT = 16 * 32, I_UP = 16 * 128, I_DN = 64 * 32, I_L = I_IN + I_OUT + I_UP + I_DN;
struct Args { const float* in[16]; float* out; unsigned char* ws; };
struct CvtItem { const float* wp; bf16* op; int N, K; f32x4 g0, g1; };
__device__ __forceinline__ void cvt_decode(const Args& args, int it, int lane, CvtItem& d) {
    const int l = it / I_L; int r = it % I_L;
    const float* W; bf16* WT; int K = 1024, N; const float* gs = nullptr; int gmask = 1023; float gmul = 1.f; bool remap = false;
    if (r < I_IN) { W = l ? args.in[7] : args.in[4]; N = 3072; WT = (bf16*)(args.ws + WS_W + (size_t)l * W_LAYER + W_IN); gs = args.in[1] + l * 1024; remap = (l == 0); }
    else if ((r -= I_IN) < I_OUT) { W = l ? args.in[13] : args.in[6]; N = 1024; WT = (bf16*)(args.ws + WS_W + (size_t)l * W_LAYER + W_OUT); gs = l ? args.in[12] : nullptr; gmask = 127; gmul = 1.0f - LAMBDA_INIT1; }
    else if ((r -= I_OUT) < I_UP) { W = args.in[14] + (size_t)l * 1024 * 4096; N = 4096; WT = (bf16*)(args.ws + WS_W + (size_t)l * W_LAYER + W_UP); gs = args.in[2] + l * 1024; }
    else { r -= I_UP; W = args.in[15] + (size_t)l * 4096 * 1024; K = 4096; N = 1024; WT = (bf16*)(args.ws + WS_W + (size_t)l * W_LAYER + W_DOWN); }
    const int nblk = N / 32, kb = r / nblk, nb = r % nblk, k0 = 64 * kb, n0 = 32 * nb, c = lane & 7;
    int r0 = n0; if (remap) r0 = n0 < 1024 ? n0 : (n0 < 1536 ? n0 + 1536 : n0 - 512);
    d.N = N; d.K = K; d.wp = W + (size_t)(k0 + (lane >> 3)) * N + n0 + 4 * c; d.op = WT + (size_t)(r0 + (lane >> 3)) * K + k0 + 8 * c;
    d.g0 = (f32x4){1.f, 1.f, 1.f, 1.f}; d.g1 = d.g0;
    if (gs) { const float* gp = gs + ((k0 + 8 * c) & gmask); d.g0 = *(const f32x4*)gp * gmul; d.g1 = *(const f32x4*)(gp + 4) * gmul; }
}
__device__ __forceinline__ void cvt_load(const CvtItem& d, f32x4 (&v)[8]) {
#pragma unroll
    for (int i = 0; i < 8; ++i) v[i] = __builtin_nontemporal_load((const f32x4*)(d.wp + (size_t)(8 * i) * d.N));
}
__device__ __forceinline__ void cvt_lds_write(const f32x4 (&v)[8], LAS float* scr, int lane) {
    const int c = lane & 7;
#pragma unroll
    for (int i = 0; i < 8; ++i) { LAS float* p = scr + (8 * i + (lane >> 3)) * 33 + 4 * c; p[0] = v[i][0]; p[1] = v[i][1]; p[2] = v[i][2]; p[3] = v[i][3]; }
    LDS_WAIT(); asm volatile("" ::: "memory");
}
__device__ __forceinline__ void cvt_lds_read_store(const CvtItem& d, LAS float* scr, int lane) {
    const int c = lane & 7;
#pragma unroll
    for (int j = 0; j < 4; ++j) { const LAS float* s = scr + (8 * c) * 33 + (lane >> 3) + 8 * j;
        v4u o; o.x = pk2(s[0 * 33] * d.g0[0], s[1 * 33] * d.g0[1]); o.y = pk2(s[2 * 33] * d.g0[2], s[3 * 33] * d.g0[3]); o.z = pk2(s[4 * 33] * d.g1[0], s[5 * 33] * d.g1[1]); o.w = pk2(s[6 * 33] * d.g1[2], s[7 * 33] * d.g1[3]);
        *(GAS v4u*)(d.op + (size_t)(8 * j) * d.K) = o; }
    LDS_WAIT(); asm volatile("" ::: "memory");
}
__device__ __forceinline__ void convert_items(const Args& args, int lo, int hi, int gw, int NGW, int lane, LAS float* scr) {
    int it = lo + gw; if (it >= hi) return;
    CvtItem A, B, C; f32x4 va[8], vb[8];
    cvt_decode(args, it, lane, A); cvt_load(A, va);
    bool hb = (it + NGW) < hi; B = A;
#pragma unroll
    for (int i = 0; i < 8; ++i) vb[i] = va[i];
    if (hb) { cvt_decode(args, it + NGW, lane, B); cvt_load(B, vb); }
    for (;;) {
        cvt_lds_write(va, scr, lane);
        const bool hc = (it + 2 * NGW) < hi; C = A;
        if (hc) { cvt_decode(args, it + 2 * NGW, lane, C); cvt_load(C, va); }
        cvt_lds_read_store(A, scr, lane);
        if (!hb) break;
        cvt_lds_write(vb, scr, lane);
        const bool hd = (it + 3 * NGW) < hi; A = B;
        CvtItem D = B;
        if (hd) { cvt_decode(args, it + 3 * NGW, lane, D); cvt_load(D, vb); }
        cvt_lds_read_store(A, scr, lane);
        if (!hc) break;
        A = C; B = D; hb = hd; it += 2 * NGW;
    }
}
#define CONVERT_ITEMS(lo, hi) convert_items(args, (lo), (hi), gw, NGW, lane, scr);
__device__ __forceinline__ void xcd_barrier_work(const XcdBarrier& b, const Args& args, int lo, int hi, LAS unsigned char* ldsp) {
    asm volatile("s_waitcnt vmcnt(0)" ::: "memory");
    __syncthreads();
    int tid = threadIdx.x; asm volatile("" : "+v"(tid));
    const int wave = __builtin_amdgcn_readfirstlane(tid >> 6);
    if (wave == 0) { if (tid == 0) xcd_barrier_thread0(b); }
    else { int G = gridDim.x, bx = blockIdx.x; asm volatile("" : "+s"(G), "+s"(bx)); const int vcu = (G % 8 == 0) ? (bx % 8) * (G / 8) + bx / 8 : bx;
           convert_items(args, lo, hi, vcu * 7 + (wave - 1), G * 7, tid & 63, (LAS float*)(ldsp + wave * 16384)); }
    __syncthreads();
}
constexpr int I_W = (2 * I_L - I_IN) / 6;
#define WSLICE(k) (I_IN + (k) * I_W), (I_IN + ((k) + 1) * I_W)
static_assert((2 * I_L - I_IN) % 6 == 0 && I_IN + 1 * I_W >= I_IN + I_OUT && I_IN + 2 * I_W >= I_IN + I_OUT + I_UP && I_IN + 3 * I_W >= I_L && I_IN + 4 * I_W >= I_L + I_IN + I_OUT, "slice k is published by barrier k+1: out0 by 1, up0 by 2, down0 by 3, in1 by 4, out1 by 6, up1 by 7, down1 by 8");

__global__ void __launch_bounds__(NWAVES * 64, 2) mega_fwd(Args args) {
    extern __shared__ __attribute__((aligned(16))) unsigned char lds[];
    cg::grid_group grid = cg::this_grid();
    LAS unsigned char* ldsp = (LAS unsigned char*)lds;
    for (int u = threadIdx.x; u < (LDS_BYTES - LDSCTL_OFF) / 4; u += NWAVES * 64) ((LAS unsigned*)(ldsp + LDSCTL_OFF))[u] = 0u;
    __syncthreads();
    const XcdBarrier bar = xcd_barrier_post((unsigned*)(args.ws + WS_CTL) + CW_BAR, (volatile LAS unsigned*)(ldsp + MISC_OFF) + 8);
#define PHASE_IDS int tid = threadIdx.x; asm volatile("" : "+v"(tid)); const int lane = tid & 63, wave = __builtin_amdgcn_readfirstlane(tid >> 6); \
    int G = gridDim.x, bx = blockIdx.x; asm volatile("" : "+s"(G), "+s"(bx)); const int vcu = (G % 8 == 0) ? (bx % 8) * (G / 8) + bx / 8 : bx; \
    const int gw = vcu * NWAVES + wave, NGW = G * NWAVES; (void)lane; (void)gw; (void)NGW; (void)tid;
#define XIN   (args.in[0])
#define XRES  (args.out)
#define SSQ(i) ((float*)(args.ws + WS_SSQ) + (size_t)(i) * MTOK)
#define XBp   ((bf16*)(args.ws + WS_XB))
#define PROJp ((bf16*)(args.ws + WS_PROJ))
#define VTp   ((bf16*)(args.ws + WS_VT))
#define MIXp  ((bf16*)(args.ws + WS_MIX))
#define HBp   ((bf16*)(args.ws + WS_H))
#define WLp(l, off) ((bf16*)(args.ws + WS_W + (size_t)(l) * W_LAYER + (off)))

    {
        PHASE_IDS
        LAS float* scr = (LAS float*)(ldsp + wave * 16384);
        CONVERT_ITEMS(0, I_IN)
        for (int m = 2 * gw; m < MTOK; m += 2 * NGW) x_rows2_to_bf16(XIN + (size_t)m * 1024, XBp + (size_t)m * 1024, SSQ(0) + m, lane);
    }
    if (args.ws == nullptr) grid.sync();
    xcd_barrier_work(bar, args, WSLICE(0), ldsp);

    {
        { PHASE_IDS pg8::Gemm g{XBp, WLp(0, W_IN), MTOK, P0W, 1024}; pg8::StaticOrder S; S.init(MTOK, P0W, G, bx);
          pg8::EpiRow<0> E{PROJp, P0W, SSQ(0), 2, QSCALE};
          pg8::gemm_phase<pg8::EpiRow<0>, pg8::StaticOrder, PG8_ALIGN, PG8_SP2>(ldsp, g, S, E); }
        { PHASE_IDS pg8::Gemm g{WLp(0, W_IN) + (size_t)P0W * 1024, XBp, 512, MTOK, 1024}; pg8::StaticOrder S; S.init(512, MTOK, G, (bx + G / 2) % G);
          pg8::EpiColScale E{VTp, MTOK, SSQ(0)};
          pg8::gemm_phase<pg8::EpiColScale, pg8::StaticOrder, PG8_ALIGN, PG8_SP2>(ldsp, g, S, E); }
        xcd_barrier_work(bar, args, WSLICE(1), ldsp);
        { PHASE_IDS
          conv_items(PROJp, args.in[5], MIXp, vcu * (NWAVES * 64) + tid, G * NWAVES * 64);
          LAS float* scr = (LAS float*)(ldsp + wave * 16384);
          for (int u = gw; u < 2 * 8 * 256; u += NGW) sb_unit(u >> 11, (u >> 8) & 7, u & 255, PROJp, VTp, MIXp, ldsp + wave * 16384 + 8704, lane);
          (void)scr; }
        xcd_barrier_work(bar, args, WSLICE(2), ldsp);
        LAYER_TAIL(0)
    }
    {
        { PHASE_IDS pg8::Gemm g{XBp, WLp(1, W_IN), MTOK, P1W, 1024}; pg8::StaticOrder S; S.init(MTOK, P1W, G, bx);
          pg8::EpiRow<0> E{PROJp, P1W, SSQ(2), 4, QSCALE};
          pg8::gemm_phase<pg8::EpiRow<0>, pg8::StaticOrder, PG8_ALIGN, PG8_SP2>(ldsp, g, S, E); }
        xcd_barrier(bar);
        { PHASE_IDS const dattn::DiffOrder S(vcu, G); dattn::diff_phase((char*)lds, PROJp, MIXp, S); }
        { PHASE_IDS float lam;
          { const float a = wave_sum(args.in[8][lane] * args.in[9][lane]), c = wave_sum(args.in[10][lane] * args.in[11][lane]); lam = __expf(a) - __expf(c) + LAMBDA_INIT1; }
          const dattn::DiffOrder S(vcu, G); dattn::diff_combine(PROJp, MIXp, S, lam); }
        xcd_barrier(bar);
        LAYER_TAIL(1)
    }
    if (gridDim.x != 256) { PHASE_IDS const float* ssq_f = SSQ(4);
      f32x4 gv[4];
#pragma unroll
      for (int j = 0; j < 4; ++j) gv[j] = ((const f32x4*)args.in[3])[lane + 64 * j];
      for (int m = 2 * gw; m < MTOK; m += 2 * NGW) { const float rs0 = pg8::rstd_of(ssq_f[m]), rs1 = pg8::rstd_of(ssq_f[m + 1]); f32x4* xr = (f32x4*)(XRES + (size_t)m * 1024) + lane;
          f32x4 v[8];
#pragma unroll
          for (int j = 0; j < 8; ++j) v[j] = xr[64 * j];
#pragma unroll
          for (int j = 0; j < 4; ++j) { xr[64 * j] = v[j] * rs0 * gv[j]; xr[256 + 64 * j] = v[4 + j] * rs1 * gv[j]; } } }
}

extern "C" void kernel_launch(void* const* d_in, const int* in_sizes, int n_in, void* d_out, int out_size, void* d_ws, size_t ws_size, hipStream_t stream) {
    static int grid = 0;
    if (grid == 0) {
        if (n_in != 16 || in_sizes[0] != MTOK * DMOD || out_size != MTOK * DMOD || ws_size < WS_END) { fprintf(stderr, "kernel_launch: unexpected shapes (n_in %d, in0 %d, out %d, ws %zu)\n", n_in, n_in > 0 ? in_sizes[0] : -1, out_size, ws_size); grid = -1; return; }
        int dev = 0, cus = 0, per_cu = 0;
        if (hipGetDevice(&dev) != hipSuccess || hipDeviceGetAttribute(&cus, hipDeviceAttributeMultiprocessorCount, dev) != hipSuccess) { grid = -1; return; }
        if (hipFuncSetAttribute((const void*)mega_fwd, hipFuncAttributeMaxDynamicSharedMemorySize, LDS_BYTES) != hipSuccess) { fprintf(stderr, "kernel_launch: hipFuncSetAttribute failed\n"); grid = -1; return; }
        if (hipOccupancyMaxActiveBlocksPerMultiprocessor(&per_cu, (const void*)mega_fwd, NWAVES * 64, LDS_BYTES) != hipSuccess || per_cu < 1) { fprintf(stderr, "kernel_launch: occupancy query says %d\n", per_cu); per_cu = 1; }
        (void)hipGetLastError();
        grid = cus;
    }
    if (grid < 0) return;
    (void)hipMemsetAsync((char*)d_ws + WS_CTL, 0, CTL_ZERO_BYTES, stream);
    Args a{};
    for (int i = 0; i < 16; ++i) a.in[i] = (const float*)d_in[i];
    a.out = (float*)d_out; a.ws = (unsigned char*)d_ws;
    void* kargs[] = {&a};
    hipError_t e = hipLaunchCooperativeKernel((const void*)mega_fwd, dim3(grid), dim3(NWAVES * 64), kargs, LDS_BYTES, stream);
    if (e != hipSuccess) fprintf(stderr, "kernel_launch: cooperative launch failed: %s (grid %d)\n", hipGetErrorString(e), grid);
}
```

```cpp
#include <hip/hip_runtime.h>
#include <cstdio>
#include <cstdint>
namespace pg8 {
#define PG8_LAS __attribute__((address_space(3)))
typedef unsigned short bf16_t;
typedef short bf16x8 __attribute__((ext_vector_type(8)));
typedef float f32x4 __attribute__((ext_vector_type(4)));
typedef unsigned u32x4 __attribute__((ext_vector_type(4)));
constexpr int BM = 256, BK = 64, HALF = 128, HTB = HALF * BK * 2  , STAGE_BYTES = 8 * HTB, NXCD = 8, WGM = 8;

__host__ __device__ __forceinline__ int lds_byte(int r, int c) { const int st = (r >> 4) * 2 + (c >> 5), rr = r & 15, cc = c & 31, ob = rr * 64 + cc * 2; return st * 1024 + (ob ^ (((ob >> 9) & 1) << 5)); }
__host__ __device__ __forceinline__ void stage_rc(int b, int& R, int& C) { const int st = b / 1024, sb = b % 1024, swz = sb ^ (((sb >> 9) & 1) << 5); R = (st >> 1) * 16 + swz / 64; C = (st & 1) * 32 + (swz % 64) / 2; }
__host__ __device__ __forceinline__ int perm32(int rho) { const int n = rho >> 4, i = rho & 15; return 8 * (i >> 2) + 4 * n + (i & 3); }

struct Unit { int pm, pn; };
struct Gemm { const bf16_t* A; const bf16_t* Bt; int M, N, K; };

struct StaticOrder {
    int nM, nN, nwg, G, c;
    __host__ __device__ void init(int M, int N, int G_, int c_) { nM = M / BM; nN = N / BM; nwg = nM * nN; G = G_; c = c_; }
    __host__ __device__ bool next(int i, Unit& u) const {
        const long L = (long)i * G + c; if (L >= nwg) return false;
        int wgid = (int)L; { const int q = nwg / NXCD, r = nwg % NXCD, xcd = wgid % NXCD, off = wgid / NXCD; wgid = (xcd < r ? xcd * (q + 1) : r * (q + 1) + (xcd - r) * q) + off; }
        const int nig = WGM * nN, gid = wgid / nig, fm = gid * WGM, gsz = (nM - fm) < WGM ? (nM - fm) : WGM;
        u.pm = fm + ((wgid % nig) % gsz); u.pn = (wgid % nig) / gsz; return true;
    }
    __device__ __forceinline__ void a_ready(const Unit&) const {}
    __device__ __forceinline__ void done(const Unit&) const {}
};

__device__ __forceinline__ unsigned cvt_pk_bf16(float lo, float hi) { unsigned r; asm volatile("v_cvt_pk_bf16_f32 %0, %1, %2" : "=v"(r) : "v"(lo), "v"(hi)); return r; }
typedef float f32x2 __attribute__((ext_vector_type(2)));
__device__ __forceinline__ float rstd_of(float ssq) { return __builtin_amdgcn_rsqf(ssq * (1.0f / 1024.0f) + 1e-6f); }
typedef unsigned u32x2 __attribute__((ext_vector_type(2)));
template <int ACT> struct EpiRow {
    static constexpr bool PERM = true, AFTER_DRAIN = false;
    bf16_t* O; int ldc; const float* ssq; int qtiles; float qscale;
    __device__ __forceinline__ void operator()(const f32x4 (&acc)[2][2][4][2], const Unit& u, int wr, int wc, int fr, int fq) const {
        const int row0 = u.pm * BM + wr * 64 + fr, col0 = u.pn * BM + wc * 32 + 8 * fq;
        const float sc = (u.pn < qtiles) ? qscale : 1.f;
        float rsv[2][4];
#pragma unroll
        for (int ai = 0; ai < 2; ++ai)
#pragma unroll
            for (int m = 0; m < 4; ++m) rsv[ai][m] = ssq[row0 + ai * HALF + m * 16];
#pragma unroll
        for (int ai = 0; ai < 2; ++ai)
#pragma unroll
            for (int m = 0; m < 4; ++m) { const int row = row0 + ai * HALF + m * 16; const float rs = rstd_of(rsv[ai][m]) * sc; bf16_t* rowp = O + (size_t)row * ldc + col0;
#pragma unroll
                for (int bj = 0; bj < 2; ++bj) { f32x4 v0 = acc[ai][bj][m][0], v1 = acc[ai][bj][m][1];
                    if (ACT == 1) { const f32x4 z = {0.f, 0.f, 0.f, 0.f}; v0 = __builtin_elementwise_max(v0, z) * rs; v1 = __builtin_elementwise_max(v1, z) * rs; v0 = v0 * v0; v1 = v1 * v1; }
                    else { v0 = v0 * rs; v1 = v1 * rs; }
                    u32x4 w; w.x = cvt_pk_bf16(v0[0], v0[1]); w.y = cvt_pk_bf16(v0[2], v0[3]); w.z = cvt_pk_bf16(v1[0], v1[1]); w.w = cvt_pk_bf16(v1[2], v1[3]);
                    *(u32x4*)(rowp + bj * HALF) = w; } }
    }
};
struct EpiColScale {
    static constexpr bool PERM = true, AFTER_DRAIN = false;
    bf16_t* O; int ldc; const float* ssq;
    __device__ __forceinline__ void operator()(const f32x4 (&acc)[2][2][4][2], const Unit& u, int wr, int wc, int fr, int fq) const {
        const int row0 = u.pm * BM + wr * 64 + fr, col0 = u.pn * BM + wc * 32 + 8 * fq;
        f32x4 sv[2][2];
#pragma unroll
        for (int bj = 0; bj < 2; ++bj)
#pragma unroll
            for (int n = 0; n < 2; ++n) { const f32x4 s = *(const f32x4*)(ssq + col0 + bj * HALF + 4 * n); sv[bj][n] = (f32x4){rstd_of(s[0]), rstd_of(s[1]), rstd_of(s[2]), rstd_of(s[3])}; }
#pragma unroll
        for (int ai = 0; ai < 2; ++ai)
#pragma unroll
            for (int m = 0; m < 4; ++m) { bf16_t* rowp = O + (size_t)(row0 + ai * HALF + m * 16) * ldc + col0;
#pragma unroll
                for (int bj = 0; bj < 2; ++bj) { const f32x4 v0 = acc[ai][bj][m][0] * sv[bj][0], v1 = acc[ai][bj][m][1] * sv[bj][1];
                    u32x4 w; w.x = cvt_pk_bf16(v0[0], v0[1]); w.y = cvt_pk_bf16(v0[2], v0[3]); w.z = cvt_pk_bf16(v1[0], v1[1]); w.w = cvt_pk_bf16(v1[2], v1[3]);
                    *(u32x4*)(rowp + bj * HALF) = w; } }
    }
};
struct EpiRes {
    static constexpr bool PERM = false, AFTER_DRAIN = false;
    const float* base; float* out; bf16_t* xb; float* ssq;
    __device__ __forceinline__ void operator()(const f32x4 (&acc)[2][2][4][2], const Unit& u, int wr, int wc, int fr, int fq) const {
        const int row0 = u.pm * BM + wr * 64 + fr, col0 = u.pn * BM + wc * 32 + 4 * fq;
#pragma unroll
        for (int ai = 0; ai < 2; ++ai) {
            f32x4 pre[4][2][2];
#pragma unroll
            for (int m = 0; m < 4; ++m) { const size_t off = (size_t)(row0 + ai * HALF + m * 16) * 1024 + col0;
#pragma unroll
                for (int bj = 0; bj < 2; ++bj)
#pragma unroll
                    for (int n = 0; n < 2; ++n) pre[m][bj][n] = __builtin_nontemporal_load((const f32x4*)(base + off + bj * HALF + n * 16)); }
            asm volatile("" ::: "memory");
#pragma unroll
            for (int m = 0; m < 4; ++m) { const int row = row0 + ai * HALF + m * 16; const size_t off = (size_t)row * 1024 + col0; float s = 0.f;
#pragma unroll
                for (int bj = 0; bj < 2; ++bj)
#pragma unroll
                    for (int n = 0; n < 2; ++n) { const f32x4 v = pre[m][bj][n] + acc[ai][bj][m][n];
                        __builtin_nontemporal_store(v, (f32x4*)(out + off + bj * HALF + n * 16)); s += (v[0] * v[0] + v[1] * v[1]) + (v[2] * v[2] + v[3] * v[3]);
                        u32x2 w; w.x = cvt_pk_bf16(v[0], v[1]); w.y = cvt_pk_bf16(v[2], v[3]); *(u32x2*)(xb + off + bj * HALF + n * 16) = w; }
                s += __shfl_xor(s, 16); s += __shfl_xor(s, 32);
                if (fq == 0) __hip_atomic_fetch_add(ssq + row, s, __ATOMIC_RELAXED, __HIP_MEMORY_SCOPE_AGENT); }
            asm volatile("" ::: "memory");
        }
    }
};

struct EpiResFinal {
    static constexpr bool PERM = false, AFTER_DRAIN = true;
    const float* base; float* out; float* ssq; unsigned* cnt; const float* gain;
    __device__ __forceinline__ void operator()(const f32x4 (&)[2][2][4][2], const Unit&, int, int, int, int) const {}
    __device__ __forceinline__ void fused(f32x4 (&acc)[2][2][4][2], const Unit& u, int wr, int wc, int fr, int fq, PG8_LAS unsigned char*, int, int lane) const {
        const int row0 = u.pm * BM + wr * 64 + fr, col0 = u.pn * BM + wc * 32 + 4 * fq;
#pragma unroll
        for (int ai = 0; ai < 2; ++ai) {
            f32x4 pre[4][2][2];
#pragma unroll
            for (int m = 0; m < 4; ++m) { const size_t off = (size_t)(row0 + ai * HALF + m * 16) * 1024 + col0;
#pragma unroll
                for (int bj = 0; bj < 2; ++bj)
#pragma unroll
                    for (int n = 0; n < 2; ++n) pre[m][bj][n] = __builtin_nontemporal_load((const f32x4*)(base + off + bj * HALF + n * 16)); }
            asm volatile("" ::: "memory");
#pragma unroll
            for (int m = 0; m < 4; ++m) { const int row = row0 + ai * HALF + m * 16; float s = 0.f;
#pragma unroll
                for (int bj = 0; bj < 2; ++bj)
#pragma unroll
                    for (int n = 0; n < 2; ++n) { const f32x4 v = pre[m][bj][n] + acc[ai][bj][m][n]; acc[ai][bj][m][n] = v; s += (v[0] * v[0] + v[1] * v[1]) + (v[2] * v[2] + v[3] * v[3]); }
                s += __shfl_xor(s, 16); s += __shfl_xor(s, 32);
                if (fq == 0) __hip_atomic_fetch_add(ssq + row, s, __ATOMIC_RELAXED, __HIP_MEMORY_SCOPE_AGENT); }
        }
        asm volatile("s_waitcnt vmcnt(0)" ::: "memory");
        unsigned* c = cnt + 64 * u.pm;
        if (lane == 0) __hip_atomic_fetch_add(c, 1u, __ATOMIC_RELAXED, __HIP_MEMORY_SCOPE_AGENT);
        { unsigned sp = 0; while ((unsigned)__builtin_amdgcn_readfirstlane(__hip_atomic_load(c, __ATOMIC_RELAXED, __HIP_MEMORY_SCOPE_AGENT)) < 32u) { __builtin_amdgcn_s_sleep(2); if (++sp > (1u << 22)) break; } }
        __builtin_amdgcn_fence(__ATOMIC_ACQUIRE, "agent");
        f32x4 gv[2][2];
#pragma unroll
        for (int bj = 0; bj < 2; ++bj)
#pragma unroll
            for (int n = 0; n < 2; ++n) gv[bj][n] = *(const f32x4*)(gain + col0 + bj * HALF + n * 16);
        float rsv[2][4];
#pragma unroll
        for (int ai = 0; ai < 2; ++ai)
#pragma unroll
            for (int m = 0; m < 4; ++m) rsv[ai][m] = __hip_atomic_load(ssq + row0 + ai * HALF + m * 16, __ATOMIC_RELAXED, __HIP_MEMORY_SCOPE_AGENT);
#pragma unroll
        for (int ai = 0; ai < 2; ++ai)
#pragma unroll
            for (int m = 0; m < 4; ++m) { const float rs = rstd_of(rsv[ai][m]); const size_t off = (size_t)(row0 + ai * HALF + m * 16) * 1024 + col0;
#pragma unroll
                for (int bj = 0; bj < 2; ++bj)
#pragma unroll
                    for (int n = 0; n < 2; ++n) __builtin_nontemporal_store(acc[ai][bj][m][n] * rs * gv[bj][n], (f32x4*)(out + off + bj * HALF + n * 16)); }
    }
};

template <class Epi, class Sched, bool ALIGN_EPI = false, bool SP2 = false>
__device__ __forceinline__ void gemm_phase(PG8_LAS unsigned char* lds, const Gemm g, const Sched& S, const Epi& E) {
    int tid_ = threadIdx.x; asm volatile("" : "+v"(tid_));
    const int tid = tid_, wid = __builtin_amdgcn_readfirstlane(tid >> 6), lane = tid & 63, wr = wid >> 2, wc = wid & 3, fr = lane & 15, fq = lane >> 4;
    const int K = g.K, nt = K / BK;
    unsigned voffA[2], voffB[2];
#pragma unroll
    for (int i = 0; i < 2; ++i) { int R, C; stage_rc(tid * 16 + i * 8192, R, C); const int Rb = Epi::PERM ? ((R & ~31) + perm32(R & 31)) : R;
        voffA[i] = (unsigned)(R * K + C) * 2u; voffB[i] = (unsigned)(Rb * K + C) * 2u; }
    const size_t kstep = (size_t)(BK * 2);
    const size_t hstep = (size_t)HALF * K * 2;
    const size_t tstep = 2 * hstep;
    const unsigned ldsw = (unsigned)wid * 1024u;
    const int aoff = lds_byte(wr * 64 + fr, fq * 8), boff = lds_byte(wc * 32 + fr, fq * 8);
#define PG8_SA(b, h) (((b) * 2 + (h)) * HTB)
#define PG8_SB(b, h) ((4 + (b) * 2 + (h)) * HTB)
#define PG8_STAGE(bufoff, gbase, voff) do { _Pragma("unroll") for (int _i = 0; _i < 2; ++_i) \
        __builtin_amdgcn_global_load_lds((const unsigned*)((const char*)(gbase) + (voff)[_i]), (PG8_LAS unsigned*)(lds + (bufoff) + ldsw + _i * 8192), 16, 0, 0); } while (0)
#define PG8_LDA(dst, b, h) do { _Pragma("unroll") for (int m = 0; m < 4; ++m) _Pragma("unroll") for (int k = 0; k < 2; ++k) dst[m][k] = *(const PG8_LAS bf16x8*)(lds + PG8_SA(b, h) + aoff + m * 2048 + k * 1024); } while (0)
#define PG8_LDB(dst, b, h) do { _Pragma("unroll") for (int n = 0; n < 2; ++n) _Pragma("unroll") for (int k = 0; k < 2; ++k) dst[n][k] = *(const PG8_LAS bf16x8*)(lds + PG8_SB(b, h) + boff + n * 2048 + k * 1024); } while (0)
#define PG8_MMA(ai, bj, At, Bt) do { __builtin_amdgcn_s_setprio(1); _Pragma("unroll") for (int m = 0; m < 4; ++m) _Pragma("unroll") for (int n = 0; n < 2; ++n) _Pragma("unroll") for (int k = 0; k < 2; ++k) \
        acc[ai][bj][m][n] = __builtin_amdgcn_mfma_f32_16x16x32_bf16(Bt[n][k], At[m][k], acc[ai][bj][m][n], 0, 0, 0); __builtin_amdgcn_s_setprio(0); } while (0)
#define PG8_WAIT_V(n) asm volatile("s_waitcnt vmcnt(" #n ")" ::: "memory")
#define PG8_WAIT_L(n) asm volatile("s_waitcnt lgkmcnt(" #n ")" ::: "memory")
#define PG8_BAR __builtin_amdgcn_s_barrier()
#define PG8_SCHED __builtin_amdgcn_sched_barrier(0)
    Unit cur, nxt; int ui = 0;
    if (!S.next(0, cur)) return;
    f32x4 acc[2][2][4][2];
#pragma unroll
    for (int a = 0; a < 2; ++a)
#pragma unroll
        for (int b = 0; b < 2; ++b)
#pragma unroll
            for (int m = 0; m < 4; ++m)
#pragma unroll
                for (int n = 0; n < 2; ++n) acc[a][b][m][n] = (f32x4){0.f, 0.f, 0.f, 0.f};
    bf16x8 At[4][2], B0[2][2], B1[2][2];
    const char* cA = (const char*)g.A + (size_t)cur.pm * tstep; const char* cB = (const char*)g.Bt + (size_t)cur.pn * tstep;
    S.a_ready(cur);
    if constexpr (SP2) {
        PG8_STAGE(PG8_SB(0, 0), cB, voffB); PG8_STAGE(PG8_SB(0, 1), cB + hstep, voffB); PG8_STAGE(PG8_SA(0, 0), cA, voffA); PG8_STAGE(PG8_SA(0, 1), cA + hstep, voffA);
        if (wr == 1) PG8_BAR;
        PG8_WAIT_V(2); PG8_BAR;
        PG8_STAGE(PG8_SB(1, 0), cB + kstep, voffB); PG8_STAGE(PG8_SA(1, 0), cA + kstep, voffA); PG8_STAGE(PG8_SB(1, 1), cB + hstep + kstep, voffB);
        PG8_WAIT_V(6); PG8_BAR;
    } else {
        PG8_STAGE(PG8_SB(0, 0), cB, voffB); PG8_STAGE(PG8_SA(0, 0), cA, voffA); PG8_STAGE(PG8_SB(0, 1), cB + hstep, voffB); PG8_STAGE(PG8_SA(0, 1), cA + hstep, voffA);
        if (wr == 1) PG8_BAR;
        PG8_WAIT_V(4); PG8_BAR;
        PG8_STAGE(PG8_SB(1, 0), cB + kstep, voffB); PG8_STAGE(PG8_SA(1, 0), cA + kstep, voffA); PG8_STAGE(PG8_SB(1, 1), cB + hstep + kstep, voffB);
        PG8_WAIT_V(6); PG8_BAR;
    }
    for (;;) {
        const bool has_next = S.next(ui + 1, nxt);
        const char* nA = has_next ? (const char*)g.A + (size_t)nxt.pm * tstep : cA; const char* nB = has_next ? (const char*)g.Bt + (size_t)nxt.pn * tstep : cB;
        for (int t = 0; t < nt; t += 2) {
            const bool last = (t == nt - 2);
            const char* a1 = cA + (size_t)(t + 1) * kstep;
            const char* a2 = last ? nA : cA + (size_t)(t + 2) * kstep; const char* b2 = last ? nB : cB + (size_t)(t + 2) * kstep;
            const char* a3 = a2 + kstep; const char* b3 = b2 + kstep;
            if (last && has_next) S.a_ready(nxt);
            if constexpr (SP2) {
            PG8_LDB(B0, 0, 0); PG8_LDB(B1, 0, 1); PG8_SCHED; PG8_LDA(At, 0, 0); PG8_STAGE(PG8_SA(1, 1), a1 + hstep, voffA);
            PG8_WAIT_V(8); PG8_WAIT_L(0); PG8_BAR; PG8_MMA(0, 0, At, B0); PG8_MMA(0, 1, At, B1); PG8_BAR; PG8_SCHED;
            PG8_LDA(At, 0, 1); PG8_STAGE(PG8_SB(0, 0), b2, voffB); PG8_STAGE(PG8_SB(0, 1), b2 + hstep, voffB); PG8_STAGE(PG8_SA(0, 0), a2, voffA);
            PG8_WAIT_V(8); PG8_WAIT_L(0); PG8_BAR; PG8_MMA(1, 0, At, B0); PG8_MMA(1, 1, At, B1); PG8_BAR; PG8_SCHED;
            PG8_LDB(B0, 1, 0); PG8_LDB(B1, 1, 1); PG8_SCHED; PG8_LDA(At, 1, 0); PG8_STAGE(PG8_SA(0, 1), a2 + hstep, voffA);
            PG8_WAIT_V(8); PG8_WAIT_L(0); PG8_BAR; PG8_MMA(0, 0, At, B0); PG8_MMA(0, 1, At, B1); PG8_BAR; PG8_SCHED;
            PG8_LDA(At, 1, 1); PG8_STAGE(PG8_SB(1, 0), b3, voffB); PG8_STAGE(PG8_SB(1, 1), b3 + hstep, voffB); PG8_STAGE(PG8_SA(1, 0), a3, voffA);
            PG8_WAIT_V(8); PG8_WAIT_L(0); PG8_BAR; PG8_MMA(1, 0, At, B0); PG8_MMA(1, 1, At, B1); PG8_BAR; PG8_SCHED;
            } else {
            PG8_LDB(B0, 0, 0); PG8_SCHED; PG8_LDA(At, 0, 0); PG8_STAGE(PG8_SA(1, 1), a1 + hstep, voffA);
            PG8_WAIT_L(8); PG8_BAR; PG8_WAIT_L(0); PG8_MMA(0, 0, At, B0); PG8_BAR; PG8_SCHED;
            PG8_LDB(B1, 0, 1); PG8_STAGE(PG8_SB(0, 0), b2, voffB);
            PG8_BAR; PG8_WAIT_L(0); PG8_MMA(0, 1, At, B1); PG8_BAR;
            PG8_LDA(At, 0, 1); PG8_STAGE(PG8_SA(0, 0), a2, voffA);
            PG8_BAR; PG8_WAIT_L(0); PG8_MMA(1, 0, At, B0); PG8_BAR; PG8_SCHED;
            PG8_STAGE(PG8_SB(0, 1), b2 + hstep, voffB);
            PG8_WAIT_V(6); PG8_BAR; PG8_MMA(1, 1, At, B1); PG8_BAR;
            PG8_LDB(B0, 1, 0); PG8_SCHED; PG8_LDA(At, 1, 0); PG8_STAGE(PG8_SA(0, 1), a2 + hstep, voffA);
            PG8_WAIT_L(8); PG8_BAR; PG8_WAIT_L(0); PG8_MMA(0, 0, At, B0); PG8_BAR; PG8_SCHED;
            PG8_LDB(B1, 1, 1); PG8_STAGE(PG8_SB(1, 0), b3, voffB);
            PG8_BAR; PG8_WAIT_L(0); PG8_MMA(0, 1, At, B1); PG8_BAR;
            PG8_LDA(At, 1, 1); PG8_STAGE(PG8_SA(1, 0), a3, voffA);
            PG8_BAR; PG8_WAIT_L(0); PG8_MMA(1, 0, At, B0); PG8_BAR; PG8_SCHED;
            PG8_STAGE(PG8_SB(1, 1), b3 + hstep, voffB);
            PG8_WAIT_V(6); PG8_BAR; PG8_MMA(1, 1, At, B1); PG8_BAR;
            }
        }
        if constexpr (ALIGN_EPI) { if (wr == 0) PG8_BAR; }
        if constexpr (!Epi::AFTER_DRAIN) { E(acc, cur, wr, wc, fr, fq); S.done(cur); }
        if (!has_next) break;
#pragma unroll
        for (int a = 0; a < 2; ++a)
#pragma unroll
            for (int b = 0; b < 2; ++b)
#pragma unroll
                for (int m = 0; m < 4; ++m)
#pragma unroll
                    for (int n = 0; n < 2; ++n) acc[a][b][m][n] = (f32x4){0.f, 0.f, 0.f, 0.f};
        cur = nxt; cA = nA; cB = nB; ++ui;
        if constexpr (ALIGN_EPI) { if (wr == 1) PG8_BAR; }
    }
    PG8_WAIT_V(0);
    if constexpr (!ALIGN_EPI) { if (wr == 0) PG8_BAR; }
    PG8_BAR;
    if constexpr (Epi::AFTER_DRAIN) { E.fused(acc, cur, wr, wc, fr, fq, lds, wid, lane); S.done(cur); }
#undef PG8_SA
#undef PG8_SB
#undef PG8_STAGE
#undef PG8_LDA
#undef PG8_LDB
#undef PG8_MMA
#undef PG8_WAIT_V
#undef PG8_WAIT_L
#undef PG8_BAR
#undef PG8_SCHED
}
}

#ifndef PG8_SP2
#define PG8_SP2 true
#endif
#ifndef PG8_ALIGN
#define PG8_ALIGN true
#endif
#include <hip/hip_bf16.h>
#include <cmath>
namespace dattn {
using bf16=__hip_bfloat16;
using bf16x8=__attribute__((ext_vector_type(8)))short;
using s16x4=__attribute__((ext_vector_type(4)))short;
using f32x16=__attribute__((ext_vector_type(16)))float;
using u32x4=__attribute__((ext_vector_type(4)))unsigned;
using u32x2=__attribute__((ext_vector_type(2)))unsigned;
constexpr int SEQ=8192,DM=3072,QB=256,NSLOT=4,KSLOT=8192,VSLOT=16384;
constexpr int LDS_K=0,LDS_V=NSLOT*KSLOT,LDS_END=LDS_V+NSLOT*VSLOT;
constexpr int OST_ROW=272,OST_WAVE=32*OST_ROW;
static_assert(8*OST_WAVE<=LDS_END,"O staging fits over the rings");
typedef __attribute__((address_space(3))) const char* lds_cptr;
typedef __attribute__((address_space(3))) char* lds_ptr;
typedef short v4i16_t __attribute__((ext_vector_type(4)));
__device__ __forceinline__ void glds16(const void*gsrc,unsigned lds_dst){unsigned keep;
  asm volatile("s_mov_b32 %0, m0\n\ts_mov_b32 m0, %2\n\ts_nop 0\n\tglobal_load_lds_dwordx4 %1, off\n\ts_mov_b32 m0, %0":"=&s"(keep):"v"(gsrc),"s"(lds_dst):"memory");}
__device__ __forceinline__ s16x4 vtr(lds_cptr p){ return __builtin_bit_cast(s16x4,__builtin_amdgcn_ds_read_tr16_b64_v4i16((__attribute__((address_space(3))) v4i16_t*)p)); }
typedef float f32x2_t __attribute__((ext_vector_type(2))); typedef __bf16 bf16x2_t __attribute__((ext_vector_type(2)));
__device__ __forceinline__ unsigned cvtpk_s(float lo,float hi){f32x2_t v={lo,hi};bf16x2_t b=__builtin_convertvector(v,bf16x2_t);return __builtin_bit_cast(unsigned,b);}
#define DWAIT_BAR(N) asm volatile("s_waitcnt vmcnt(" #N ") lgkmcnt(0)\n\ts_barrier":::"memory")
__device__ __forceinline__ void unit(int b,int qb,const bf16*Q,const bf16*__restrict__ K,const bf16*__restrict__ V,bf16*O,int opitch,char*shm){
  const int tid=threadIdx.x,lane=tid&63,r32=lane&31,hi=lane>>5; const int wid=__builtin_amdgcn_readfirstlane(tid>>6);
  const long rowbase=(long)b*SEQ; const int q0=qb*QB;
  const bf16*Qw=Q+(rowbase+q0+wid*32)*DM;
  const unsigned lds0=(unsigned)(uintptr_t)shm;
  const bf16*ksrc=K+rowbase*DM+(long)lane*DM+wid*8;
  const bf16*vsrc=V+rowbase*DM+(long)(16*(wid&3)+(lane>>2))*DM+(wid>>2)*32+(lane&3)*8;
  const unsigned kdst=lds0+LDS_K+wid*1024,vdst=lds0+LDS_V+wid*1024;
  #define DDMA(t,sl) do{ glds16(ksrc+(long)(t)*64*DM,(unsigned)__builtin_amdgcn_readfirstlane(kdst+(sl)*KSLOT)); \
      glds16(vsrc+(long)(t)*64*DM,(unsigned)__builtin_amdgcn_readfirstlane(vdst+(sl)*VSLOT)); \
      glds16(vsrc+(long)(t)*64*DM+64,(unsigned)__builtin_amdgcn_readfirstlane(vdst+(sl)*VSLOT+8192)); }while(0)
  #define SBARR() do{}while(0)
  #define DVRD(dst,vp_,cb_) do{ _Pragma("unroll") for(int c_=0;c_<4;++c_){ dst[2*c_]=vtr((vp_)+((cb_)>>1)*8192+((cb_)&1)*4096+c_*1024); dst[2*c_+1]=vtr((vp_)+((cb_)>>1)*8192+((cb_)&1)*4096+c_*1024+512); } }while(0)
  #define DVF(src,c_) (bf16x8){src[2*(c_)][0],src[2*(c_)][1],src[2*(c_)][2],src[2*(c_)][3],src[2*(c_)+1][0],src[2*(c_)+1][1],src[2*(c_)+1][2],src[2*(c_)+1][3]}
  #define DVRDC(dst,vp_,c_) do{ _Pragma("unroll") for(int b_=0;b_<4;++b_){ dst[2*b_]=vtr((vp_)+(b_>>1)*8192+(b_&1)*4096+(c_)*1024); dst[2*b_+1]=vtr((vp_)+(b_>>1)*8192+(b_&1)*4096+(c_)*1024+512); } }while(0)
  #define DPVC(src,c_) do{ _Pragma("unroll") for(int b_=0;b_<4;++b_) o[b_]=__builtin_amdgcn_mfma_f32_32x32x16_bf16(DVF(src,b_),pw[c_],o[b_],0,0,0); }while(0)
  #define DPV(src,cb_) do{ o[cb_]=__builtin_amdgcn_mfma_f32_32x32x16_bf16(DVF(src,0),pw[0],o[cb_],0,0,0); o[cb_]=__builtin_amdgcn_mfma_f32_32x32x16_bf16(DVF(src,1),pw[1],o[cb_],0,0,0); \
      o[cb_]=__builtin_amdgcn_mfma_f32_32x32x16_bf16(DVF(src,2),pw[2],o[cb_],0,0,0); o[cb_]=__builtin_amdgcn_mfma_f32_32x32x16_bf16(DVF(src,3),pw[3],o[cb_],0,0,0); }while(0)
  #define PV_PLAIN(vp_) do{ DPVC(va,0); DVRDC(va,vp_,2); DPVC(vb,1); DVRDC(vb,vp_,3); DPVC(va,2); DPVC(vb,3); }while(0)
  #define EXPS_PLAIN() do{ float ls0=0.f,ls1=0.f; \
      _Pragma("unroll") for(int r=0;r<16;++r){ p0[r]=__builtin_amdgcn_exp2f(p0[r]-mref); ls0+=p0[r]; p1[r]=__builtin_amdgcn_exp2f(p1[r]-mref); ls1+=p1[r]; } l+=ls0+ls1; \
      u32x4 w0,w1,w2,w3; w0.x=cvtpk_s(p0[0],p0[1]);w0.y=cvtpk_s(p0[2],p0[3]);w0.z=cvtpk_s(p0[4],p0[5]);w0.w=cvtpk_s(p0[6],p0[7]); \
      w1.x=cvtpk_s(p0[8],p0[9]);w1.y=cvtpk_s(p0[10],p0[11]);w1.z=cvtpk_s(p0[12],p0[13]);w1.w=cvtpk_s(p0[14],p0[15]); \
      w2.x=cvtpk_s(p1[0],p1[1]);w2.y=cvtpk_s(p1[2],p1[3]);w2.z=cvtpk_s(p1[4],p1[5]);w2.w=cvtpk_s(p1[6],p1[7]); \
      w3.x=cvtpk_s(p1[8],p1[9]);w3.y=cvtpk_s(p1[10],p1[11]);w3.z=cvtpk_s(p1[12],p1[13]);w3.w=cvtpk_s(p1[14],p1[15]); \
      pw[0]=__builtin_bit_cast(bf16x8,w0);pw[1]=__builtin_bit_cast(bf16x8,w1);pw[2]=__builtin_bit_cast(bf16x8,w2);pw[3]=__builtin_bit_cast(bf16x8,w3); }while(0)
  const int NT=(q0+QB)/64;
  DDMA(0,0); DDMA(1,1);
  bf16x8 qr[4];
  #pragma unroll
  for(int d0=0;d0<4;++d0)qr[d0]=*reinterpret_cast<const bf16x8*>(&Qw[(long)r32*DM+d0*16+hi*8]);
  asm volatile("":"+v"(qr[0]),"+v"(qr[1]),"+v"(qr[2]),"+v"(qr[3]));
  const lds_cptr shm3=(lds_cptr)shm;
  const lds_cptr kp0=shm3+LDS_K+hi*1024+r32*16;
  const lds_cptr vp0=shm3+LDS_V+((lane>>4)&1)*32+(lane&3)*8+(4*hi+((lane&15)>>2))*64;
  f32x16 o[4]; o[0]=f32x16{};o[1]=f32x16{};o[2]=f32x16{};o[3]=f32x16{};
  float mref=0.f,l=0.f;
  f32x16 negm=f32x16{};
  const int qfirst=q0+wid*32, qme=qfirst+r32;
  const int TI=(qfirst+1)>>6;
  int t=0;
  bf16x8 pw[4]; pw[0]=bf16x8{};pw[1]=bf16x8{};pw[2]=bf16x8{};pw[3]=bf16x8{};
  for(;t<TI;++t){
    const int slot=t&3;
    if(t+1<NT){DWAIT_BAR(3);}else{DWAIT_BAR(0);}
    const lds_cptr kp=kp0+slot*KSLOT; const lds_cptr vpp=vp0+((t?t-1:0)&3)*VSLOT;
    bf16x8 kf[8];
    #pragma unroll
    for(int d0=0;d0<4;++d0){ kf[2*d0]=*(const __attribute__((address_space(3))) bf16x8*)(kp+d0*2048); kf[2*d0+1]=*(const __attribute__((address_space(3))) bf16x8*)(kp+d0*2048+512); }
    s16x4 va[8],vb[8];
    f32x16 p0=__builtin_amdgcn_mfma_f32_32x32x16_bf16(kf[0],qr[0],negm,0,0,0),p1=__builtin_amdgcn_mfma_f32_32x32x16_bf16(kf[1],qr[0],negm,0,0,0);
    #pragma unroll
    for(int d0=1;d0<4;++d0){ p0=__builtin_amdgcn_mfma_f32_32x32x16_bf16(kf[2*d0],qr[d0],p0,0,0,0); p1=__builtin_amdgcn_mfma_f32_32x32x16_bf16(kf[2*d0+1],qr[d0],p1,0,0,0); }
    DVRDC(va,vpp,0); DVRDC(vb,vpp,1);
    float mt=__builtin_fmaxf(__builtin_fmaxf(p0[0],p0[1]),__builtin_fmaxf(p1[0],p1[1]));
    #pragma unroll
    for(int r=2;r<16;r+=2){ mt=__builtin_fmaxf(mt,__builtin_fmaxf(p0[r],p0[r+1])); mt=__builtin_fmaxf(mt,__builtin_fmaxf(p1[r],p1[r+1])); }
    { auto rr=__builtin_amdgcn_permlane32_swap(__float_as_uint(mt),__float_as_uint(mt),false,false); mt=__builtin_fmaxf(__uint_as_float(rr[0]),__uint_as_float(rr[1])); }
    if(t==0||__any(mt>8.0f)){
      PV_PLAIN(vpp);
      const float delta=t?__builtin_fmaxf(mt,0.f):mt; const float alpha=t?__builtin_amdgcn_exp2f(-delta):1.0f;
      #pragma unroll
      for(int cb=0;cb<4;++cb)o[cb]=o[cb]*alpha;
      l*=alpha; mref+=delta;
      #pragma unroll
      for(int r=0;r<16;++r){ p0[r]-=delta; p1[r]-=delta; negm[r]=-mref; }
      pw[0]=bf16x8{};pw[1]=bf16x8{};pw[2]=bf16x8{};pw[3]=bf16x8{};
      DVRDC(va,vpp,0); DVRDC(vb,vpp,1);
    }
    {
      float ls0=0.f,ls1=0.f; u32x4 wq;
      o[0]=__builtin_amdgcn_mfma_f32_32x32x16_bf16(DVF(va,0),pw[0],o[0],0,0,0);
      p0[0]=__builtin_amdgcn_exp2f(p0[0]); p0[1]=__builtin_amdgcn_exp2f(p0[1]); ls0+=p0[0]+p0[1];
      o[1]=__builtin_amdgcn_mfma_f32_32x32x16_bf16(DVF(va,1),pw[0],o[1],0,0,0);
      p0[2]=__builtin_amdgcn_exp2f(p0[2]); p0[3]=__builtin_amdgcn_exp2f(p0[3]); ls0+=p0[2]+p0[3];
      o[2]=__builtin_amdgcn_mfma_f32_32x32x16_bf16(DVF(va,2),pw[0],o[2],0,0,0);
      p0[4]=__builtin_amdgcn_exp2f(p0[4]); p0[5]=__builtin_amdgcn_exp2f(p0[5]); ls0+=p0[4]+p0[5];
      o[3]=__builtin_amdgcn_mfma_f32_32x32x16_bf16(DVF(va,3),pw[0],o[3],0,0,0);
      p0[6]=__builtin_amdgcn_exp2f(p0[6]); p0[7]=__builtin_amdgcn_exp2f(p0[7]); ls0+=p0[6]+p0[7];
      if(t+2<NT){ DDMA(t+2,(t+2)&3); }
      DVRDC(va,vpp,2);
      o[0]=__builtin_amdgcn_mfma_f32_32x32x16_bf16(DVF(vb,0),pw[1],o[0],0,0,0);
      p0[8]=__builtin_amdgcn_exp2f(p0[8]); p0[9]=__builtin_amdgcn_exp2f(p0[9]); ls0+=p0[8]+p0[9];
      wq.x=cvtpk_s(p0[0],p0[1]);
      o[1]=__builtin_amdgcn_mfma_f32_32x32x16_bf16(DVF(vb,1),pw[1],o[1],0,0,0);
      p0[10]=__builtin_amdgcn_exp2f(p0[10]); p0[11]=__builtin_amdgcn_exp2f(p0[11]); ls0+=p0[10]+p0[11];
      wq.y=cvtpk_s(p0[2],p0[3]);
      o[2]=__builtin_amdgcn_mfma_f32_32x32x16_bf16(DVF(vb,2),pw[1],o[2],0,0,0);
      p0[12]=__builtin_amdgcn_exp2f(p0[12]); p0[13]=__builtin_amdgcn_exp2f(p0[13]); ls0+=p0[12]+p0[13];
      wq.z=cvtpk_s(p0[4],p0[5]);
      o[3]=__builtin_amdgcn_mfma_f32_32x32x16_bf16(DVF(vb,3),pw[1],o[3],0,0,0);
      p0[14]=__builtin_amdgcn_exp2f(p0[14]); p0[15]=__builtin_amdgcn_exp2f(p0[15]); ls0+=p0[14]+p0[15];
      wq.w=cvtpk_s(p0[6],p0[7]);
      pw[0]=__builtin_bit_cast(bf16x8,wq);
      DVRDC(vb,vpp,3);
      o[0]=__builtin_amdgcn_mfma_f32_32x32x16_bf16(DVF(va,0),pw[2],o[0],0,0,0);
      p1[0]=__builtin_amdgcn_exp2f(p1[0]); p1[1]=__builtin_amdgcn_exp2f(p1[1]); ls1+=p1[0]+p1[1];
      wq.x=cvtpk_s(p0[8],p0[9]);
      o[1]=__builtin_amdgcn_mfma_f32_32x32x16_bf16(DVF(va,1),pw[2],o[1],0,0,0);
      p1[2]=__builtin_amdgcn_exp2f(p1[2]); p1[3]=__builtin_amdgcn_exp2f(p1[3]); ls1+=p1[2]+p1[3];
      wq.y=cvtpk_s(p0[10],p0[11]);
      o[2]=__builtin_amdgcn_mfma_f32_32x32x16_bf16(DVF(va,2),pw[2],o[2],0,0,0);
      p1[4]=__builtin_amdgcn_exp2f(p1[4]); p1[5]=__builtin_amdgcn_exp2f(p1[5]); ls1+=p1[4]+p1[5];
      wq.z=cvtpk_s(p0[12],p0[13]);
      o[3]=__builtin_amdgcn_mfma_f32_32x32x16_bf16(DVF(va,3),pw[2],o[3],0,0,0);
      p1[6]=__builtin_amdgcn_exp2f(p1[6]); p1[7]=__builtin_amdgcn_exp2f(p1[7]); ls1+=p1[6]+p1[7];
      wq.w=cvtpk_s(p0[14],p0[15]);
      pw[1]=__builtin_bit_cast(bf16x8,wq);
      o[0]=__builtin_amdgcn_mfma_f32_32x32x16_bf16(DVF(vb,0),pw[3],o[0],0,0,0);
      p1[8]=__builtin_amdgcn_exp2f(p1[8]); p1[9]=__builtin_amdgcn_exp2f(p1[9]); ls1+=p1[8]+p1[9];
      wq.x=cvtpk_s(p1[0],p1[1]);
      o[1]=__builtin_amdgcn_mfma_f32_32x32x16_bf16(DVF(vb,1),pw[3],o[1],0,0,0);
      p1[10]=__builtin_amdgcn_exp2f(p1[10]); p1[11]=__builtin_amdgcn_exp2f(p1[11]); ls1+=p1[10]+p1[11];
      wq.y=cvtpk_s(p1[2],p1[3]);
      o[2]=__builtin_amdgcn_mfma_f32_32x32x16_bf16(DVF(vb,2),pw[3],o[2],0,0,0);
      p1[12]=__builtin_amdgcn_exp2f(p1[12]); p1[13]=__builtin_amdgcn_exp2f(p1[13]); ls1+=p1[12]+p1[13];
      wq.z=cvtpk_s(p1[4],p1[5]);
      o[3]=__builtin_amdgcn_mfma_f32_32x32x16_bf16(DVF(vb,3),pw[3],o[3],0,0,0);
      p1[14]=__builtin_amdgcn_exp2f(p1[14]); p1[15]=__builtin_amdgcn_exp2f(p1[15]); ls1+=p1[14]+p1[15];
      wq.w=cvtpk_s(p1[6],p1[7]);
      pw[2]=__builtin_bit_cast(bf16x8,wq);
      wq.x=cvtpk_s(p1[8],p1[9]); wq.y=cvtpk_s(p1[10],p1[11]); wq.z=cvtpk_s(p1[12],p1[13]); wq.w=cvtpk_s(p1[14],p1[15]); pw[3]=__builtin_bit_cast(bf16x8,wq);
      l+=ls0+ls1;
    }
  }
  if(TI>0){ const lds_cptr vpp=vp0+((t+3)&3)*VSLOT; s16x4 va[8],vb[8]; DVRDC(va,vpp,0); DVRDC(vb,vpp,1); PV_PLAIN(vpp); }
  for(;t<NT;++t){
    const int slot=t&3;
    if(t+1<NT){DWAIT_BAR(3);}else{DWAIT_BAR(0);}
    if(t+2<NT){ DDMA(t+2,(t+2)&3); }
    const lds_cptr kp=kp0+slot*KSLOT; const lds_cptr vp=vp0+slot*VSLOT;
    #pragma unroll
    for(int s=0;s<2;++s){
      const int key0=64*t+32*s;
      if(key0>qfirst+31)continue;
      f32x16 p=f32x16{};
      #pragma unroll
      for(int d0=0;d0<4;++d0){ const bf16x8 kf=*(const __attribute__((address_space(3))) bf16x8*)(kp+d0*2048+s*512); p=__builtin_amdgcn_mfma_f32_32x32x16_bf16(kf,qr[d0],p,0,0,0); }
      if(key0+31>qfirst){
        #pragma unroll
        for(int r=0;r<16;++r){ const int kv=key0+(r&3)+8*(r>>2)+4*hi; if(kv>qme)p[r]=-INFINITY; } }
      float mt=__builtin_fmaxf(p[0],p[1]);
      #pragma unroll
      for(int r=2;r<16;++r)mt=__builtin_fmaxf(mt,p[r]);
      { auto rr=__builtin_amdgcn_permlane32_swap(__float_as_uint(mt),__float_as_uint(mt),false,false); mt=__builtin_fmaxf(__uint_as_float(rr[0]),__uint_as_float(rr[1])); }
      const bool first=(t==0&&s==0);
      if(first||__any(mt>mref+8.0f)){
        const float mnew=first?mt:__builtin_fmaxf(mref,mt); const float alpha=first?1.0f:__builtin_amdgcn_exp2f(mref-mnew);
        #pragma unroll
        for(int cb=0;cb<4;++cb)o[cb]=o[cb]*alpha;
        l*=alpha; mref=mnew; }
      float ls=0.f;
      #pragma unroll
      for(int r=0;r<16;++r){ p[r]=__builtin_amdgcn_exp2f(p[r]-mref); ls+=p[r]; }
      l+=ls;
      u32x4 w0,w1; w0.x=cvtpk_s(p[0],p[1]);w0.y=cvtpk_s(p[2],p[3]);w0.z=cvtpk_s(p[4],p[5]);w0.w=cvtpk_s(p[6],p[7]);
      w1.x=cvtpk_s(p[8],p[9]);w1.y=cvtpk_s(p[10],p[11]);w1.z=cvtpk_s(p[12],p[13]);w1.w=cvtpk_s(p[14],p[15]);
      const bf16x8 pb0=__builtin_bit_cast(bf16x8,w0),pb1=__builtin_bit_cast(bf16x8,w1);
      #pragma unroll
      for(int cb=0;cb<4;++cb){
        const int off=(cb>>1)*8192+(cb&1)*4096+(2*s)*1024;
        const s16x4 a0=vtr(vp+off),a1=vtr(vp+off+512),c0=vtr(vp+off+1024),c1=vtr(vp+off+1536);
        const bf16x8 v0=(bf16x8){a0[0],a0[1],a0[2],a0[3],a1[0],a1[1],a1[2],a1[3]},v1=(bf16x8){c0[0],c0[1],c0[2],c0[3],c1[0],c1[1],c1[2],c1[3]};
        o[cb]=__builtin_amdgcn_mfma_f32_32x32x16_bf16(v0,pb0,o[cb],0,0,0);
        o[cb]=__builtin_amdgcn_mfma_f32_32x32x16_bf16(v1,pb1,o[cb],0,0,0); }
    }

  }
  { auto rr=__builtin_amdgcn_permlane32_swap(__float_as_uint(l),__float_as_uint(l),false,false); l=__uint_as_float(rr[0])+__uint_as_float(rr[1]); }
  const float inv=__builtin_amdgcn_rcpf(l);
  DWAIT_BAR(0);
  const lds_ptr stg=(lds_ptr)shm+wid*OST_WAVE;
  #pragma unroll
  for(int cb=0;cb<4;++cb)
    #pragma unroll
    for(int g=0;g<4;++g){ u32x2 w; w.x=cvtpk_s(o[cb][4*g]*inv,o[cb][4*g+1]*inv); w.y=cvtpk_s(o[cb][4*g+2]*inv,o[cb][4*g+3]*inv);
      *(__attribute__((address_space(3))) u32x2*)(stg+r32*OST_ROW+(32*cb+8*g+4*hi)*2)=w; }
  asm volatile("s_waitcnt lgkmcnt(0)":::"memory");
  bf16*Ow=O+(rowbase+q0+wid*32)*(long)opitch;
  #pragma unroll
  for(int i=0;i<8;++i){ const int row=i*4+(lane>>4),ch=lane&15; const u32x4 v=*(const __attribute__((address_space(3))) u32x4*)(stg+row*OST_ROW+ch*16); *(u32x4*)(Ow+(long)row*opitch+ch*8)=v; }
  asm volatile("s_waitcnt lgkmcnt(0)\n\ts_barrier":::"memory");
  #undef DDMA
  #undef SBARR
  #undef DVRD
  #undef DVF
  #undef DPV
  #undef PV_PLAIN
  #undef DVRDC
  #undef DPVC
  #undef EXPS_PLAIN
}
struct DiffUnit { int bh; int qb; int m; };
struct DiffOrder {
  int vcu, G;
  __device__ __forceinline__ DiffOrder(int vcu_,int G_):vcu(vcu_),G(G_){}
  __device__ __forceinline__ bool next(int i,DiffUnit&u)const{
    const int ii=i>>1; u.m=i&1;
    if(G==256){ if(i>=4)return false; const int s=vcu&15; u.bh=vcu>>4; u.qb=ii?31-s:s; return true; }
    const int un=vcu+ii*G; if(un>=512)return false; u.bh=un>>5; u.qb=un&31; return true; }
};
__device__ __forceinline__ void diff_phase(char*shm,const unsigned short*PROJ,unsigned short*OA,const DiffOrder&S){
  DiffUnit u;
  for(int i=0;S.next(i,u);++i){
    const int h=u.bh&7;
    const bf16*Qp=(const bf16*)PROJ+h*128+u.m*64;
    unit(u.bh>>3,u.qb,Qp,Qp+1024,(const bf16*)PROJ+2048+h*128,u.m?((bf16*)PROJ+h*128):((bf16*)OA+h*128),u.m?DM:1024,shm);
  }
}
__device__ __forceinline__ float bflo(unsigned w){return __builtin_bit_cast(float,w<<16);}
__device__ __forceinline__ float bfhi(unsigned w){return __builtin_bit_cast(float,w&0xffff0000u);}
__device__ __forceinline__ void diff_combine(const unsigned short*PROJ,unsigned short*OA,const DiffOrder&S,float lam){
  asm volatile("s_waitcnt vmcnt(0)":::"memory");
  int tid_=threadIdx.x; asm volatile("":"+v"(tid_));
  const int lane=tid_&63; const int wid=__builtin_amdgcn_readfirstlane(tid_>>6); const int c8=(lane&7)*8;
  DiffUnit u;
  for(int i=0;S.next(i,u);i+=2){
    const int h=u.bh&7; const long row0=(long)(u.bh>>3)*SEQ+u.qb*QB+wid*32+(lane>>3);
    #pragma unroll 1
    for(int it=0;it<4;++it){
      unsigned short*ma=OA+(row0+it*8)*1024+h*128+c8; const unsigned short*pb=PROJ+(row0+it*8)*DM+h*128+c8;
      const u32x4 a0=*(const u32x4*)ma,a1=*(const u32x4*)(ma+64),b0=*(const u32x4*)pb,b1=*(const u32x4*)(pb+64);
      float o0[8],o1[8]; float ss=0.f;
      #pragma unroll
      for(int k=0;k<4;++k){ o0[2*k]=bflo(a0[k])-lam*bflo(b0[k]); o0[2*k+1]=bfhi(a0[k])-lam*bfhi(b0[k]); o1[2*k]=bflo(a1[k])-lam*bflo(b1[k]); o1[2*k+1]=bfhi(a1[k])-lam*bfhi(b1[k]); }
      #pragma unroll
      for(int k=0;k<8;++k)ss+=o0[k]*o0[k]+o1[k]*o1[k];
      ss+=__shfl_xor(ss,1); ss+=__shfl_xor(ss,2); ss+=__shfl_xor(ss,4);
      const float rs=__builtin_amdgcn_rsqf(ss*(1.0f/128.0f)+1e-6f);
      u32x4 w0,w1;
      #pragma unroll
      for(int k=0;k<4;++k){ w0[k]=cvtpk_s(o0[2*k]*rs,o0[2*k+1]*rs); w1[k]=cvtpk_s(o1[2*k]*rs,o1[2*k+1]*rs); }
      *(u32x4*)ma=w0; *(u32x4*)(ma+64)=w1;
    }
  }
}
#undef DWAIT_BAR
}
#include <hip/hip_cooperative_groups.h>
namespace cg = cooperative_groups;
constexpr int NWAVES = 8;
constexpr int SEQ = 8192, DMOD = 1024, MTOK = 2 * SEQ, FF = 4096;
constexpr int P0W = 2560;
constexpr int P1W = 3072;
constexpr float QSCALE = 0.125f * 1.4426950408889634f;
constexpr float LAMBDA_INIT1 = 0.35550906f;
constexpr size_t MiB = 1u << 20;
constexpr size_t WS_CTL = 0, CTL_ZERO_BYTES = 1 * MiB;
constexpr size_t WS_SSQ = 65536;
constexpr size_t WS_W = 2 * MiB;
constexpr size_t W_IN = 0, W_OUT = 6 * MiB, W_UP = 8 * MiB, W_DOWN = 16 * MiB, W_LAYER = 24 * MiB;
constexpr size_t WS_XB = 50 * MiB;
constexpr size_t WS_PROJ = 82 * MiB;
constexpr size_t WS_VT = WS_PROJ + 80 * MiB;
constexpr size_t WS_MIX = 178 * MiB;
constexpr size_t WS_H = WS_PROJ;
constexpr size_t WS_END = 210 * MiB;
constexpr int RING_BYTES = 131072, LDS_BYTES = 147456;

#define GAS __attribute__((address_space(1)))
#define LAS __attribute__((address_space(3)))
typedef unsigned short bf16;
typedef unsigned v4u __attribute__((ext_vector_type(4)));
typedef float f32x4 __attribute__((ext_vector_type(4)));
typedef short bf16x8 __attribute__((ext_vector_type(8)));
typedef float f32x16 __attribute__((ext_vector_type(16)));
#define LDS_WAIT() asm volatile("s_waitcnt lgkmcnt(0)" ::: "memory")
__device__ __forceinline__ unsigned f2bf(float f) { unsigned u = __builtin_bit_cast(unsigned, f); return (u + 0x7fffu + ((u >> 16) & 1u)) >> 16; }
__device__ __forceinline__ unsigned pk2(float lo, float hi) { return f2bf(lo) | (f2bf(hi) << 16); }
__device__ __forceinline__ float bf_lo(unsigned w) { return __builtin_bit_cast(float, w << 16); }
__device__ __forceinline__ float bf_hi(unsigned w) { return __builtin_bit_cast(float, w & 0xffff0000u); }
__device__ __forceinline__ float wave_sum(float v) {
#pragma unroll
    for (int o = 1; o < 64; o <<= 1) v += __shfl_xor(v, o);
    return v;
}
__device__ __forceinline__ void x_rows2_to_bf16(const float* xrow, bf16* orow, float* ssq, int lane) {
    const GAS f32x4* xr = (const GAS f32x4*)xrow + lane;
    f32x4 v[8]; float s0 = 0.f, s1 = 0.f;
#pragma unroll
    for (int j = 0; j < 8; ++j) v[j] = __builtin_nontemporal_load(xr + 64 * j);
#pragma unroll
    for (int j = 0; j < 4; ++j) { s0 += (v[j].x * v[j].x + v[j].y * v[j].y) + (v[j].z * v[j].z + v[j].w * v[j].w); s1 += (v[4 + j].x * v[4 + j].x + v[4 + j].y * v[4 + j].y) + (v[4 + j].z * v[4 + j].z + v[4 + j].w * v[4 + j].w); }
    s0 = wave_sum(s0); s1 = wave_sum(s1); if (lane == 0) { ssq[0] = s0; ssq[1] = s1; }
    GAS unsigned long long* o8 = (GAS unsigned long long*)orow + lane;
#pragma unroll
    for (int j = 0; j < 8; ++j) o8[64 * j] = (unsigned long long)pk2(v[j].x, v[j].y) | ((unsigned long long)pk2(v[j].z, v[j].w) << 32);
}

__device__ __forceinline__ int swap23(int i) { return (i & ~12) | ((i & 4) << 1) | ((i & 8) >> 1); }
__device__ __forceinline__ unsigned cvtpk2(float lo, float hi) { typedef float f2 __attribute__((ext_vector_type(2))); typedef __bf16 b2 __attribute__((ext_vector_type(2))); f2 v = {lo, hi}; b2 b = __builtin_convertvector(v, b2); return __builtin_bit_cast(unsigned, b); }
__device__ __forceinline__ void sb_unit(int b, int h, int qb, const bf16* __restrict__ proj, const bf16* __restrict__ Vt, bf16* __restrict__ mix, LAS unsigned char* stage, int lane) {
    const int r32 = lane & 31, hi = lane >> 5;
    const size_t rowbase = (size_t)b * SEQ; const int t0 = qb * 32;
    const bf16* qp = proj + (rowbase + t0 + r32) * P0W + h * 64 + hi * 8;
    bf16x8 qr[4];
#pragma unroll
    for (int d0 = 0; d0 < 4; ++d0) qr[d0] = *(const bf16x8*)(qp + d0 * 16);
    const bf16* kbase = proj + (rowbase + swap23(r32)) * P0W + 512 + h * 64 + hi * 8;
    const bf16* vbase = Vt + (size_t)(h * 64 + r32) * MTOK + rowbase + hi * 8;
    f32x16 o0 = {}, o1 = {};
    float R = 0.f;
#define SB_LOAD(KF, VF, kt_) do { const bf16* kp = kbase + (size_t)(kt_) * 32 * P0W; const bf16* vp = vbase + (kt_) * 32; \
        _Pragma("unroll") for (int d0 = 0; d0 < 4; ++d0) KF[d0] = *(const bf16x8*)(kp + d0 * 16); \
        VF[0] = *(const bf16x8*)(vp); VF[1] = *(const bf16x8*)(vp + 16); VF[2] = *(const bf16x8*)(vp + (size_t)32 * MTOK); VF[3] = *(const bf16x8*)(vp + (size_t)32 * MTOK + 16); } while (0)
#define SB_COMPUTE(KF, VF, kt_) do { \
        f32x16 p = {}; \
        _Pragma("unroll") for (int d0 = 0; d0 < 4; ++d0) p = __builtin_amdgcn_mfma_f32_32x32x16_bf16(KF[d0], qr[d0], p, 0, 0, 0); \
        const bool diag = ((kt_) == qb); \
        float sp[16], lb[16]; \
        _Pragma("unroll") for (int r = 0; r < 16; ++r) { const float z = p[r]; const float e = __builtin_amdgcn_exp2f(-__builtin_fabsf(z)); const float l = __builtin_amdgcn_logf(1.0f + e); \
            sp[r] = __builtin_fmaxf(z, 0.f) + l; lb[r] = __builtin_fminf(z, 0.f) - l; \
            if (diag) { const int koff = (r & 7) + 8 * hi + 16 * (r >> 3); if (koff >= r32) { sp[r] = 0.f; lb[r] = -INFINITY; } } } \
        float ex[16], G0, G1; \
        { float run = 0.f; \
          _Pragma("unroll") for (int j = 7; j >= 0; --j) { ex[j] = run; run += sp[j]; } G0 = run; run = 0.f; \
          _Pragma("unroll") for (int j = 7; j >= 0; --j) { ex[8 + j] = run; run += sp[8 + j]; } G1 = run; } \
        const float Gp0 = __shfl_xor(G0, 32), Gp1 = __shfl_xor(G1, 32); \
        const float base1 = R + (hi ? 0.f : Gp1), base0 = R + G1 + Gp1 + (hi ? 0.f : Gp0); \
        float w[16]; \
        _Pragma("unroll") for (int r = 0; r < 16; ++r) w[r] = __builtin_amdgcn_exp2f(lb[r] - ((r < 8) ? base0 : base1) - ex[r]); \
        R += (G0 + G1) + (Gp0 + Gp1); \
        v4u a0, a1; a0.x = cvtpk2(w[0], w[1]); a0.y = cvtpk2(w[2], w[3]); a0.z = cvtpk2(w[4], w[5]); a0.w = cvtpk2(w[6], w[7]); \
        a1.x = cvtpk2(w[8], w[9]); a1.y = cvtpk2(w[10], w[11]); a1.z = cvtpk2(w[12], w[13]); a1.w = cvtpk2(w[14], w[15]); \
        const bf16x8 pa0 = __builtin_bit_cast(bf16x8, a0), pa1 = __builtin_bit_cast(bf16x8, a1); \
        o0 = __builtin_amdgcn_mfma_f32_32x32x16_bf16(pa0, VF[0], o0, 0, 0, 0); o0 = __builtin_amdgcn_mfma_f32_32x32x16_bf16(pa1, VF[1], o0, 0, 0, 0); \
        o1 = __builtin_amdgcn_mfma_f32_32x32x16_bf16(pa0, VF[2], o1, 0, 0, 0); o1 = __builtin_amdgcn_mfma_f32_32x32x16_bf16(pa1, VF[3], o1, 0, 0, 0); \
        done = __all(R > 151.0f) != 0; } while (0)
    bf16x8 kA[4], vA[4], kB[4], vB[4];
    SB_LOAD(kA, vA, qb);
#pragma unroll
    for (int d0 = 0; d0 < 4; ++d0) { kB[d0] = kA[d0]; vB[d0] = vA[d0]; }
    if (qb > 0) SB_LOAD(kB, vB, qb - 1);
    bool done = false;
    for (int kt = qb;; kt -= 2) {
        SB_COMPUTE(kA, vA, kt);
        if (done || kt < 1) break;
        if (kt >= 2) SB_LOAD(kA, vA, kt - 2);
        SB_COMPUTE(kB, vB, kt - 1);
        if (done || kt < 2) break;
        if (kt >= 3) SB_LOAD(kB, vB, kt - 3);
    }
#undef SB_LOAD
#undef SB_COMPUTE
    LAS bf16* stg = (LAS bf16*)stage;
#pragma unroll
    for (int r = 0; r < 16; ++r) { const int orow = (r & 3) + 8 * (r >> 2) + 4 * hi; stg[orow * 64 + r32] = (bf16)f2bf(o0[r]); stg[orow * 64 + 32 + r32] = (bf16)f2bf(o1[r]); }
    LDS_WAIT(); asm volatile("" ::: "memory");
    bf16* op = mix + (rowbase + t0) * 1024 + h * 64;
#pragma unroll
    for (int i = 0; i < 4; ++i) { const int row = i * 8 + (lane >> 3), ch = lane & 7; const v4u v = *(const LAS v4u*)(stg + row * 64 + ch * 8); *(v4u*)(op + (size_t)row * 1024 + ch * 8) = v; }
    LDS_WAIT(); asm volatile("" ::: "memory");
}
__device__ __forceinline__ void conv_items(const bf16* __restrict__ proj, const float* __restrict__ cw, bf16* __restrict__ mix, int gtid, int nthreads) {
    for (int it = gtid; it < (MTOK / 8) * 64; it += nthreads) {
        const int rb = it >> 6, ch = (it & 63) * 8, m0 = rb * 8;
        float w0[8], w1[8], w2[8], c2[8], c1[8];
#pragma unroll
        for (int i = 0; i < 8; ++i) { w0[i] = cw[ch + i]; w1[i] = cw[512 + ch + i]; w2[i] = cw[1024 + ch + i]; c2[i] = 0.f; c1[i] = 0.f; }
        if ((m0 & (SEQ - 1)) != 0) {
            const v4u Ca = *(const v4u*)(proj + (size_t)(m0 - 2) * P0W + 1536 + ch), Ua = *(const v4u*)(proj + (size_t)(m0 - 2) * P0W + 2048 + ch);
            const v4u Cb = *(const v4u*)(proj + (size_t)(m0 - 1) * P0W + 1536 + ch), Ub = *(const v4u*)(proj + (size_t)(m0 - 1) * P0W + 2048 + ch);
#pragma unroll
            for (int i = 0; i < 4; ++i) { c2[2 * i] = bf_lo(Ca[i]) * bf_lo(Ua[i]); c2[2 * i + 1] = bf_hi(Ca[i]) * bf_hi(Ua[i]); c1[2 * i] = bf_lo(Cb[i]) * bf_lo(Ub[i]); c1[2 * i + 1] = bf_hi(Cb[i]) * bf_hi(Ub[i]); }
        }
#pragma unroll
        for (int r = 0; r < 8; ++r) { const bf16* rp = proj + (size_t)(m0 + r) * P0W + ch;
            const v4u Bv = __builtin_nontemporal_load((const v4u*)(rp + 1024)), Cv = __builtin_nontemporal_load((const v4u*)(rp + 1536)), Uv = __builtin_nontemporal_load((const v4u*)(rp + 2048));
            float c0[8], y[8];
#pragma unroll
            for (int i = 0; i < 4; ++i) { c0[2 * i] = bf_lo(Cv[i]) * bf_lo(Uv[i]); c0[2 * i + 1] = bf_hi(Cv[i]) * bf_hi(Uv[i]); }
#pragma unroll
            for (int i = 0; i < 8; ++i) y[i] = w0[i] * c2[i] + w1[i] * c1[i] + w2[i] * c0[i];
            v4u o;
#pragma unroll
            for (int i = 0; i < 4; ++i) o[i] = pk2(bf_lo(Bv[i]) * y[2 * i], bf_hi(Bv[i]) * y[2 * i + 1]);
            *(v4u*)(mix + (size_t)(m0 + r) * 1024 + 512 + ch) = o;
#pragma unroll
            for (int i = 0; i < 8; ++i) { c2[i] = c1[i]; c1[i] = c0[i]; } }
    }
}

typedef GAS unsigned gu32;
#define RLX_AGENT __ATOMIC_RELAXED, __HIP_MEMORY_SCOPE_AGENT
constexpr int CW_PANEL = 8192;
constexpr int CW_BAR = 4096;
constexpr int LDSCTL_OFF = RING_BYTES, MISC_OFF = LDSCTL_OFF + 320;
#define XB_TMO      128
#define XB_XCNT(j)  (256  + 64 * (j))
#define XB_XSUB(j)  (1280 + 64 * (j))
#define XB_XGEN(j)  (2304 + 64 * (j))
#define XB_TOP      3328
#define XB_TOPGEN   3392
#define XCD_BAR_WORDS 3456
#define XB_SPIN_CAP (1u << 18)

__device__ __forceinline__ unsigned xb_ld(unsigned* p)              { return __hip_atomic_load(p, __ATOMIC_RELAXED, __HIP_MEMORY_SCOPE_AGENT); }
__device__ __forceinline__ unsigned xb_add(unsigned* p, unsigned v) { return __hip_atomic_fetch_add(p, v, __ATOMIC_RELAXED, __HIP_MEMORY_SCOPE_AGENT); }
__device__ __forceinline__ unsigned xb_xcc_id() { return (unsigned)__builtin_amdgcn_s_getreg((3 << 11) | 20) & 0xFu; }
#define XB_SPIN(cond, bar) do { unsigned _sp = 0; while (cond) { __builtin_amdgcn_s_sleep(1); \
    if ((++_sp & 255u) == 0u) { if (xb_ld(&(bar)[XB_TMO])) break; if (_sp > XB_SPIN_CAP) { atomicAdd(&(bar)[XB_TMO], 1u); break; } } } } while (0)

struct XcdBarrier {
    unsigned* bar; unsigned x;
    volatile LAS unsigned* st;
};

__device__ __forceinline__ XcdBarrier xcd_barrier_post(unsigned* bar, volatile LAS unsigned* st) {
    XcdBarrier b; b.bar = bar; b.x = xb_xcc_id(); b.st = st;
    if (threadIdx.x == 0) (void)xb_add(&bar[XB_XCNT(b.x)], 1u);
    return b;
}
__device__ __forceinline__ void xcd_barrier_complete(unsigned* bar, unsigned x, unsigned& nloc, unsigned& nx) {
    const unsigned G = gridDim.x * gridDim.y * gridDim.z;
    unsigned sum, cnt, mine, sp = 0u;
    for (;;) {
        sum = 0u; cnt = 0u; mine = 0u;
#pragma unroll
        for (unsigned j = 0; j < 16; ++j) { const unsigned c = xb_ld(&bar[XB_XCNT(j)]); sum += c; cnt += (c > 0u) ? 1u : 0u; mine = (j == x) ? c : mine; }
        if (sum == G) break;
        __builtin_amdgcn_s_sleep(1);
        if ((++sp & 255u) == 0u) { if (xb_ld(&bar[XB_TMO])) break; if (sp > XB_SPIN_CAP) { atomicAdd(&bar[XB_TMO], 1u); break; } }
    }
    nloc = mine > 0u ? mine : 1u; nx = cnt > 0u ? cnt : 1u;
}

__device__ __forceinline__ void xcd_barrier_thread0(const XcdBarrier& b) {
    {
        unsigned* bar = b.bar;
        __builtin_amdgcn_s_waitcnt(0);
        unsigned nloc = b.st[0], nx = b.st[1];
        if (nloc == 0u) { xcd_barrier_complete(bar, b.x, nloc, nx); b.st[0] = nloc; b.st[1] = nx; }
        const unsigned old = xb_add(&bar[XB_XSUB(b.x)], 1u);
        const unsigned gen = old / nloc;
        if (old + 1u == (gen + 1u) * nloc) {
            __builtin_amdgcn_fence(__ATOMIC_RELEASE, "agent");
            asm volatile("s_waitcnt vmcnt(0)" ::: "memory");
            const unsigned og = xb_add(&bar[XB_TOP], 1u);
            const unsigned tg = og / nx;
            if (og + 1u == (tg + 1u) * nx) xb_add(&bar[XB_TOPGEN], 1u);
            else XB_SPIN(xb_ld(&bar[XB_TOPGEN]) == tg, bar);
            __builtin_amdgcn_fence(__ATOMIC_ACQUIRE, "agent");
            xb_add(&bar[XB_XGEN(b.x)], 1u);
            asm volatile("s_waitcnt vmcnt(0)" ::: "memory");
        } else {
            XB_SPIN(xb_ld(&bar[XB_XGEN(b.x)]) == gen, bar);
            __builtin_amdgcn_fence(__ATOMIC_ACQUIRE, "agent");
            asm volatile("s_waitcnt vmcnt(0)" ::: "memory");
        }
    }
}
__device__ __forceinline__ void xcd_barrier(const XcdBarrier& b) {
    asm volatile("s_waitcnt vmcnt(0)" ::: "memory");
    __syncthreads();
    if (threadIdx.x == 0) xcd_barrier_thread0(b);
    __syncthreads();
}
#define LAYER_TAIL(layer) \
        { PHASE_IDS pg8::Gemm g{MIXp, WLp(layer, W_OUT), MTOK, 1024, 1024}; pg8::StaticOrder S; S.init(MTOK, 1024, G, bx); \
          pg8::EpiRes E{layer ? (const float*)XRES : XIN, XRES, XBp, SSQ(2 * layer + 1)}; \
          pg8::gemm_phase<pg8::EpiRes, pg8::StaticOrder, PG8_ALIGN, PG8_SP2>(ldsp, g, S, E); } \
        if (layer == 0) xcd_barrier_work(bar, args, WSLICE(3), ldsp); else xcd_barrier(bar); \
        { PHASE_IDS pg8::Gemm g{XBp, WLp(layer, W_UP), MTOK, FF, 1024}; pg8::StaticOrder S; S.init(MTOK, FF, G, bx); \
          pg8::EpiRow<1> E{HBp, FF, SSQ(2 * layer + 1), 0, 1.f}; \
          pg8::gemm_phase<pg8::EpiRow<1>, pg8::StaticOrder, PG8_ALIGN, PG8_SP2>(ldsp, g, S, E); } \
        if (layer == 0) xcd_barrier_work(bar, args, WSLICE(4), ldsp); else xcd_barrier(bar); \
        if (layer == 1 && gridDim.x == 256) {     \
          PHASE_IDS pg8::Gemm g{HBp, WLp(layer, W_DOWN), MTOK, 1024, FF}; pg8::StaticOrder S; S.init(MTOK, 1024, G, bx); \
          pg8::EpiResFinal E{XRES, XRES, SSQ(4), (unsigned*)(args.ws + WS_CTL) + CW_PANEL, args.in[3]}; \
          pg8::gemm_phase<pg8::EpiResFinal, pg8::StaticOrder, false, PG8_SP2>(ldsp, g, S, E); \
        } else { \
        { PHASE_IDS pg8::Gemm g{HBp, WLp(layer, W_DOWN), MTOK, 1024, FF}; pg8::StaticOrder S; S.init(MTOK, 1024, G, bx); \
          pg8::EpiRes E{XRES, XRES, XBp, SSQ(2 * layer + 2)}; \
          pg8::gemm_phase<pg8::EpiRes, pg8::StaticOrder, PG8_ALIGN, PG8_SP2>(ldsp, g, S, E); } \
        if (layer == 0) xcd_barrier_work(bar, args, WSLICE(5), ldsp); else xcd_barrier(bar); }
constexpr int I_IN = 16 * 96, I_OUT = 16 * 32, I_UP = 16 * 128, I_DN = 64 * 32, I_L = I_IN + I_OUT + I_UP + I_DN;
struct Args { const float* in[16]; float* out; unsigned char* ws; };
struct CvtItem { const float* wp; bf16* op; int N, K; f32x4 g0, g1; };
__device__ __forceinline__ void cvt_decode(const Args& args, int it, int lane, CvtItem& d) {
    const int l = it / I_L; int r = it % I_L;
    const float* W; bf16* WT; int K = 1024, N; const float* gs = nullptr; int gmask = 1023; float gmul = 1.f; bool remap = false;
    if (r < I_IN) { W = l ? args.in[7] : args.in[4]; N = 3072; WT = (bf16*)(args.ws + WS_W + (size_t)l * W_LAYER + W_IN); gs = args.in[1] + l * 1024; remap = (l == 0); }
    else if ((r -= I_IN) < I_OUT) { W = l ? args.in[13] : args.in[6]; N = 1024; WT = (bf16*)(args.ws + WS_W + (size_t)l * W_LAYER + W_OUT); gs = l ? args.in[12] : nullptr; gmask = 127; gmul = 1.0f - LAMBDA_INIT1; }
    else if ((r -= I_OUT) < I_UP) { W = args.in[14] + (size_t)l * 1024 * 4096; N = 4096; WT = (bf16*)(args.ws + WS_W + (size_t)l * W_LAYER + W_UP); gs = args.in[2] + l * 1024; }
    else { r -= I_UP; W = args.in[15] + (size_t)l * 4096 * 1024; K = 4096; N = 1024; WT = (bf16*)(args.ws + WS_W + (size_t)l * W_LAYER + W_DOWN); }
    const int nblk = N / 32, kb = r / nblk, nb = r % nblk, k0 = 64 * kb, n0 = 32 * nb, c = lane & 7;
    int r0 = n0; if (remap) r0 = n0 < 1024 ? n0 : (n0 < 1536 ? n0 + 1536 : n0 - 512);
    d.N = N; d.K = K; d.wp = W + (size_t)(k0 + (lane >> 3)) * N + n0 + 4 * c; d.op = WT + (size_t)(r0 + (lane >> 3)) * K + k0 + 8 * c;
    d.g0 = (f32x4){1.f, 1.f, 1.f, 1.f}; d.g1 = d.g0;
    if (gs) { const float* gp = gs + ((k0 + 8 * c) & gmask); d.g0 = *(const f32x4*)gp * gmul; d.g1 = *(const f32x4*)(gp + 4) * gmul; }
}
__device__ __forceinline__ void cvt_load(const CvtItem& d, f32x4 (&v)[8]) {
#pragma unroll
    for (int i = 0; i < 8; ++i) v[i] = __builtin_nontemporal_load((const f32x4*)(d.wp + (size_t)(8 * i) * d.N));
}
__device__ __forceinline__ void cvt_lds_write(const f32x4 (&v)[8], LAS float* scr, int lane) {
    const int c = lane & 7;
#pragma unroll
    for (int i = 0; i < 8; ++i) { LAS float* p = scr + (8 * i + (lane >> 3)) * 33 + 4 * c; p[0] = v[i][0]; p[1] = v[i][1]; p[2] = v[i][2]; p[3] = v[i][3]; }
    LDS_WAIT(); asm volatile("" ::: "memory");
}
__device__ __forceinline__ void cvt_lds_read_store(const CvtItem& d, LAS float* scr, int lane) {
    const int c = lane & 7;
#pragma unroll
    for (int j = 0; j < 4; ++j) { const LAS float* s = scr + (8 * c) * 33 + (lane >> 3) + 8 * j;
        v4u o; o.x = pk2(s[0 * 33] * d.g0[0], s[1 * 33] * d.g0[1]); o.y = pk2(s[2 * 33] * d.g0[2], s[3 * 33] * d.g0[3]); o.z = pk2(s[4 * 33] * d.g1[0], s[5 * 33] * d.g1[1]); o.w = pk2(s[6 * 33] * d.g1[2], s[7 * 33] * d.g1[3]);
        *(GAS v4u*)(d.op + (size_t)(8 * j) * d.K) = o; }
    LDS_WAIT(); asm volatile("" ::: "memory");
}
__device__ __forceinline__ void convert_items(const Args& args, int lo, int hi, int gw, int NGW, int lane, LAS float* scr) {
    int it = lo + gw; if (it >= hi) return;
    CvtItem A, B, C; f32x4 va[8], vb[8];
    cvt_decode(args, it, lane, A); cvt_load(A, va);
    bool hb = (it + NGW) < hi; B = A;
#pragma unroll
    for (int i = 0; i < 8; ++i) vb[i] = va[i];
    if (hb) { cvt_decode(args, it + NGW, lane, B); cvt_load(B, vb); }
    for (;;) {
        cvt_lds_write(va, scr, lane);
        const bool hc = (it + 2 * NGW) < hi; C = A;
        if (hc) { cvt_decode(args, it + 2 * NGW, lane, C); cvt_load(C, va); }
        cvt_lds_read_store(A, scr, lane);
        if (!hb) break;
        cvt_lds_write(vb, scr, lane);
        const bool hd = (it + 3 * NGW) < hi; A = B;
        CvtItem D = B;
        if (hd) { cvt_decode(args, it + 3 * NGW, lane, D); cvt_load(D, vb); }
        cvt_lds_read_store(A, scr, lane);
        if (!hc) break;
        A = C; B = D; hb = hd; it += 2 * NGW;
    }
}
#define CONVERT_ITEMS(lo, hi) convert_items(args, (lo), (hi), gw, NGW, lane, scr);
__device__ __forceinline__ void xcd_barrier_work(const XcdBarrier& b, const Args& args, int lo, int hi, LAS unsigned char* ldsp) {
    asm volatile("s_waitcnt vmcnt(0)" ::: "memory");
    __syncthreads();
    int tid = threadIdx.x; asm volatile("" : "+v"(tid));
    const int wave = __builtin_amdgcn_readfirstlane(tid >> 6);
    if (wave == 0) { if (tid == 0) xcd_barrier_thread0(b); }
    else { int G = gridDim.x, bx = blockIdx.x; asm volatile("" : "+s"(G), "+s"(bx)); const int vcu = (G % 8 == 0) ? (bx % 8) * (G / 8) + bx / 8 : bx;
           convert_items(args, lo, hi, vcu * 7 + (wave - 1), G * 7, tid & 63, (LAS float*)(ldsp + wave * 16384)); }
    __syncthreads();
}
constexpr int I_W = (2 * I_L - I_IN) / 6;
#define WSLICE(k) (I_IN + (k) * I_W), (I_IN + ((k) + 1) * I_W)
static_assert((2 * I_L - I_IN) % 6 == 0 && I_IN + 1 * I_W >= I_IN + I_OUT && I_IN + 2 * I_W >= I_IN + I_OUT + I_UP && I_IN + 3 * I_W >= I_L && I_IN + 4 * I_W >= I_L + I_IN + I_OUT, "slice k is published by barrier k+1: out0 by 1, up0 by 2, down0 by 3, in1 by 4, out1 by 6, up1 by 7, down1 by 8");

__global__ void __launch_bounds__(NWAVES * 64, 2) mega_fwd(Args args) {
    extern __shared__ __attribute__((aligned(16))) unsigned char lds[];
    cg::grid_group grid = cg::this_grid();
    LAS unsigned char* ldsp = (LAS unsigned char*)lds;
    for (int u = threadIdx.x; u < (LDS_BYTES - LDSCTL_OFF) / 4; u += NWAVES * 64) ((LAS unsigned*)(ldsp + LDSCTL_OFF))[u] = 0u;
    __syncthreads();
    const XcdBarrier bar = xcd_barrier_post((unsigned*)(args.ws + WS_CTL) + CW_BAR, (volatile LAS unsigned*)(ldsp + MISC_OFF) + 8);
#define PHASE_IDS int tid = threadIdx.x; asm volatile("" : "+v"(tid)); const int lane = tid & 63, wave = __builtin_amdgcn_readfirstlane(tid >> 6); \
    int G = gridDim.x, bx = blockIdx.x; asm volatile("" : "+s"(G), "+s"(bx)); const int vcu = (G % 8 == 0) ? (bx % 8) * (G / 8) + bx / 8 : bx; \
    const int gw = vcu * NWAVES + wave, NGW = G * NWAVES; (void)lane; (void)gw; (void)NGW; (void)tid;
#define XIN   (args.in[0])
#define XRES  (args.out)
#define SSQ(i) ((float*)(args.ws + WS_SSQ) + (size_t)(i) * MTOK)
#define XBp   ((bf16*)(args.ws + WS_XB))
#define PROJp ((bf16*)(args.ws + WS_PROJ))
#define VTp   ((bf16*)(args.ws + WS_VT))
#define MIXp  ((bf16*)(args.ws + WS_MIX))
#define HBp   ((bf16*)(args.ws + WS_H))
#define WLp(l, off) ((bf16*)(args.ws + WS_W + (size_t)(l) * W_LAYER + (off)))

    {
        PHASE_IDS
        LAS float* scr = (LAS float*)(ldsp + wave * 16384);
        CONVERT_ITEMS(0, I_IN)
        for (int m = 2 * gw; m < MTOK; m += 2 * NGW) x_rows2_to_bf16(XIN + (size_t)m * 1024, XBp + (size_t)m * 1024, SSQ(0) + m, lane);
    }
    if (args.ws == nullptr) grid.sync();
    xcd_barrier_work(bar, args, WSLICE(0), ldsp);

    {
        { PHASE_IDS pg8::Gemm g{XBp, WLp(0, W_IN), MTOK, P0W, 1024}; pg8::StaticOrder S; S.init(MTOK, P0W, G, bx);
          pg8::EpiRow<0> E{PROJp, P0W, SSQ(0), 2, QSCALE};
          pg8::gemm_phase<pg8::EpiRow<0>, pg8::StaticOrder, PG8_ALIGN, PG8_SP2>(ldsp, g, S, E); }
        { PHASE_IDS pg8::Gemm g{WLp(0, W_IN) + (size_t)P0W * 1024, XBp, 512, MTOK, 1024}; pg8::StaticOrder S; S.init(512, MTOK, G, (bx + G / 2) % G);
          pg8::EpiColScale E{VTp, MTOK, SSQ(0)};
          pg8::gemm_phase<pg8::EpiColScale, pg8::StaticOrder, PG8_ALIGN, PG8_SP2>(ldsp, g, S, E); }
        xcd_barrier_work(bar, args, WSLICE(1), ldsp);
        { PHASE_IDS
          conv_items(PROJp, args.in[5], MIXp, vcu * (NWAVES * 64) + tid, G * NWAVES * 64);
          LAS float* scr = (LAS float*)(ldsp + wave * 16384);
          for (int u = gw; u < 2 * 8 * 256; u += NGW) sb_unit(u >> 11, (u >> 8) & 7, u & 255, PROJp, VTp, MIXp, ldsp + wave * 16384 + 8704, lane);
          (void)scr; }
        xcd_barrier_work(bar, args, WSLICE(2), ldsp);
        LAYER_TAIL(0)
    }
    {
        { PHASE_IDS pg8::Gemm g{XBp, WLp(1, W_IN), MTOK, P1W, 1024}; pg8::StaticOrder S; S.init(MTOK, P1W, G, bx);
          pg8::EpiRow<0> E{PROJp, P1W, SSQ(2), 4, QSCALE};
          pg8::gemm_phase<pg8::EpiRow<0>, pg8::StaticOrder, PG8_ALIGN, PG8_SP2>(ldsp, g, S, E); }
        xcd_barrier(bar);
        { PHASE_IDS const dattn::DiffOrder S(vcu, G); dattn::diff_phase((char*)lds, PROJp, MIXp, S); }
        { PHASE_IDS float lam;
          { const float a = wave_sum(args.in[8][lane] * args.in[9][lane]), c = wave_sum(args.in[10][lane] * args.in[11][lane]); lam = __expf(a) - __expf(c) + LAMBDA_INIT1; }
          const dattn::DiffOrder S(vcu, G); dattn::diff_combine(PROJp, MIXp, S, lam); }
        xcd_barrier(bar);
        LAYER_TAIL(1)
    }
    if (gridDim.x != 256) { PHASE_IDS const float* ssq_f = SSQ(4);
      f32x4 gv[4];
#pragma unroll
      for (int j = 0; j < 4; ++j) gv[j] = ((const f32x4*)args.in[3])[lane + 64 * j];
      for (int m = 2 * gw; m < MTOK; m += 2 * NGW) { const float rs0 = pg8::rstd_of(ssq_f[m]), rs1 = pg8::rstd_of(ssq_f[m + 1]); f32x4* xr = (f32x4*)(XRES + (size_t)m * 1024) + lane;
          f32x4 v[8];
#pragma unroll
          for (int j = 0; j < 8; ++j) v[j] = xr[64 * j];
#pragma unroll
          for (int j = 0; j < 4; ++j) { xr[64 * j] = v[j] * rs0 * gv[j]; xr[256 + 64 * j] = v[4 + j] * rs1 * gv[j]; } } }
}

extern "C" void kernel_launch(void* const* d_in, const int* in_sizes, int n_in, void* d_out, int out_size, void* d_ws, size_t ws_size, hipStream_t stream) {
    static int grid = 0;
    if (grid == 0) {
        if (n_in != 16 || in_sizes[0] != MTOK * DMOD || out_size != MTOK * DMOD || ws_size < WS_END) { fprintf(stderr, "kernel_launch: unexpected shapes (n_in %d, in0 %d, out %d, ws %zu)\n", n_in, n_in > 0 ? in_sizes[0] : -1, out_size, ws_size); grid = -1; return; }
        int dev = 0, cus = 0, per_cu = 0;
        if (hipGetDevice(&dev) != hipSuccess || hipDeviceGetAttribute(&cus, hipDeviceAttributeMultiprocessorCount, dev) != hipSuccess) { grid = -1; return; }
        if (hipFuncSetAttribute((const void*)mega_fwd, hipFuncAttributeMaxDynamicSharedMemorySize, LDS_BYTES) != hipSuccess) { fprintf(stderr, "kernel_launch: hipFuncSetAttribute failed\n"); grid = -1; return; }
        if (hipOccupancyMaxActiveBlocksPerMultiprocessor(&per_cu, (const void*)mega_fwd, NWAVES * 64, LDS_BYTES) != hipSuccess || per_cu < 1) { fprintf(stderr, "kernel_launch: occupancy query says %d\n", per_cu); per_cu = 1; }
        (void)hipGetLastError();
        grid = cus;
    }
    if (grid < 0) return;
    (void)hipMemsetAsync((char*)d_ws + WS_CTL, 0, CTL_ZERO_BYTES, stream);
    Args a{};
    for (int i = 0; i < 16; ++i) a.in[i] = (const float*)d_in[i];
    a.out = (float*)d_out; a.ws = (unsigned char*)d_ws;
    void* kargs[] = {&a};
    hipError_t e = hipLaunchCooperativeKernel((const void*)mega_fwd, dim3(grid), dim3(NWAVES * 64), kargs, LDS_BYTES, stream);
    if (e != hipSuccess) fprintf(stderr, "kernel_launch: cooperative launch failed: %s (grid %d)\n", hipGetErrorString(e), grid);
}
```

```cpp
#include <hip/hip_runtime.h>
#include <cstdio>
#include <cstdint>
namespace pg8 {
#define PG8_LAS __attribute__((address_space(3)))
typedef unsigned short bf16_t;
typedef short bf16x8 __attribute__((ext_vector_type(8)));
typedef float f32x4 __attribute__((ext_vector_type(4)));
typedef unsigned u32x4 __attribute__((ext_vector_type(4)));
constexpr int BM = 256, BK = 64, HALF = 128, HTB = HALF * BK * 2  , STAGE_BYTES = 8 * HTB, NXCD = 8, WGM = 8;

__host__ __device__ __forceinline__ int lds_byte(int r, int c) { const int st = (r >> 4) * 2 + (c >> 5), rr = r & 15, cc = c & 31, ob = rr * 64 + cc * 2; return st * 1024 + (ob ^ (((ob >> 9) & 1) << 5)); }
__host__ __device__ __forceinline__ void stage_rc(int b, int& R, int& C) { const int st = b / 1024, sb = b % 1024, swz = sb ^ (((sb >> 9) & 1) << 5); R = (st >> 1) * 16 + swz / 64; C = (st & 1) * 32 + (swz % 64) / 2; }
__host__ __device__ __forceinline__ int perm32(int rho) { const int n = rho >> 4, i = rho & 15; return 8 * (i >> 2) + 4 * n + (i & 3); }

struct Unit { int pm, pn; };
struct Gemm { const bf16_t* A; const bf16_t* Bt; int M, N, K; };

struct StaticOrder {
    int nM, nN, nwg, G, c;
    __host__ __device__ void init(int M, int N, int G_, int c_) { nM = M / BM; nN = N / BM; nwg = nM * nN; G = G_; c = c_; }
    __host__ __device__ bool next(int i, Unit& u) const {
        const long L = (long)i * G + c; if (L >= nwg) return false;
        int wgid = (int)L; { const int q = nwg / NXCD, r = nwg % NXCD, xcd = wgid % NXCD, off = wgid / NXCD; wgid = (xcd < r ? xcd * (q + 1) : r * (q + 1) + (xcd - r) * q) + off; }
        const int nig = WGM * nN, gid = wgid / nig, fm = gid * WGM, gsz = (nM - fm) < WGM ? (nM - fm) : WGM;
        u.pm = fm + ((wgid % nig) % gsz); u.pn = (wgid % nig) / gsz; return true;
    }
    __device__ __forceinline__ void a_ready(const Unit&) const {}
    __device__ __forceinline__ void done(const Unit&) const {}
};

__device__ __forceinline__ unsigned cvt_pk_bf16(float lo, float hi) { unsigned r; asm volatile("v_cvt_pk_bf16_f32 %0, %1, %2" : "=v"(r) : "v"(lo), "v"(hi)); return r; }
typedef float f32x2 __attribute__((ext_vector_type(2)));
__device__ __forceinline__ float rstd_of(float ssq) { return __builtin_amdgcn_rsqf(ssq * (1.0f / 1024.0f) + 1e-6f); }
typedef unsigned u32x2 __attribute__((ext_vector_type(2)));
template <int ACT> struct EpiRow {
    static constexpr bool PERM = true, AFTER_DRAIN = false;
    bf16_t* O; int ldc; const float* ssq; int qtiles; float qscale;
    __device__ __forceinline__ void operator()(const f32x4 (&acc)[2][2][4][2], const Unit& u, int wr, int wc, int fr, int fq) const {
        const int row0 = u.pm * BM + wr * 64 + fr, col0 = u.pn * BM + wc * 32 + 8 * fq;
        const float sc = (u.pn < qtiles) ? qscale : 1.f;
        float rsv[2][4];
#pragma unroll
        for (int ai = 0; ai < 2; ++ai)
#pragma unroll
            for (int m = 0; m < 4; ++m) rsv[ai][m] = ssq[row0 + ai * HALF + m * 16];
#pragma unroll
        for (int ai = 0; ai < 2; ++ai)
#pragma unroll
            for (int m = 0; m < 4; ++m) { const int row = row0 + ai * HALF + m * 16; const float rs = rstd_of(rsv[ai][m]) * sc; bf16_t* rowp = O + (size_t)row * ldc + col0;
#pragma unroll
                for (int bj = 0; bj < 2; ++bj) { f32x4 v0 = acc[ai][bj][m][0], v1 = acc[ai][bj][m][1];
                    if (ACT == 1) { const f32x4 z = {0.f, 0.f, 0.f, 0.f}; v0 = __builtin_elementwise_max(v0, z) * rs; v1 = __builtin_elementwise_max(v1, z) * rs; v0 = v0 * v0; v1 = v1 * v1; }
                    else { v0 = v0 * rs; v1 = v1 * rs; }
                    u32x4 w; w.x = cvt_pk_bf16(v0[0], v0[1]); w.y = cvt_pk_bf16(v0[2], v0[3]); w.z = cvt_pk_bf16(v1[0], v1[1]); w.w = cvt_pk_bf16(v1[2], v1[3]);
                    *(u32x4*)(rowp + bj * HALF) = w; } }
    }
};
struct EpiColScale {
    static constexpr bool PERM = true, AFTER_DRAIN = false;
    bf16_t* O; int ldc; const float* ssq;
    __device__ __forceinline__ void operator()(const f32x4 (&acc)[2][2][4][2], const Unit& u, int wr, int wc, int fr, int fq) const {
        const int row0 = u.pm * BM + wr * 64 + fr, col0 = u.pn * BM + wc * 32 + 8 * fq;
        f32x4 sv[2][2];
#pragma unroll
        for (int bj = 0; bj < 2; ++bj)
#pragma unroll
            for (int n = 0; n < 2; ++n) { const f32x4 s = *(const f32x4*)(ssq + col0 + bj * HALF + 4 * n); sv[bj][n] = (f32x4){rstd_of(s[0]), rstd_of(s[1]), rstd_of(s[2]), rstd_of(s[3])}; }
#pragma unroll
        for (int ai = 0; ai < 2; ++ai)
#pragma unroll
            for (int m = 0; m < 4; ++m) { bf16_t* rowp = O + (size_t)(row0 + ai * HALF + m * 16) * ldc + col0;
#pragma unroll
                for (int bj = 0; bj < 2; ++bj) { const f32x4 v0 = acc[ai][bj][m][0] * sv[bj][0], v1 = acc[ai][bj][m][1] * sv[bj][1];
                    u32x4 w; w.x = cvt_pk_bf16(v0[0], v0[1]); w.y = cvt_pk_bf16(v0[2], v0[3]); w.z = cvt_pk_bf16(v1[0], v1[1]); w.w = cvt_pk_bf16(v1[2], v1[3]);
                    *(u32x4*)(rowp + bj * HALF) = w; } }
    }
};
struct EpiRes {
    static constexpr bool PERM = false, AFTER_DRAIN = false;
    const float* base; float* out; bf16_t* xb; float* ssq;
    __device__ __forceinline__ void operator()(const f32x4 (&acc)[2][2][4][2], const Unit& u, int wr, int wc, int fr, int fq) const {
        const int row0 = u.pm * BM + wr * 64 + fr, col0 = u.pn * BM + wc * 32 + 4 * fq;
#pragma unroll
        for (int ai = 0; ai < 2; ++ai) {
            f32x4 pre[4][2][2];
#pragma unroll
            for (int m = 0; m < 4; ++m) { const size_t off = (size_t)(row0 + ai * HALF + m * 16) * 1024 + col0;
#pragma unroll
                for (int bj = 0; bj < 2; ++bj)
#pragma unroll
                    for (int n = 0; n < 2; ++n) pre[m][bj][n] = __builtin_nontemporal_load((const f32x4*)(base + off + bj * HALF + n * 16)); }
            asm volatile("" ::: "memory");
#pragma unroll
            for (int m = 0; m < 4; ++m) { const int row = row0 + ai * HALF + m * 16; const size_t off = (size_t)row * 1024 + col0; float s = 0.f;
#pragma unroll
                for (int bj = 0; bj < 2; ++bj)
#pragma unroll
                    for (int n = 0; n < 2; ++n) { const f32x4 v = pre[m][bj][n] + acc[ai][bj][m][n];
                        __builtin_nontemporal_store(v, (f32x4*)(out + off + bj * HALF + n * 16)); s += (v[0] * v[0] + v[1] * v[1]) + (v[2] * v[2] + v[3] * v[3]);
                        u32x2 w; w.x = cvt_pk_bf16(v[0], v[1]); w.y = cvt_pk_bf16(v[2], v[3]); *(u32x2*)(xb + off + bj * HALF + n * 16) = w; }
                s += __shfl_xor(s, 16); s += __shfl_xor(s, 32);
                if (fq == 0) __hip_atomic_fetch_add(ssq + row, s, __ATOMIC_RELAXED, __HIP_MEMORY_SCOPE_AGENT); }
            asm volatile("" ::: "memory");
        }
    }
};

struct EpiResFinal {
    static constexpr bool PERM = false, AFTER_DRAIN = true;
    const float* base; float* out; float* ssq; unsigned* cnt; const float* gain;
    __device__ __forceinline__ void operator()(const f32x4 (&)[2][2][4][2], const Unit&, int, int, int, int) const {}
    __device__ __forceinline__ void fused(f32x4 (&acc)[2][2][4][2], const Unit& u, int wr, int wc, int fr, int fq, PG8_LAS unsigned char*, int, int lane) const {
        const int row0 = u.pm * BM + wr * 64 + fr, col0 = u.pn * BM + wc * 32 + 4 * fq;
#pragma unroll
        for (int ai = 0; ai < 2; ++ai) {
            f32x4 pre[4][2][2];
#pragma unroll
            for (int m = 0; m < 4; ++m) { const size_t off = (size_t)(row0 + ai * HALF + m * 16) * 1024 + col0;
#pragma unroll
                for (int bj = 0; bj < 2; ++bj)
#pragma unroll
                    for (int n = 0; n < 2; ++n) pre[m][bj][n] = __builtin_nontemporal_load((const f32x4*)(base + off + bj * HALF + n * 16)); }
            asm volatile("" ::: "memory");
#pragma unroll
            for (int m = 0; m < 4; ++m) { const int row = row0 + ai * HALF + m * 16; float s = 0.f;
#pragma unroll
                for (int bj = 0; bj < 2; ++bj)
#pragma unroll
                    for (int n = 0; n < 2; ++n) { const f32x4 v = pre[m][bj][n] + acc[ai][bj][m][n]; acc[ai][bj][m][n] = v; s += (v[0] * v[0] + v[1] * v[1]) + (v[2] * v[2] + v[3] * v[3]); }
                s += __shfl_xor(s, 16); s += __shfl_xor(s, 32);
                if (fq == 0) __hip_atomic_fetch_add(ssq + row, s, __ATOMIC_RELAXED, __HIP_MEMORY_SCOPE_AGENT); }
        }
        asm volatile("s_waitcnt vmcnt(0)" ::: "memory");
        unsigned* c = cnt + 64 * u.pm;
        if (lane == 0) __hip_atomic_fetch_add(c, 1u, __ATOMIC_RELAXED, __HIP_MEMORY_SCOPE_AGENT);
        { unsigned sp = 0; while ((unsigned)__builtin_amdgcn_readfirstlane(__hip_atomic_load(c, __ATOMIC_RELAXED, __HIP_MEMORY_SCOPE_AGENT)) < 32u) { __builtin_amdgcn_s_sleep(2); if (++sp > (1u << 22)) break; } }
        __builtin_amdgcn_fence(__ATOMIC_ACQUIRE, "agent");
        f32x4 gv[2][2];
#pragma unroll
        for (int bj = 0; bj < 2; ++bj)
#pragma unroll
            for (int n = 0; n < 2; ++n) gv[bj][n] = *(const f32x4*)(gain + col0 + bj * HALF + n * 16);
        float rsv[2][4];
#pragma unroll
        for (int ai = 0; ai < 2; ++ai)
#pragma unroll
            for (int m = 0; m < 4; ++m) rsv[ai][m] = __hip_atomic_load(ssq + row0 + ai * HALF + m * 16, __ATOMIC_RELAXED, __HIP_MEMORY_SCOPE_AGENT);
#pragma unroll
        for (int ai = 0; ai < 2; ++ai)
#pragma unroll
            for (int m = 0; m < 4; ++m) { const float rs = rstd_of(rsv[ai][m]); const size_t off = (size_t)(row0 + ai * HALF + m * 16) * 1024 + col0;
#pragma unroll
                for (int bj = 0; bj < 2; ++bj)
#pragma unroll
                    for (int n = 0; n < 2; ++n) __builtin_nontemporal_store(acc[ai][bj][m][n] * rs * gv[bj][n], (f32x4*)(out + off + bj * HALF + n * 16)); }
    }
};

template <class Epi, class Sched, bool ALIGN_EPI = false, bool SP2 = false>
__device__ __forceinline__ void gemm_phase(PG8_LAS unsigned char* lds, const Gemm g, const Sched& S, const Epi& E) {
    int tid_ = threadIdx.x; asm volatile("" : "+v"(tid_));
    const int tid = tid_, wid = __builtin_amdgcn_readfirstlane(tid >> 6), lane = tid & 63, wr = wid >> 2, wc = wid & 3, fr = lane & 15, fq = lane >> 4;
    const int K = g.K, nt = K / BK;
    unsigned voffA[2], voffB[2];
#pragma unroll
    for (int i = 0; i < 2; ++i) { int R, C; stage_rc(tid * 16 + i * 8192, R, C); const int Rb = Epi::PERM ? ((R & ~31) + perm32(R & 31)) : R;
        voffA[i] = (unsigned)(R * K + C) * 2u; voffB[i] = (unsigned)(Rb * K + C) * 2u; }
    const size_t kstep = (size_t)(BK * 2);
    const size_t hstep = (size_t)HALF * K * 2;
    const size_t tstep = 2 * hstep;
    const unsigned ldsw = (unsigned)wid * 1024u;
    const int aoff = lds_byte(wr * 64 + fr, fq * 8), boff = lds_byte(wc * 32 + fr, fq * 8);
#define PG8_SA(b, h) (((b) * 2 + (h)) * HTB)
#define PG8_SB(b, h) ((4 + (b) * 2 + (h)) * HTB)
#define PG8_STAGE(bufoff, gbase, voff) do { _Pragma("unroll") for (int _i = 0; _i < 2; ++_i) \
        __builtin_amdgcn_global_load_lds((const unsigned*)((const char*)(gbase) + (voff)[_i]), (PG8_LAS unsigned*)(lds + (bufoff) + ldsw + _i * 8192), 16, 0, 0); } while (0)
#define PG8_LDA(dst, b, h) do { _Pragma("unroll") for (int m = 0; m < 4; ++m) _Pragma("unroll") for (int k = 0; k < 2; ++k) dst[m][k] = *(const PG8_LAS bf16x8*)(lds + PG8_SA(b, h) + aoff + m * 2048 + k * 1024); } while (0)
#define PG8_LDB(dst, b, h) do { _Pragma("unroll") for (int n = 0; n < 2; ++n) _Pragma("unroll") for (int k = 0; k < 2; ++k) dst[n][k] = *(const PG8_LAS bf16x8*)(lds + PG8_SB(b, h) + boff + n * 2048 + k * 1024); } while (0)
#define PG8_MMA(ai, bj, At, Bt) do { __builtin_amdgcn_s_setprio(1); _Pragma("unroll") for (int m = 0; m < 4; ++m) _Pragma("unroll") for (int n = 0; n < 2; ++n) _Pragma("unroll") for (int k = 0; k < 2; ++k) \
        acc[ai][bj][m][n] = __builtin_amdgcn_mfma_f32_16x16x32_bf16(Bt[n][k], At[m][k], acc[ai][bj][m][n], 0, 0, 0); __builtin_amdgcn_s_setprio(0); } while (0)
#define PG8_WAIT_V(n) asm volatile("s_waitcnt vmcnt(" #n ")" ::: "memory")
#define PG8_WAIT_L(n) asm volatile("s_waitcnt lgkmcnt(" #n ")" ::: "memory")
#define PG8_BAR __builtin_amdgcn_s_barrier()
#define PG8_SCHED __builtin_amdgcn_sched_barrier(0)
    Unit cur, nxt; int ui = 0;
    if (!S.next(0, cur)) return;
    f32x4 acc[2][2][4][2];
#pragma unroll
    for (int a = 0; a < 2; ++a)
#pragma unroll
        for (int b = 0; b < 2; ++b)
#pragma unroll
            for (int m = 0; m < 4; ++m)
#pragma unroll
                for (int n = 0; n < 2; ++n) acc[a][b][m][n] = (f32x4){0.f, 0.f, 0.f, 0.f};
    bf16x8 At[4][2], B0[2][2], B1[2][2];
    const char* cA = (const char*)g.A + (size_t)cur.pm * tstep; const char* cB = (const char*)g.Bt + (size_t)cur.pn * tstep;
    S.a_ready(cur);
    if constexpr (SP2) {
        PG8_STAGE(PG8_SB(0, 0), cB, voffB); PG8_STAGE(PG8_SB(0, 1), cB + hstep, voffB); PG8_STAGE(PG8_SA(0, 0), cA, voffA); PG8_STAGE(PG8_SA(0, 1), cA + hstep, voffA);
        if (wr == 1) PG8_BAR;
        PG8_WAIT_V(2); PG8_BAR;
        PG8_STAGE(PG8_SB(1, 0), cB + kstep, voffB); PG8_STAGE(PG8_SA(1, 0), cA + kstep, voffA); PG8_STAGE(PG8_SB(1, 1), cB + hstep + kstep, voffB);
        PG8_WAIT_V(6); PG8_BAR;
    } else {
        PG8_STAGE(PG8_SB(0, 0), cB, voffB); PG8_STAGE(PG8_SA(0, 0), cA, voffA); PG8_STAGE(PG8_SB(0, 1), cB + hstep, voffB); PG8_STAGE(PG8_SA(0, 1), cA + hstep, voffA);
        if (wr == 1) PG8_BAR;
        PG8_WAIT_V(4); PG8_BAR;
        PG8_STAGE(PG8_SB(1, 0), cB + kstep, voffB); PG8_STAGE(PG8_SA(1, 0), cA + kstep, voffA); PG8_STAGE(PG8_SB(1, 1), cB + hstep + kstep, voffB);
        PG8_WAIT_V(6); PG8_BAR;
    }
    for (;;) {
        const bool has_next = S.next(ui + 1, nxt);
        const char* nA = has_next ? (const char*)g.A + (size_t)nxt.pm * tstep : cA; const char* nB = has_next ? (const char*)g.Bt + (size_t)nxt.pn * tstep : cB;
        for (int t = 0; t < nt; t += 2) {
            const bool last = (t == nt - 2);
            const char* a1 = cA + (size_t)(t + 1) * kstep;
            const char* a2 = last ? nA : cA + (size_t)(t + 2) * kstep; const char* b2 = last ? nB : cB + (size_t)(t + 2) * kstep;
            const char* a3 = a2 + kstep; const char* b3 = b2 + kstep;
            if (last && has_next) S.a_ready(nxt);
            if constexpr (SP2) {
            PG8_LDB(B0, 0, 0); PG8_LDB(B1, 0, 1); PG8_SCHED; PG8_LDA(At, 0, 0); PG8_STAGE(PG8_SA(1, 1), a1 + hstep, voffA);
            PG8_WAIT_V(8); PG8_WAIT_L(0); PG8_BAR; PG8_MMA(0, 0, At, B0); PG8_MMA(0, 1, At, B1); PG8_BAR; PG8_SCHED;
            PG8_LDA(At, 0, 1); PG8_STAGE(PG8_SB(0, 0), b2, voffB); PG8_STAGE(PG8_SB(0, 1), b2 + hstep, voffB); PG8_STAGE(PG8_SA(0, 0), a2, voffA);
            PG8_WAIT_V(8); PG8_WAIT_L(0); PG8_BAR; PG8_MMA(1, 0, At, B0); PG8_MMA(1, 1, At, B1); PG8_BAR; PG8_SCHED;
            PG8_LDB(B0, 1, 0); PG8_LDB(B1, 1, 1); PG8_SCHED; PG8_LDA(At, 1, 0); PG8_STAGE(PG8_SA(0, 1), a2 + hstep, voffA);
            PG8_WAIT_V(8); PG8_WAIT_L(0); PG8_BAR; PG8_MMA(0, 0, At, B0); PG8_MMA(0, 1, At, B1); PG8_BAR; PG8_SCHED;
            PG8_LDA(At, 1, 1); PG8_STAGE(PG8_SB(1, 0), b3, voffB); PG8_STAGE(PG8_SB(1, 1), b3 + hstep, voffB); PG8_STAGE(PG8_SA(1, 0), a3, voffA);
            PG8_WAIT_V(8); PG8_WAIT_L(0); PG8_BAR; PG8_MMA(1, 0, At, B0); PG8_MMA(1, 1, At, B1); PG8_BAR; PG8_SCHED;
            } else {
            PG8_LDB(B0, 0, 0); PG8_SCHED; PG8_LDA(At, 0, 0); PG8_STAGE(PG8_SA(1, 1), a1 + hstep, voffA);
            PG8_WAIT_L(8); PG8_BAR; PG8_WAIT_L(0); PG8_MMA(0, 0, At, B0); PG8_BAR; PG8_SCHED;
            PG8_LDB(B1, 0, 1); PG8_STAGE(PG8_SB(0, 0), b2, voffB);
            PG8_BAR; PG8_WAIT_L(0); PG8_MMA(0, 1, At, B1); PG8_BAR;
            PG8_LDA(At, 0, 1); PG8_STAGE(PG8_SA(0, 0), a2, voffA);
            PG8_BAR; PG8_WAIT_L(0); PG8_MMA(1, 0, At, B0); PG8_BAR; PG8_SCHED;
            PG8_STAGE(PG8_SB(0, 1), b2 + hstep, voffB);
            PG8_WAIT_V(6); PG8_BAR; PG8_MMA(1, 1, At, B1); PG8_BAR;
            PG8_LDB(B0, 1, 0); PG8_SCHED; PG8_LDA(At, 1, 0); PG8_STAGE(PG8_SA(0, 1), a2 + hstep, voffA);
            PG8_WAIT_L(8); PG8_BAR; PG8_WAIT_L(0); PG8_MMA(0, 0, At, B0); PG8_BAR; PG8_SCHED;
            PG8_LDB(B1, 1, 1); PG8_STAGE(PG8_SB(1, 0), b3, voffB);
            PG8_BAR; PG8_WAIT_L(0); PG8_MMA(0, 1, At, B1); PG8_BAR;
            PG8_LDA(At, 1, 1); PG8_STAGE(PG8_SA(1, 0), a3, voffA);
            PG8_BAR; PG8_WAIT_L(0); PG8_MMA(1, 0, At, B0); PG8_BAR; PG8_SCHED;
            PG8_STAGE(PG8_SB(1, 1), b3 + hstep, voffB);
            PG8_WAIT_V(6); PG8_BAR; PG8_MMA(1, 1, At, B1); PG8_BAR;
            }
        }
        if constexpr (ALIGN_EPI) { if (wr == 0) PG8_BAR; }
        if constexpr (!Epi::AFTER_DRAIN) { E(acc, cur, wr, wc, fr, fq); S.done(cur); }
        if (!has_next) break;
#pragma unroll
        for (int a = 0; a < 2; ++a)
#pragma unroll
            for (int b = 0; b < 2; ++b)
#pragma unroll
                for (int m = 0; m < 4; ++m)
#pragma unroll
                    for (int n = 0; n < 2; ++n) acc[a][b][m][n] = (f32x4){0.f, 0.f, 0.f, 0.f};
        cur = nxt; cA = nA; cB = nB; ++ui;
        if constexpr (ALIGN_EPI) { if (wr == 1) PG8_BAR; }
    }
    PG8_WAIT_V(0);
    if constexpr (!ALIGN_EPI) { if (wr == 0) PG8_BAR; }
    PG8_BAR;
    if constexpr (Epi::AFTER_DRAIN) { E.fused(acc, cur, wr, wc, fr, fq, lds, wid, lane); S.done(cur); }
#undef PG8_SA
#undef PG8_SB
#undef PG8_STAGE
#undef PG8_LDA
#undef PG8_LDB
#undef PG8_MMA
#undef PG8_WAIT_V
#undef PG8_WAIT_L
#undef PG8_BAR
#undef PG8_SCHED
}
}

#ifndef PG8_SP2
#define PG8_SP2 true
#endif
#ifndef PG8_ALIGN
#define PG8_ALIGN true
#endif
#include <hip/hip_bf16.h>
#include <cmath>
namespace dattn {
using bf16=__hip_bfloat16;
using bf16x8=__attribute__((ext_vector_type(8)))short;
using s16x4=__attribute__((ext_vector_type(4)))short;
using f32x16=__attribute__((ext_vector_type(16)))float;
using u32x4=__attribute__((ext_vector_type(4)))unsigned;
using u32x2=__attribute__((ext_vector_type(2)))unsigned;
constexpr int SEQ=8192,DM=3072,QB=256,NSLOT=4,KSLOT=8192,VSLOT=16384;
constexpr int LDS_K=0,LDS_V=NSLOT*KSLOT,LDS_END=LDS_V+NSLOT*VSLOT;
constexpr int OST_ROW=272,OST_WAVE=32*OST_ROW;
static_assert(8*OST_WAVE<=LDS_END,"O staging fits over the rings");
typedef __attribute__((address_space(3))) const char* lds_cptr;
typedef __attribute__((address_space(3))) char* lds_ptr;
typedef short v4i16_t __attribute__((ext_vector_type(4)));
__device__ __forceinline__ void glds16(const void*gsrc,unsigned lds_dst){unsigned keep;
  asm volatile("s_mov_b32 %0, m0\n\ts_mov_b32 m0, %2\n\ts_nop 0\n\tglobal_load_lds_dwordx4 %1, off\n\ts_mov_b32 m0, %0":"=&s"(keep):"v"(gsrc),"s"(lds_dst):"memory");}
__device__ __forceinline__ s16x4 vtr(lds_cptr p){ return __builtin_bit_cast(s16x4,__builtin_amdgcn_ds_read_tr16_b64_v4i16((__attribute__((address_space(3))) v4i16_t*)p)); }
typedef float f32x2_t __attribute__((ext_vector_type(2))); typedef __bf16 bf16x2_t __attribute__((ext_vector_type(2)));
__device__ __forceinline__ unsigned cvtpk_s(float lo,float hi){f32x2_t v={lo,hi};bf16x2_t b=__builtin_convertvector(v,bf16x2_t);return __builtin_bit_cast(unsigned,b);}
#define DWAIT_BAR(N) asm volatile("s_waitcnt vmcnt(" #N ") lgkmcnt(0)\n\ts_barrier":::"memory")
__device__ __forceinline__ void unit(int b,int qb,const bf16*Q,const bf16*__restrict__ K,const bf16*__restrict__ V,bf16*O,int opitch,char*shm){
  const int tid=threadIdx.x,lane=tid&63,r32=lane&31,hi=lane>>5; const int wid=__builtin_amdgcn_readfirstlane(tid>>6);
  const long rowbase=(long)b*SEQ; const int q0=qb*QB;
  const bf16*Qw=Q+(rowbase+q0+wid*32)*DM;
  const unsigned lds0=(unsigned)(uintptr_t)shm;
  const bf16*ksrc=K+rowbase*DM+(long)lane*DM+wid*8;
  const bf16*vsrc=V+rowbase*DM+(long)(16*(wid&3)+(lane>>2))*DM+(wid>>2)*32+(lane&3)*8;
  const unsigned kdst=lds0+LDS_K+wid*1024,vdst=lds0+LDS_V+wid*1024;
  #define DDMA(t,sl) do{ glds16(ksrc+(long)(t)*64*DM,(unsigned)__builtin_amdgcn_readfirstlane(kdst+(sl)*KSLOT)); \
      glds16(vsrc+(long)(t)*64*DM,(unsigned)__builtin_amdgcn_readfirstlane(vdst+(sl)*VSLOT)); \
      glds16(vsrc+(long)(t)*64*DM+64,(unsigned)__builtin_amdgcn_readfirstlane(vdst+(sl)*VSLOT+8192)); }while(0)
  #define SBARR() do{}while(0)
  #define DVRD(dst,vp_,cb_) do{ _Pragma("unroll") for(int c_=0;c_<4;++c_){ dst[2*c_]=vtr((vp_)+((cb_)>>1)*8192+((cb_)&1)*4096+c_*1024); dst[2*c_+1]=vtr((vp_)+((cb_)>>1)*8192+((cb_)&1)*4096+c_*1024+512); } }while(0)
  #define DVF(src,c_) (bf16x8){src[2*(c_)][0],src[2*(c_)][1],src[2*(c_)][2],src[2*(c_)][3],src[2*(c_)+1][0],src[2*(c_)+1][1],src[2*(c_)+1][2],src[2*(c_)+1][3]}
  #define DVRDC(dst,vp_,c_) do{ _Pragma("unroll") for(int b_=0;b_<4;++b_){ dst[2*b_]=vtr((vp_)+(b_>>1)*8192+(b_&1)*4096+(c_)*1024); dst[2*b_+1]=vtr((vp_)+(b_>>1)*8192+(b_&1)*4096+(c_)*1024+512); } }while(0)
  #define DPVC(src,c_) do{ _Pragma("unroll") for(int b_=0;b_<4;++b_) o[b_]=__builtin_amdgcn_mfma_f32_32x32x16_bf16(DVF(src,b_),pw[c_],o[b_],0,0,0); }while(0)
  #define DPV(src,cb_) do{ o[cb_]=__builtin_amdgcn_mfma_f32_32x32x16_bf16(DVF(src,0),pw[0],o[cb_],0,0,0); o[cb_]=__builtin_amdgcn_mfma_f32_32x32x16_bf16(DVF(src,1),pw[1],o[cb_],0,0,0); \
      o[cb_]=__builtin_amdgcn_mfma_f32_32x32x16_bf16(DVF(src,2),pw[2],o[cb_],0,0,0); o[cb_]=__builtin_amdgcn_mfma_f32_32x32x16_bf16(DVF(src,3),pw[3],o[cb_],0,0,0); }while(0)
  #define PV_PLAIN(vp_) do{ DPVC(va,0); DVRDC(va,vp_,2); DPVC(vb,1); DVRDC(vb,vp_,3); DPVC(va,2); DPVC(vb,3); }while(0)
  #define EXPS_PLAIN() do{ float ls0=0.f,ls1=0.f; \
      _Pragma("unroll") for(int r=0;r<16;++r){ p0[r]=__builtin_amdgcn_exp2f(p0[r]-mref); ls0+=p0[r]; p1[r]=__builtin_amdgcn_exp2f(p1[r]-mref); ls1+=p1[r]; } l+=ls0+ls1; \
      u32x4 w0,w1,w2,w3; w0.x=cvtpk_s(p0[0],p0[1]);w0.y=cvtpk_s(p0[2],p0[3]);w0.z=cvtpk_s(p0[4],p0[5]);w0.w=cvtpk_s(p0[6],p0[7]); \
      w1.x=cvtpk_s(p0[8],p0[9]);w1.y=cvtpk_s(p0[10],p0[11]);w1.z=cvtpk_s(p0[12],p0[13]);w1.w=cvtpk_s(p0[14],p0[15]); \
      w2.x=cvtpk_s(p1[0],p1[1]);w2.y=cvtpk_s(p1[2],p1[3]);w2.z=cvtpk_s(p1[4],p1[5]);w2.w=cvtpk_s(p1[6],p1[7]); \
      w3.x=cvtpk_s(p1[8],p1[9]);w3.y=cvtpk_s(p1[10],p1[11]);w3.z=cvtpk_s(p1[12],p1[13]);w3.w=cvtpk_s(p1[14],p1[15]); \
      pw[0]=__builtin_bit_cast(bf16x8,w0);pw[1]=__builtin_bit_cast(bf16x8,w1);pw[2]=__builtin_bit_cast(bf16x8,w2);pw[3]=__builtin_bit_cast(bf16x8,w3); }while(0)
  const int NT=(q0+QB)/64;
  DDMA(0,0); DDMA(1,1);
  bf16x8 qr[4];
  #pragma unroll
  for(int d0=0;d0<4;++d0)qr[d0]=*reinterpret_cast<const bf16x8*>(&Qw[(long)r32*DM+d0*16+hi*8]);
  asm volatile("":"+v"(qr[0]),"+v"(qr[1]),"+v"(qr[2]),"+v"(qr[3]));
  const lds_cptr shm3=(lds_cptr)shm;
  const lds_cptr kp0=shm3+LDS_K+hi*1024+r32*16;
  const lds_cptr vp0=shm3+LDS_V+((lane>>4)&1)*32+(lane&3)*8+(4*hi+((lane&15)>>2))*64;
  f32x16 o[4]; o[0]=f32x16{};o[1]=f32x16{};o[2]=f32x16{};o[3]=f32x16{};
  float mref=0.f,l=0.f;
  f32x16 negm=f32x16{};
  const int qfirst=q0+wid*32, qme=qfirst+r32;
  const int TI=(qfirst+1)>>6;
  int t=0;
  bf16x8 pw[4]; pw[0]=bf16x8{};pw[1]=bf16x8{};pw[2]=bf16x8{};pw[3]=bf16x8{};
  for(;t<TI;++t){
    const int slot=t&3;
    if(t+1<NT){DWAIT_BAR(3);}else{DWAIT_BAR(0);}
    const lds_cptr kp=kp0+slot*KSLOT; const lds_cptr vpp=vp0+((t?t-1:0)&3)*VSLOT;
    bf16x8 kf[8];
    #pragma unroll
    for(int d0=0;d0<4;++d0){ kf[2*d0]=*(const __attribute__((address_space(3))) bf16x8*)(kp+d0*2048); kf[2*d0+1]=*(const __attribute__((address_space(3))) bf16x8*)(kp+d0*2048+512); }
    s16x4 va[8],vb[8];
    f32x16 p0=__builtin_amdgcn_mfma_f32_32x32x16_bf16(kf[0],qr[0],negm,0,0,0),p1=__builtin_amdgcn_mfma_f32_32x32x16_bf16(kf[1],qr[0],negm,0,0,0);
    #pragma unroll
    for(int d0=1;d0<4;++d0){ p0=__builtin_amdgcn_mfma_f32_32x32x16_bf16(kf[2*d0],qr[d0],p0,0,0,0); p1=__builtin_amdgcn_mfma_f32_32x32x16_bf16(kf[2*d0+1],qr[d0],p1,0,0,0); }
    DVRDC(va,vpp,0);
    float mt=__builtin_fmaxf(__builtin_fmaxf(p0[0],p0[1]),__builtin_fmaxf(p1[0],p1[1]));
    #pragma unroll
    for(int r=2;r<16;r+=2){ mt=__builtin_fmaxf(mt,__builtin_fmaxf(p0[r],p0[r+1])); mt=__builtin_fmaxf(mt,__builtin_fmaxf(p1[r],p1[r+1])); }
    { auto rr=__builtin_amdgcn_permlane32_swap(__float_as_uint(mt),__float_as_uint(mt),false,false); mt=__builtin_fmaxf(__uint_as_float(rr[0]),__uint_as_float(rr[1])); }
    if(t==0||__any(mt>8.0f)){
      DVRDC(vb,vpp,1); PV_PLAIN(vpp);
      const float delta=t?__builtin_fmaxf(mt,0.f):mt; const float alpha=t?__builtin_amdgcn_exp2f(-delta):1.0f;
      #pragma unroll
      for(int cb=0;cb<4;++cb)o[cb]=o[cb]*alpha;
      l*=alpha; mref+=delta;
      #pragma unroll
      for(int r=0;r<16;++r){ p0[r]-=delta; p1[r]-=delta; negm[r]=-mref; }
      pw[0]=bf16x8{};pw[1]=bf16x8{};pw[2]=bf16x8{};pw[3]=bf16x8{};
      DVRDC(va,vpp,0);
    }
    {
      float ls0=0.f,ls1=0.f; u32x4 wq;
      DVRDC(vb,vpp,1);
      o[0]=__builtin_amdgcn_mfma_f32_32x32x16_bf16(DVF(va,0),pw[0],o[0],0,0,0);
      p0[0]=__builtin_amdgcn_exp2f(p0[0]); p0[1]=__builtin_amdgcn_exp2f(p0[1]); ls0+=p0[0]+p0[1];
      o[1]=__builtin_amdgcn_mfma_f32_32x32x16_bf16(DVF(va,1),pw[0],o[1],0,0,0);
      p0[2]=__builtin_amdgcn_exp2f(p0[2]); p0[3]=__builtin_amdgcn_exp2f(p0[3]); ls0+=p0[2]+p0[3];
      o[2]=__builtin_amdgcn_mfma_f32_32x32x16_bf16(DVF(va,2),pw[0],o[2],0,0,0);
      p0[4]=__builtin_amdgcn_exp2f(p0[4]); p0[5]=__builtin_amdgcn_exp2f(p0[5]); ls0+=p0[4]+p0[5];
      o[3]=__builtin_amdgcn_mfma_f32_32x32x16_bf16(DVF(va,3),pw[0],o[3],0,0,0);
      p0[6]=__builtin_amdgcn_exp2f(p0[6]); p0[7]=__builtin_amdgcn_exp2f(p0[7]); ls0+=p0[6]+p0[7];
      if(t+2<NT){ DDMA(t+2,(t+2)&3); }
      DVRDC(va,vpp,2);
      o[0]=__builtin_amdgcn_mfma_f32_32x32x16_bf16(DVF(vb,0),pw[1],o[0],0,0,0);
      p0[8]=__builtin_amdgcn_exp2f(p0[8]); p0[9]=__builtin_amdgcn_exp2f(p0[9]); ls0+=p0[8]+p0[9];
      wq.x=cvtpk_s(p0[0],p0[1]);
      o[1]=__builtin_amdgcn_mfma_f32_32x32x16_bf16(DVF(vb,1),pw[1],o[1],0,0,0);
      p0[10]=__builtin_amdgcn_exp2f(p0[10]); p0[11]=__builtin_amdgcn_exp2f(p0[11]); ls0+=p0[10]+p0[11];
      wq.y=cvtpk_s(p0[2],p0[3]);
      o[2]=__builtin_amdgcn_mfma_f32_32x32x16_bf16(DVF(vb,2),pw[1],o[2],0,0,0);
      p0[12]=__builtin_amdgcn_exp2f(p0[12]); p0[13]=__builtin_amdgcn_exp2f(p0[13]); ls0+=p0[12]+p0[13];
      wq.z=cvtpk_s(p0[4],p0[5]);
      o[3]=__builtin_amdgcn_mfma_f32_32x32x16_bf16(DVF(vb,3),pw[1],o[3],0,0,0);
      p0[14]=__builtin_amdgcn_exp2f(p0[14]); p0[15]=__builtin_amdgcn_exp2f(p0[15]); ls0+=p0[14]+p0[15];
      wq.w=cvtpk_s(p0[6],p0[7]);
      pw[0]=__builtin_bit_cast(bf16x8,wq);
      DVRDC(vb,vpp,3);
      o[0]=__builtin_amdgcn_mfma_f32_32x32x16_bf16(DVF(va,0),pw[2],o[0],0,0,0);
      p1[0]=__builtin_amdgcn_exp2f(p1[0]); p1[1]=__builtin_amdgcn_exp2f(p1[1]); ls1+=p1[0]+p1[1];
      wq.x=cvtpk_s(p0[8],p0[9]);
      o[1]=__builtin_amdgcn_mfma_f32_32x32x16_bf16(DVF(va,1),pw[2],o[1],0,0,0);
      p1[2]=__builtin_amdgcn_exp2f(p1[2]); p1[3]=__builtin_amdgcn_exp2f(p1[3]); ls1+=p1[2]+p1[3];
      wq.y=cvtpk_s(p0[10],p0[11]);
      o[2]=__builtin_amdgcn_mfma_f32_32x32x16_bf16(DVF(va,2),pw[2],o[2],0,0,0);
      p1[4]=__builtin_amdgcn_exp2f(p1[4]); p1[5]=__builtin_amdgcn_exp2f(p1[5]); ls1+=p1[4]+p1[5];
      wq.z=cvtpk_s(p0[12],p0[13]);
      o[3]=__builtin_amdgcn_mfma_f32_32x32x16_bf16(DVF(va,3),pw[2],o[3],0,0,0);
      p1[6]=__builtin_amdgcn_exp2f(p1[6]); p1[7]=__builtin_amdgcn_exp2f(p1[7]); ls1+=p1[6]+p1[7];
      wq.w=cvtpk_s(p0[14],p0[15]);
      pw[1]=__builtin_bit_cast(bf16x8,wq);
      o[0]=__builtin_amdgcn_mfma_f32_32x32x16_bf16(DVF(vb,0),pw[3],o[0],0,0,0);
      p1[8]=__builtin_amdgcn_exp2f(p1[8]); p1[9]=__builtin_amdgcn_exp2f(p1[9]); ls1+=p1[8]+p1[9];
      wq.x=cvtpk_s(p1[0],p1[1]);
      o[1]=__builtin_amdgcn_mfma_f32_32x32x16_bf16(DVF(vb,1),pw[3],o[1],0,0,0);
      p1[10]=__builtin_amdgcn_exp2f(p1[10]); p1[11]=__builtin_amdgcn_exp2f(p1[11]); ls1+=p1[10]+p1[11];
      wq.y=cvtpk_s(p1[2],p1[3]);
      o[2]=__builtin_amdgcn_mfma_f32_32x32x16_bf16(DVF(vb,2),pw[3],o[2],0,0,0);
      p1[12]=__builtin_amdgcn_exp2f(p1[12]); p1[13]=__builtin_amdgcn_exp2f(p1[13]); ls1+=p1[12]+p1[13];
      wq.z=cvtpk_s(p1[4],p1[5]);
      o[3]=__builtin_amdgcn_mfma_f32_32x32x16_bf16(DVF(vb,3),pw[3],o[3],0,0,0);
      p1[14]=__builtin_amdgcn_exp2f(p1[14]); p1[15]=__builtin_amdgcn_exp2f(p1[15]); ls1+=p1[14]+p1[15];
      wq.w=cvtpk_s(p1[6],p1[7]);
      pw[2]=__builtin_bit_cast(bf16x8,wq);
      wq.x=cvtpk_s(p1[8],p1[9]); wq.y=cvtpk_s(p1[10],p1[11]); wq.z=cvtpk_s(p1[12],p1[13]); wq.w=cvtpk_s(p1[14],p1[15]); pw[3]=__builtin_bit_cast(bf16x8,wq);
      l+=ls0+ls1;
    }
  }
  if(TI>0){ const lds_cptr vpp=vp0+((t+3)&3)*VSLOT; s16x4 va[8],vb[8]; DVRDC(va,vpp,0); DVRDC(vb,vpp,1); PV_PLAIN(vpp); }
  for(;t<NT;++t){
    const int slot=t&3;
    if(t+1<NT){DWAIT_BAR(3);}else{DWAIT_BAR(0);}
    if(t+2<NT){ DDMA(t+2,(t+2)&3); }
    const lds_cptr kp=kp0+slot*KSLOT; const lds_cptr vp=vp0+slot*VSLOT;
    #pragma unroll
    for(int s=0;s<2;++s){
      const int key0=64*t+32*s;
      if(key0>qfirst+31)continue;
      f32x16 p=f32x16{};
      #pragma unroll
      for(int d0=0;d0<4;++d0){ const bf16x8 kf=*(const __attribute__((address_space(3))) bf16x8*)(kp+d0*2048+s*512); p=__builtin_amdgcn_mfma_f32_32x32x16_bf16(kf,qr[d0],p,0,0,0); }
      if(key0+31>qfirst){
        #pragma unroll
        for(int r=0;r<16;++r){ const int kv=key0+(r&3)+8*(r>>2)+4*hi; if(kv>qme)p[r]=-INFINITY; } }
      float mt=__builtin_fmaxf(p[0],p[1]);
      #pragma unroll
      for(int r=2;r<16;++r)mt=__builtin_fmaxf(mt,p[r]);
      { auto rr=__builtin_amdgcn_permlane32_swap(__float_as_uint(mt),__float_as_uint(mt),false,false); mt=__builtin_fmaxf(__uint_as_float(rr[0]),__uint_as_float(rr[1])); }
      const bool first=(t==0&&s==0);
      if(first||__any(mt>mref+8.0f)){
        const float mnew=first?mt:__builtin_fmaxf(mref,mt); const float alpha=first?1.0f:__builtin_amdgcn_exp2f(mref-mnew);
        #pragma unroll
        for(int cb=0;cb<4;++cb)o[cb]=o[cb]*alpha;
        l*=alpha; mref=mnew; }
      float ls=0.f;
      #pragma unroll
      for(int r=0;r<16;++r){ p[r]=__builtin_amdgcn_exp2f(p[r]-mref); ls+=p[r]; }
      l+=ls;
      u32x4 w0,w1; w0.x=cvtpk_s(p[0],p[1]);w0.y=cvtpk_s(p[2],p[3]);w0.z=cvtpk_s(p[4],p[5]);w0.w=cvtpk_s(p[6],p[7]);
      w1.x=cvtpk_s(p[8],p[9]);w1.y=cvtpk_s(p[10],p[11]);w1.z=cvtpk_s(p[12],p[13]);w1.w=cvtpk_s(p[14],p[15]);
      const bf16x8 pb0=__builtin_bit_cast(bf16x8,w0),pb1=__builtin_bit_cast(bf16x8,w1);
      #pragma unroll
      for(int cb=0;cb<4;++cb){
        const int off=(cb>>1)*8192+(cb&1)*4096+(2*s)*1024;
        const s16x4 a0=vtr(vp+off),a1=vtr(vp+off+512),c0=vtr(vp+off+1024),c1=vtr(vp+off+1536);
        const bf16x8 v0=(bf16x8){a0[0],a0[1],a0[2],a0[3],a1[0],a1[1],a1[2],a1[3]},v1=(bf16x8){c0[0],c0[1],c0[2],c0[3],c1[0],c1[1],c1[2],c1[3]};
        o[cb]=__builtin_amdgcn_mfma_f32_32x32x16_bf16(v0,pb0,o[cb],0,0,0);
        o[cb]=__builtin_amdgcn_mfma_f32_32x32x16_bf16(v1,pb1,o[cb],0,0,0); }
    }

  }
  { auto rr=__builtin_amdgcn_permlane32_swap(__float_as_uint(l),__float_as_uint(l),false,false); l=__uint_as_float(rr[0])+__uint_as_float(rr[1]); }
  const float inv=__builtin_amdgcn_rcpf(l);
  DWAIT_BAR(0);
  const lds_ptr stg=(lds_ptr)shm+wid*OST_WAVE;
  #pragma unroll
  for(int cb=0;cb<4;++cb)
    #pragma unroll
    for(int g=0;g<4;++g){ u32x2 w; w.x=cvtpk_s(o[cb][4*g]*inv,o[cb][4*g+1]*inv); w.y=cvtpk_s(o[cb][4*g+2]*inv,o[cb][4*g+3]*inv);
      *(__attribute__((address_space(3))) u32x2*)(stg+r32*OST_ROW+(32*cb+8*g+4*hi)*2)=w; }
  asm volatile("s_waitcnt lgkmcnt(0)":::"memory");
  bf16*Ow=O+(rowbase+q0+wid*32)*(long)opitch;
  #pragma unroll
  for(int i=0;i<8;++i){ const int row=i*4+(lane>>4),ch=lane&15; const u32x4 v=*(const __attribute__((address_space(3))) u32x4*)(stg+row*OST_ROW+ch*16); *(u32x4*)(Ow+(long)row*opitch+ch*8)=v; }
  asm volatile("s_waitcnt lgkmcnt(0)\n\ts_barrier":::"memory");
  #undef DDMA
  #undef SBARR
  #undef DVRD
  #undef DVF
  #undef DPV
  #undef PV_PLAIN
  #undef DVRDC
  #undef DPVC
  #undef EXPS_PLAIN
}
struct DiffUnit { int bh; int qb; int m; };
struct DiffOrder {
  int vcu, G;
  __device__ __forceinline__ DiffOrder(int vcu_,int G_):vcu(vcu_),G(G_){}
  __device__ __forceinline__ bool next(int i,DiffUnit&u)const{
    const int ii=i>>1; u.m=i&1;
    if(G==256){ if(i>=4)return false; const int s=vcu&15; u.bh=vcu>>4; u.qb=ii?31-s:s; return true; }
    const int un=vcu+ii*G; if(un>=512)return false; u.bh=un>>5; u.qb=un&31; return true; }
};
__device__ __forceinline__ void diff_phase(char*shm,const unsigned short*PROJ,unsigned short*OA,const DiffOrder&S){
  DiffUnit u;
  for(int i=0;S.next(i,u);++i){
    const int h=u.bh&7;
    const bf16*Qp=(const bf16*)PROJ+h*128+u.m*64;
    unit(u.bh>>3,u.qb,Qp,Qp+1024,(const bf16*)PROJ+2048+h*128,u.m?((bf16*)PROJ+h*128):((bf16*)OA+h*128),u.m?DM:1024,shm);
  }
}
__device__ __forceinline__ float bflo(unsigned w){return __builtin_bit_cast(float,w<<16);}
__device__ __forceinline__ float bfhi(unsigned w){return __builtin_bit_cast(float,w&0xffff0000u);}
__device__ __forceinline__ void diff_combine(const unsigned short*PROJ,unsigned short*OA,const DiffOrder&S,float lam){
  asm volatile("s_waitcnt vmcnt(0)":::"memory");
  int tid_=threadIdx.x; asm volatile("":"+v"(tid_));
  const int lane=tid_&63; const int wid=__builtin_amdgcn_readfirstlane(tid_>>6); const int c8=(lane&7)*8;
  DiffUnit u;
  for(int i=0;S.next(i,u);i+=2){
    const int h=u.bh&7; const long row0=(long)(u.bh>>3)*SEQ+u.qb*QB+wid*32+(lane>>3);
    #pragma unroll 1
    for(int it=0;it<4;++it){
      unsigned short*ma=OA+(row0+it*8)*1024+h*128+c8; const unsigned short*pb=PROJ+(row0+it*8)*DM+h*128+c8;
      const u32x4 a0=*(const u32x4*)ma,a1=*(const u32x4*)(ma+64),b0=*(const u32x4*)pb,b1=*(const u32x4*)(pb+64);
      float o0[8],o1[8]; float ss=0.f;
      #pragma unroll
      for(int k=0;k<4;++k){ o0[2*k]=bflo(a0[k])-lam*bflo(b0[k]); o0[2*k+1]=bfhi(a0[k])-lam*bfhi(b0[k]); o1[2*k]=bflo(a1[k])-lam*bflo(b1[k]); o1[2*k+1]=bfhi(a1[k])-lam*bfhi(b1[k]); }
      #pragma unroll
      for(int k=0;k<8;++k)ss+=o0[k]*o0[k]+o1[k]*o1[k];
      ss+=__shfl_xor(ss,1); ss+=__shfl_xor(ss,2); ss+=__shfl_xor(ss,4);
      const float rs=__builtin_amdgcn_rsqf(ss*(1.0f/128.0f)+1e-6f);
      u32x4 w0,w1;
      #pragma unroll
      for(int k=0;k<4;++k){ w0[k]=cvtpk_s(o0[2*k]*rs,o0[2*k+1]*rs); w1[k]=cvtpk_s(o1[2*k]*rs,o1[2*k+1]*rs); }
      *(u32x4*)ma=w0; *(u32x4*)(ma+64)=w1;
    }
  }
}
#undef DWAIT_BAR
}
#include <hip/hip_cooperative_groups.h>
namespace cg = cooperative_groups;
constexpr int NWAVES = 8;
constexpr int SEQ = 8192, DMOD = 1024, MTOK = 2 * SEQ, FF = 4096;
constexpr int P0W = 2560;
constexpr int P1W = 3072;
constexpr float QSCALE = 0.125f * 1.4426950408889634f;
constexpr float LAMBDA_INIT1 = 0.35550906f;
constexpr size_t MiB = 1u << 20;
constexpr size_t WS_CTL = 0, CTL_ZERO_BYTES = 1 * MiB;
constexpr size_t WS_SSQ = 65536;
constexpr size_t WS_W = 2 * MiB;
constexpr size_t W_IN = 0, W_OUT = 6 * MiB, W_UP = 8 * MiB, W_DOWN = 16 * MiB, W_LAYER = 24 * MiB;
constexpr size_t WS_XB = 50 * MiB;
constexpr size_t WS_PROJ = 82 * MiB;
constexpr size_t WS_VT = WS_PROJ + 80 * MiB;
constexpr size_t WS_MIX = 178 * MiB;
constexpr size_t WS_H = WS_PROJ;
constexpr size_t WS_END = 210 * MiB;
constexpr int RING_BYTES = 131072, LDS_BYTES = 147456;

#define GAS __attribute__((address_space(1)))
#define LAS __attribute__((address_space(3)))
typedef unsigned short bf16;
typedef unsigned v4u __attribute__((ext_vector_type(4)));
typedef float f32x4 __attribute__((ext_vector_type(4)));
typedef short bf16x8 __attribute__((ext_vector_type(8)));
typedef float f32x16 __attribute__((ext_vector_type(16)));
#define LDS_WAIT() asm volatile("s_waitcnt lgkmcnt(0)" ::: "memory")
__device__ __forceinline__ unsigned f2bf(float f) { unsigned u = __builtin_bit_cast(unsigned, f); return (u + 0x7fffu + ((u >> 16) & 1u)) >> 16; }
__device__ __forceinline__ unsigned pk2(float lo, float hi) { return f2bf(lo) | (f2bf(hi) << 16); }
__device__ __forceinline__ float bf_lo(unsigned w) { return __builtin_bit_cast(float, w << 16); }
__device__ __forceinline__ float bf_hi(unsigned w) { return __builtin_bit_cast(float, w & 0xffff0000u); }
__device__ __forceinline__ float wave_sum(float v) {
#pragma unroll
    for (int o = 1; o < 64; o <<= 1) v += __shfl_xor(v, o);
    return v;
}
__device__ __forceinline__ void x_rows2_to_bf16(const float* xrow, bf16* orow, float* ssq, int lane) {
    const GAS f32x4* xr = (const GAS f32x4*)xrow + lane;
    f32x4 v[8]; float s0 = 0.f, s1 = 0.f;
#pragma unroll
    for (int j = 0; j < 8; ++j) v[j] = __builtin_nontemporal_load(xr + 64 * j);
#pragma unroll
    for (int j = 0; j < 4; ++j) { s0 += (v[j].x * v[j].x + v[j].y * v[j].y) + (v[j].z * v[j].z + v[j].w * v[j].w); s1 += (v[4 + j].x * v[4 + j].x + v[4 + j].y * v[4 + j].y) + (v[4 + j].z * v[4 + j].z + v[4 + j].w * v[4 + j].w); }
    s0 = wave_sum(s0); s1 = wave_sum(s1); if (lane == 0) { ssq[0] = s0; ssq[1] = s1; }
    GAS unsigned long long* o8 = (GAS unsigned long long*)orow + lane;
#pragma unroll
    for (int j = 0; j < 8; ++j) o8[64 * j] = (unsigned long long)pk2(v[j].x, v[j].y) | ((unsigned long long)pk2(v[j].z, v[j].w) << 32);
}

__device__ __forceinline__ int swap23(int i) { return (i & ~12) | ((i & 4) << 1) | ((i & 8) >> 1); }
__device__ __forceinline__ unsigned cvtpk2(float lo, float hi) { typedef float f2 __attribute__((ext_vector_type(2))); typedef __bf16 b2 __attribute__((ext_vector_type(2))); f2 v = {lo, hi}; b2 b = __builtin_convertvector(v, b2); return __builtin_bit_cast(unsigned, b); }
__device__ __forceinline__ void sb_unit(int b, int h, int qb, const bf16* __restrict__ proj, const bf16* __restrict__ Vt, bf16* __restrict__ mix, LAS unsigned char* stage, int lane) {
    const int r32 = lane & 31, hi = lane >> 5;
    const size_t rowbase = (size_t)b * SEQ; const int t0 = qb * 32;
    const bf16* qp = proj + (rowbase + t0 + r32) * P0W + h * 64 + hi * 8;
    bf16x8 qr[4];
#pragma unroll
    for (int d0 = 0; d0 < 4; ++d0) qr[d0] = *(const bf16x8*)(qp + d0 * 16);
    const bf16* kbase = proj + (rowbase + swap23(r32)) * P0W + 512 + h * 64 + hi * 8;
    const bf16* vbase = Vt + (size_t)(h * 64 + r32) * MTOK + rowbase + hi * 8;
    f32x16 o0 = {}, o1 = {};
    float R = 0.f;
#define SB_LOAD(KF, VF, kt_) do { const bf16* kp = kbase + (size_t)(kt_) * 32 * P0W; const bf16* vp = vbase + (kt_) * 32; \
        _Pragma("unroll") for (int d0 = 0; d0 < 4; ++d0) KF[d0] = *(const bf16x8*)(kp + d0 * 16); \
        VF[0] = *(const bf16x8*)(vp); VF[1] = *(const bf16x8*)(vp + 16); VF[2] = *(const bf16x8*)(vp + (size_t)32 * MTOK); VF[3] = *(const bf16x8*)(vp + (size_t)32 * MTOK + 16); } while (0)
#define SB_COMPUTE(KF, VF, kt_) do { \
        f32x16 p = {}; \
        _Pragma("unroll") for (int d0 = 0; d0 < 4; ++d0) p = __builtin_amdgcn_mfma_f32_32x32x16_bf16(KF[d0], qr[d0], p, 0, 0, 0); \
        const bool diag = ((kt_) == qb); \
        float sp[16], lb[16]; \
        _Pragma("unroll") for (int r = 0; r < 16; ++r) { const float z = p[r]; const float e = __builtin_amdgcn_exp2f(-__builtin_fabsf(z)); const float l = __builtin_amdgcn_logf(1.0f + e); \
            sp[r] = __builtin_fmaxf(z, 0.f) + l; lb[r] = __builtin_fminf(z, 0.f) - l; \
            if (diag) { const int koff = (r & 7) + 8 * hi + 16 * (r >> 3); if (koff >= r32) { sp[r] = 0.f; lb[r] = -INFINITY; } } } \
        float ex[16], G0, G1; \
        { float run = 0.f; \
          _Pragma("unroll") for (int j = 7; j >= 0; --j) { ex[j] = run; run += sp[j]; } G0 = run; run = 0.f; \
          _Pragma("unroll") for (int j = 7; j >= 0; --j) { ex[8 + j] = run; run += sp[8 + j]; } G1 = run; } \
        const float Gp0 = __shfl_xor(G0, 32), Gp1 = __shfl_xor(G1, 32); \
        const float base1 = R + (hi ? 0.f : Gp1), base0 = R + G1 + Gp1 + (hi ? 0.f : Gp0); \
        float w[16]; \
        _Pragma("unroll") for (int r = 0; r < 16; ++r) w[r] = __builtin_amdgcn_exp2f(lb[r] - ((r < 8) ? base0 : base1) - ex[r]); \
        R += (G0 + G1) + (Gp0 + Gp1); \
        v4u a0, a1; a0.x = cvtpk2(w[0], w[1]); a0.y = cvtpk2(w[2], w[3]); a0.z = cvtpk2(w[4], w[5]); a0.w = cvtpk2(w[6], w[7]); \
        a1.x = cvtpk2(w[8], w[9]); a1.y = cvtpk2(w[10], w[11]); a1.z = cvtpk2(w[12], w[13]); a1.w = cvtpk2(w[14], w[15]); \
        const bf16x8 pa0 = __builtin_bit_cast(bf16x8, a0), pa1 = __builtin_bit_cast(bf16x8, a1); \
        o0 = __builtin_amdgcn_mfma_f32_32x32x16_bf16(pa0, VF[0], o0, 0, 0, 0); o0 = __builtin_amdgcn_mfma_f32_32x32x16_bf16(pa1, VF[1], o0, 0, 0, 0); \
        o1 = __builtin_amdgcn_mfma_f32_32x32x16_bf16(pa0, VF[2], o1, 0, 0, 0); o1 = __builtin_amdgcn_mfma_f32_32x32x16_bf16(pa1, VF[3], o1, 0, 0, 0); \
        done = __all(R > 151.0f) != 0; } while (0)
    bf16x8 kA[4], vA[4], kB[4], vB[4];
    SB_LOAD(kA, vA, qb);
#pragma unroll
    for (int d0 = 0; d0 < 4; ++d0) { kB[d0] = kA[d0]; vB[d0] = vA[d0]; }
    if (qb > 0) SB_LOAD(kB, vB, qb - 1);
    bool done = false;
    for (int kt = qb;; kt -= 2) {
        SB_COMPUTE(kA, vA, kt);
        if (done || kt < 1) break;
        if (kt >= 2) SB_LOAD(kA, vA, kt - 2);
        SB_COMPUTE(kB, vB, kt - 1);
        if (done || kt < 2) break;
        if (kt >= 3) SB_LOAD(kB, vB, kt - 3);
    }
#undef SB_LOAD
#undef SB_COMPUTE
    LAS bf16* stg = (LAS bf16*)stage;
#pragma unroll
    for (int r = 0; r < 16; ++r) { const int orow = (r & 3) + 8 * (r >> 2) + 4 * hi; stg[orow * 64 + r32] = (bf16)f2bf(o0[r]); stg[orow * 64 + 32 + r32] = (bf16)f2bf(o1[r]); }
    LDS_WAIT(); asm volatile("" ::: "memory");
    bf16* op = mix + (rowbase + t0) * 1024 + h * 64;
#pragma unroll
    for (int i = 0; i < 4; ++i) { const int row = i * 8 + (lane >> 3), ch = lane & 7; const v4u v = *(const LAS v4u*)(stg + row * 64 + ch * 8); *(v4u*)(op + (size_t)row * 1024 + ch * 8) = v; }
    LDS_WAIT(); asm volatile("" ::: "memory");
}
__device__ __forceinline__ void conv_items(const bf16* __restrict__ proj, const float* __restrict__ cw, bf16* __restrict__ mix, int gtid, int nthreads) {
    for (int it = gtid; it < (MTOK / 8) * 64; it += nthreads) {
        const int rb = it >> 6, ch = (it & 63) * 8, m0 = rb * 8;
        float w0[8], w1[8], w2[8], c2[8], c1[8];
#pragma unroll
        for (int i = 0; i < 8; ++i) { w0[i] = cw[ch + i]; w1[i] = cw[512 + ch + i]; w2[i] = cw[1024 + ch + i]; c2[i] = 0.f; c1[i] = 0.f; }
        if ((m0 & (SEQ - 1)) != 0) {
            const v4u Ca = *(const v4u*)(proj + (size_t)(m0 - 2) * P0W + 1536 + ch), Ua = *(const v4u*)(proj + (size_t)(m0 - 2) * P0W + 2048 + ch);
            const v4u Cb = *(const v4u*)(proj + (size_t)(m0 - 1) * P0W + 1536 + ch), Ub = *(const v4u*)(proj + (size_t)(m0 - 1) * P0W + 2048 + ch);
#pragma unroll
            for (int i = 0; i < 4; ++i) { c2[2 * i] = bf_lo(Ca[i]) * bf_lo(Ua[i]); c2[2 * i + 1] = bf_hi(Ca[i]) * bf_hi(Ua[i]); c1[2 * i] = bf_lo(Cb[i]) * bf_lo(Ub[i]); c1[2 * i + 1] = bf_hi(Cb[i]) * bf_hi(Ub[i]); }
        }
#pragma unroll
        for (int r = 0; r < 8; ++r) { const bf16* rp = proj + (size_t)(m0 + r) * P0W + ch;
            const v4u Bv = __builtin_nontemporal_load((const v4u*)(rp + 1024)), Cv = __builtin_nontemporal_load((const v4u*)(rp + 1536)), Uv = __builtin_nontemporal_load((const v4u*)(rp + 2048));
            float c0[8], y[8];
#pragma unroll
            for (int i = 0; i < 4; ++i) { c0[2 * i] = bf_lo(Cv[i]) * bf_lo(Uv[i]); c0[2 * i + 1] = bf_hi(Cv[i]) * bf_hi(Uv[i]); }
#pragma unroll
            for (int i = 0; i < 8; ++i) y[i] = w0[i] * c2[i] + w1[i] * c1[i] + w2[i] * c0[i];
            v4u o;
#pragma unroll
            for (int i = 0; i < 4; ++i) o[i] = pk2(bf_lo(Bv[i]) * y[2 * i], bf_hi(Bv[i]) * y[2 * i + 1]);
            *(v4u*)(mix + (size_t)(m0 + r) * 1024 + 512 + ch) = o;
#pragma unroll
            for (int i = 0; i < 8; ++i) { c2[i] = c1[i]; c1[i] = c0[i]; } }
    }
}

typedef GAS unsigned gu32;
#define RLX_AGENT __ATOMIC_RELAXED, __HIP_MEMORY_SCOPE_AGENT
constexpr int CW_PANEL = 8192;
constexpr int CW_BAR = 4096;
constexpr int LDSCTL_OFF = RING_BYTES, MISC_OFF = LDSCTL_OFF + 320;
#define XB_TMO      128
#define XB_XCNT(j)  (256  + 64 * (j))
#define XB_XSUB(j)  (1280 + 64 * (j))
#define XB_XGEN(j)  (2304 + 64 * (j))
#define XB_TOP      3328
#define XB_TOPGEN   3392
#define XCD_BAR_WORDS 3456
#define XB_SPIN_CAP (1u << 18)

__device__ __forceinline__ unsigned xb_ld(unsigned* p)              { return __hip_atomic_load(p, __ATOMIC_RELAXED, __HIP_MEMORY_SCOPE_AGENT); }
__device__ __forceinline__ unsigned xb_add(unsigned* p, unsigned v) { return __hip_atomic_fetch_add(p, v, __ATOMIC_RELAXED, __HIP_MEMORY_SCOPE_AGENT); }
__device__ __forceinline__ unsigned xb_xcc_id() { return (unsigned)__builtin_amdgcn_s_getreg((3 << 11) | 20) & 0xFu; }
#define XB_SPIN(cond, bar) do { unsigned _sp = 0; while (cond) { __builtin_amdgcn_s_sleep(1); \
    if ((++_sp & 255u) == 0u) { if (xb_ld(&(bar)[XB_TMO])) break; if (_sp > XB_SPIN_CAP) { atomicAdd(&(bar)[XB_TMO], 1u); break; } } } } while (0)

struct XcdBarrier {
    unsigned* bar; unsigned x;
    volatile LAS unsigned* st;
};

__device__ __forceinline__ XcdBarrier xcd_barrier_post(unsigned* bar, volatile LAS unsigned* st) {
    XcdBarrier b; b.bar = bar; b.x = xb_xcc_id(); b.st = st;
    if (threadIdx.x == 0) (void)xb_add(&bar[XB_XCNT(b.x)], 1u);
    return b;
}
__device__ __forceinline__ void xcd_barrier_complete(unsigned* bar, unsigned x, unsigned& nloc, unsigned& nx) {
    const unsigned G = gridDim.x * gridDim.y * gridDim.z;
    unsigned sum, cnt, mine, sp = 0u;
    for (;;) {
        sum = 0u; cnt = 0u; mine = 0u;
#pragma unroll
        for (unsigned j = 0; j < 16; ++j) { const unsigned c = xb_ld(&bar[XB_XCNT(j)]); sum += c; cnt += (c > 0u) ? 1u : 0u; mine = (j == x) ? c : mine; }
        if (sum == G) break;
        __builtin_amdgcn_s_sleep(1);
        if ((++sp & 255u) == 0u) { if (xb_ld(&bar[XB_TMO])) break; if (sp > XB_SPIN_CAP) { atomicAdd(&bar[XB_TMO], 1u); break; } }
    }
    nloc = mine > 0u ? mine : 1u; nx = cnt > 0u ? cnt : 1u;
}

__device__ __forceinline__ void xcd_barrier_thread0(const XcdBarrier& b) {
    {
        unsigned* bar = b.bar;
        __builtin_amdgcn_s_waitcnt(0);
        unsigned nloc = b.st[0], nx = b.st[1];
        if (nloc == 0u) { xcd_barrier_complete(bar, b.x, nloc, nx); b.st[0] = nloc; b.st[1] = nx; }
        const unsigned old = xb_add(&bar[XB_XSUB(b.x)], 1u);
        const unsigned gen = old / nloc;
        if (old + 1u == (gen + 1u) * nloc) {
            __builtin_amdgcn_fence(__ATOMIC_RELEASE, "agent");
            asm volatile("s_waitcnt vmcnt(0)" ::: "memory");
            const unsigned og = xb_add(&bar[XB_TOP], 1u);
            const unsigned tg = og / nx;
            if (og + 1u == (tg + 1u) * nx) xb_add(&bar[XB_TOPGEN], 1u);
            else XB_SPIN(xb_ld(&bar[XB_TOPGEN]) == tg, bar);
            __builtin_amdgcn_fence(__ATOMIC_ACQUIRE, "agent");
            xb_add(&bar[XB_XGEN(b.x)], 1u);
            asm volatile("s_waitcnt vmcnt(0)" ::: "memory");
        } else {
            XB_SPIN(xb_ld(&bar[XB_XGEN(b.x)]) == gen, bar);
            __builtin_amdgcn_fence(__ATOMIC_ACQUIRE, "agent");
            asm volatile("s_waitcnt vmcnt(0)" ::: "memory");
        }
    }
}
__device__ __forceinline__ void xcd_barrier(const XcdBarrier& b) {
    asm volatile("s_waitcnt vmcnt(0)" ::: "memory");
    __syncthreads();
    if (threadIdx.x == 0) xcd_barrier_thread0(b);
    __syncthreads();
}
#define LAYER_TAIL(layer) \
        { PHASE_IDS pg8::Gemm g{MIXp, WLp(layer, W_OUT), MTOK, 1024, 1024}; pg8::StaticOrder S; S.init(MTOK, 1024, G, bx); \
          pg8::EpiRes E{layer ? (const float*)XRES : XIN, XRES, XBp, SSQ(2 * layer + 1)}; \
          pg8::gemm_phase<pg8::EpiRes, pg8::StaticOrder, PG8_ALIGN, PG8_SP2>(ldsp, g, S, E); } \
        if (layer == 0) xcd_barrier_work(bar, args, WSLICE(3), ldsp); else xcd_barrier(bar); \
        { PHASE_IDS pg8::Gemm g{XBp, WLp(layer, W_UP), MTOK, FF, 1024}; pg8::StaticOrder S; S.init(MTOK, FF, G, bx); \
          pg8::EpiRow<1> E{HBp, FF, SSQ(2 * layer + 1), 0, 1.f}; \
          pg8::gemm_phase<pg8::EpiRow<1>, pg8::StaticOrder, PG8_ALIGN, PG8_SP2>(ldsp, g, S, E); } \
        if (layer == 0) xcd_barrier_work(bar, args, WSLICE(4), ldsp); else xcd_barrier(bar); \
        if (layer == 1 && gridDim.x == 256) {     \
          PHASE_IDS pg8::Gemm g{HBp, WLp(layer, W_DOWN), MTOK, 1024, FF}; pg8::StaticOrder S; S.init(MTOK, 1024, G, bx); \
          pg8::EpiResFinal E{XRES, XRES, SSQ(4), (unsigned*)(args.ws + WS_CTL) + CW_PANEL, args.in[3]}; \
          pg8::gemm_phase<pg8::EpiResFinal, pg8::StaticOrder, false, PG8_SP2>(ldsp, g, S, E); \
        } else { \
        { PHASE_IDS pg8::Gemm g{HBp, WLp(layer, W_DOWN), MTOK, 1024, FF}; pg8::StaticOrder S; S.init(MTOK, 1024, G, bx); \
          pg8::EpiRes E{XRES, XRES, XBp, SSQ(2 * layer + 2)}; \
          pg8::gemm_phase<pg8::EpiRes, pg8::StaticOrder, PG8_ALIGN, PG8_SP2>(ldsp, g, S, E); } \
        if (layer == 0) xcd_barrier_work(bar, args, WSLICE(5), ldsp); else xcd_barrier(bar); }
constexpr int I_IN = 16 * 96, I_OUT = 16 * 32, I_UP = 16 * 128, I_DN = 64 * 32, I_L = I_IN + I_OUT + I_UP + I_DN;
struct Args { const float* in[16]; float* out; unsigned char* ws; };
struct CvtItem { const float* wp; bf16* op; int N, K; f32x4 g0, g1; };
__device__ __forceinline__ void cvt_decode(const Args& args, int it, int lane, CvtItem& d) {
    const int l = it / I_L; int r = it % I_L;
    const float* W; bf16* WT; int K = 1024, N; const float* gs = nullptr; int gmask = 1023; float gmul = 1.f; bool remap = false;
    if (r < I_IN) { W = l ? args.in[7] : args.in[4]; N = 3072; WT = (bf16*)(args.ws + WS_W + (size_t)l * W_LAYER + W_IN); gs = args.in[1] + l * 1024; remap = (l == 0); }
    else if ((r -= I_IN) < I_OUT) { W = l ? args.in[13] : args.in[6]; N = 1024; WT = (bf16*)(args.ws + WS_W + (size_t)l * W_LAYER + W_OUT); gs = l ? args.in[12] : nullptr; gmask = 127; gmul = 1.0f - LAMBDA_INIT1; }
    else if ((r -= I_OUT) < I_UP) { W = args.in[14] + (size_t)l * 1024 * 4096; N = 4096; WT = (bf16*)(args.ws + WS_W + (size_t)l * W_LAYER + W_UP); gs = args.in[2] + l * 1024; }
    else { r -= I_UP; W = args.in[15] + (size_t)l * 4096 * 1024; K = 4096; N = 1024; WT = (bf16*)(args.ws + WS_W + (size_t)l * W_LAYER + W_DOWN); }
    const int nblk = N / 32, kb = r / nblk, nb = r % nblk, k0 = 64 * kb, n0 = 32 * nb, c = lane & 7;
    int r0 = n0; if (remap) r0 = n0 < 1024 ? n0 : (n0 < 1536 ? n0 + 1536 : n0 - 512);
    d.N = N; d.K = K; d.wp = W + (size_t)(k0 + (lane >> 3)) * N + n0 + 4 * c; d.op = WT + (size_t)(r0 + (lane >> 3)) * K + k0 + 8 * c;
    d.g0 = (f32x4){1.f, 1.f, 1.f, 1.f}; d.g1 = d.g0;
    if (gs) { const float* gp = gs + ((k0 + 8 * c) & gmask); d.g0 = *(const f32x4*)gp * gmul; d.g1 = *(const f32x4*)(gp + 4) * gmul; }
}
__device__ __forceinline__ void cvt_load(const CvtItem& d, f32x4 (&v)[8]) {
#pragma unroll
    for (int i = 0; i < 8; ++i) v[i] = __builtin_nontemporal_load((const f32x4*)(d.wp + (size_t)(8 * i) * d.N));
}
__device__ __forceinline__ void cvt_lds_write(const f32x4 (&v)[8], LAS float* scr, int lane) {
    const int c = lane & 7;
#pragma unroll
    for (int i = 0; i < 8; ++i) { LAS float* p = scr + (8 * i + (lane >> 3)) * 33 + 4 * c; p[0] = v[i][0]; p[1] = v[i][1]; p[2] = v[i][2]; p[3] = v[i][3]; }
    LDS_WAIT(); asm volatile("" ::: "memory");
}
__device__ __forceinline__ void cvt_lds_read_store(const CvtItem& d, LAS float* scr, int lane) {
    const int c = lane & 7;
#pragma unroll
    for (int j = 0; j < 4; ++j) { const LAS float* s = scr + (8 * c) * 33 + (lane >> 3) + 8 * j;
        v4u o; o.x = pk2(s[0 * 33] * d.g0[0], s[1 * 33] * d.g0[1]); o.y = pk2(s[2 * 33] * d.g0[2], s[3 * 33] * d.g0[3]); o.z = pk2(s[4 * 33] * d.g1[0], s[5 * 33] * d.g1[1]); o.w = pk2(s[6 * 33] * d.g1[2], s[7 * 33] * d.g1[3]);
        *(GAS v4u*)(d.op + (size_t)(8 * j) * d.K) = o; }
    LDS_WAIT(); asm volatile("" ::: "memory");
}
__device__ __forceinline__ void convert_items(const Args& args, int lo, int hi, int gw, int NGW, int lane, LAS float* scr) {
    int it = lo + gw; if (it >= hi) return;
    CvtItem A, B, C; f32x4 va[8], vb[8];
    cvt_decode(args, it, lane, A); cvt_load(A, va);
    bool hb = (it + NGW) < hi; B = A;
#pragma unroll
    for (int i = 0; i < 8; ++i) vb[i] = va[i];
    if (hb) { cvt_decode(args, it + NGW, lane, B); cvt_load(B, vb); }
    for (;;) {
        cvt_lds_write(va, scr, lane);
        const bool hc = (it + 2 * NGW) < hi; C = A;
        if (hc) { cvt_decode(args, it + 2 * NGW, lane, C); cvt_load(C, va); }
        cvt_lds_read_store(A, scr, lane);
        if (!hb) break;
        cvt_lds_write(vb, scr, lane);
        const bool hd = (it + 3 * NGW) < hi; A = B;
        CvtItem D = B;
        if (hd) { cvt_decode(args, it + 3 * NGW, lane, D); cvt_load(D, vb); }
        cvt_lds_read_store(A, scr, lane);
        if (!hc) break;
        A = C; B = D; hb = hd; it += 2 * NGW;
    }
}
#define CONVERT_ITEMS(lo, hi) convert_items(args, (lo), (hi), gw, NGW, lane, scr);
__device__ __forceinline__ void xcd_barrier_work(const XcdBarrier& b, const Args& args, int lo, int hi, LAS unsigned char* ldsp) {
    asm volatile("s_waitcnt vmcnt(0)" ::: "memory");
    __syncthreads();
    int tid = threadIdx.x; asm volatile("" : "+v"(tid));
    const int wave = __builtin_amdgcn_readfirstlane(tid >> 6);
    if (wave == 0) { if (tid == 0) xcd_barrier_thread0(b); }
    else { int G = gridDim.x, bx = blockIdx.x; asm volatile("" : "+s"(G), "+s"(bx)); const int vcu = (G % 8 == 0) ? (bx % 8) * (G / 8) + bx / 8 : bx;
           convert_items(args, lo, hi, vcu * 7 + (wave - 1), G * 7, tid & 63, (LAS float*)(ldsp + wave * 16384)); }
    __syncthreads();
}
constexpr int I_W = (2 * I_L - I_IN) / 6;
#define WSLICE(k) (I_IN + (k) * I_W), (I_IN + ((k) + 1) * I_W)
static_assert((2 * I_L - I_IN) % 6 == 0 && I_IN + 1 * I_W >= I_IN + I_OUT && I_IN + 2 * I_W >= I_IN + I_OUT + I_UP && I_IN + 3 * I_W >= I_L && I_IN + 4 * I_W >= I_L + I_IN + I_OUT, "slice k is published by barrier k+1: out0 by 1, up0 by 2, down0 by 3, in1 by 4, out1 by 6, up1 by 7, down1 by 8");

__global__ void __launch_bounds__(NWAVES * 64, 2) mega_fwd(Args args) {
    extern __shared__ __attribute__((aligned(16))) unsigned char lds[];
    cg::grid_group grid = cg::this_grid();
    LAS unsigned char* ldsp = (LAS unsigned char*)lds;
    for (int u = threadIdx.x; u < (LDS_BYTES - LDSCTL_OFF) / 4; u += NWAVES * 64) ((LAS unsigned*)(ldsp + LDSCTL_OFF))[u] = 0u;
    __syncthreads();
    const XcdBarrier bar = xcd_barrier_post((unsigned*)(args.ws + WS_CTL) + CW_BAR, (volatile LAS unsigned*)(ldsp + MISC_OFF) + 8);
#define PHASE_IDS int tid = threadIdx.x; asm volatile("" : "+v"(tid)); const int lane = tid & 63, wave = __builtin_amdgcn_readfirstlane(tid >> 6); \
    int G = gridDim.x, bx = blockIdx.x; asm volatile("" : "+s"(G), "+s"(bx)); const int vcu = (G % 8 == 0) ? (bx % 8) * (G / 8) + bx / 8 : bx; \
    const int gw = vcu * NWAVES + wave, NGW = G * NWAVES; (void)lane; (void)gw; (void)NGW; (void)tid;
#define XIN   (args.in[0])
#define XRES  (args.out)
#define SSQ(i) ((float*)(args.ws + WS_SSQ) + (size_t)(i) * MTOK)
#define XBp   ((bf16*)(args.ws + WS_XB))
#define PROJp ((bf16*)(args.ws + WS_PROJ))
#define VTp   ((bf16*)(args.ws + WS_VT))
#define MIXp  ((bf16*)(args.ws + WS_MIX))
#define HBp   ((bf16*)(args.ws + WS_H))
#define WLp(l, off) ((bf16*)(args.ws + WS_W + (size_t)(l) * W_LAYER + (off)))

    {
        PHASE_IDS
        LAS float* scr = (LAS float*)(ldsp + wave * 16384);
        CONVERT_ITEMS(0, I_IN)
        for (int m = 2 * gw; m < MTOK; m += 2 * NGW) x_rows2_to_bf16(XIN + (size_t)m * 1024, XBp + (size_t)m * 1024, SSQ(0) + m, lane);
    }
    if (args.ws == nullptr) grid.sync();
    xcd_barrier_work(bar, args, WSLICE(0), ldsp);

    {
        { PHASE_IDS pg8::Gemm g{XBp, WLp(0, W_IN), MTOK, P0W, 1024}; pg8::StaticOrder S; S.init(MTOK, P0W, G, bx);
          pg8::EpiRow<0> E{PROJp, P0W, SSQ(0), 2, QSCALE};
          pg8::gemm_phase<pg8::EpiRow<0>, pg8::StaticOrder, PG8_ALIGN, PG8_SP2>(ldsp, g, S, E); }
        { PHASE_IDS pg8::Gemm g{WLp(0, W_IN) + (size_t)P0W * 1024, XBp, 512, MTOK, 1024}; pg8::StaticOrder S; S.init(512, MTOK, G, (bx + G / 2) % G);
          pg8::EpiColScale E{VTp, MTOK, SSQ(0)};
          pg8::gemm_phase<pg8::EpiColScale, pg8::StaticOrder, PG8_ALIGN, PG8_SP2>(ldsp, g, S, E); }
        xcd_barrier_work(bar, args, WSLICE(1), ldsp);
        { PHASE_IDS
          conv_items(PROJp, args.in[5], MIXp, vcu * (NWAVES * 64) + tid, G * NWAVES * 64);
          LAS float* scr = (LAS float*)(ldsp + wave * 16384);
          for (int u = gw; u < 2 * 8 * 256; u += NGW) sb_unit(u >> 11, (u >> 8) & 7, u & 255, PROJp, VTp, MIXp, ldsp + wave * 16384 + 8704, lane);
          (void)scr; }
        xcd_barrier_work(bar, args, WSLICE(2), ldsp);
        LAYER_TAIL(0)
    }
    {
        { PHASE_IDS pg8::Gemm g{XBp, WLp(1, W_IN), MTOK, P1W, 1024}; pg8::StaticOrder S; S.init(MTOK, P1W, G, bx);
          pg8::EpiRow<0> E{PROJp, P1W, SSQ(2), 4, QSCALE};
          pg8::gemm_phase<pg8::EpiRow<0>, pg8::StaticOrder, PG8_ALIGN, PG8_SP2>(ldsp, g, S, E); }
        xcd_barrier(bar);
        { PHASE_IDS const dattn::DiffOrder S(vcu, G); dattn::diff_phase((char*)lds, PROJp, MIXp, S); }
        { PHASE_IDS float lam;
          { const float a = wave_sum(args.in[8][lane] * args.in[9][lane]), c = wave_sum(args.in[10][lane] * args.in[11][lane]); lam = __expf(a) - __expf(c) + LAMBDA_INIT1; }
          const dattn::DiffOrder S(vcu, G); dattn::diff_combine(PROJp, MIXp, S, lam); }
        xcd_barrier(bar);
        LAYER_TAIL(1)
    }
    if (gridDim.x != 256) { PHASE_IDS const float* ssq_f = SSQ(4);
      f32x4 gv[4];
#pragma unroll
      for (int j = 0; j < 4; ++j) gv[j] = ((const f32x4*)args.in[3])[lane + 64 * j];
      for (int m = 2 * gw; m < MTOK; m += 2 * NGW) { const float rs0 = pg8::rstd_of(ssq_f[m]), rs1 = pg8::rstd_of(ssq_f[m + 1]); f32x4* xr = (f32x4*)(XRES + (size_t)m * 1024) + lane;
          f32x4 v[8];
#pragma unroll
          for (int j = 0; j < 8; ++j) v[j] = xr[64 * j];
#pragma unroll
          for (int j = 0; j < 4; ++j) { xr[64 * j] = v[j] * rs0 * gv[j]; xr[256 + 64 * j] = v[4 + j] * rs1 * gv[j]; } } }
}

extern "C" void kernel_launch(void* const* d_in, const int* in_sizes, int n_in, void* d_out, int out_size, void* d_ws, size_t ws_size, hipStream_t stream) {
    static int grid = 0;
    if (grid == 0) {
        if (n_in != 16 || in_sizes[0] != MTOK * DMOD || out_size != MTOK * DMOD || ws_size < WS_END) { fprintf(stderr, "kernel_launch: unexpected shapes (n_in %d, in0 %d, out %d, ws %zu)\n", n_in, n_in > 0 ? in_sizes[0] : -1, out_size, ws_size); grid = -1; return; }
        int dev = 0, cus = 0, per_cu = 0;
        if (hipGetDevice(&dev) != hipSuccess || hipDeviceGetAttribute(&cus, hipDeviceAttributeMultiprocessorCount, dev) != hipSuccess) { grid = -1; return; }
        if (hipFuncSetAttribute((const void*)mega_fwd, hipFuncAttributeMaxDynamicSharedMemorySize, LDS_BYTES) != hipSuccess) { fprintf(stderr, "kernel_launch: hipFuncSetAttribute failed\n"); grid = -1; return; }
        if (hipOccupancyMaxActiveBlocksPerMultiprocessor(&per_cu, (const void*)mega_fwd, NWAVES * 64, LDS_BYTES) != hipSuccess || per_cu < 1) { fprintf(stderr, "kernel_launch: occupancy query says %d\n", per_cu); per_cu = 1; }
        (void)hipGetLastError();
        grid = cus;
    }
    if (grid < 0) return;
    (void)hipMemsetAsync((char*)d_ws + WS_CTL, 0, CTL_ZERO_BYTES, stream);
    Args a{};
    for (int i = 0; i < 16; ++i) a.in[i] = (const float*)d_in[i];
    a.out = (float*)d_out; a.ws = (unsigned char*)d_ws;
    void* kargs[] = {&a};
    hipError_t e = hipLaunchCooperativeKernel((const void*)mega_fwd, dim3(grid), dim3(NWAVES * 64), kargs, LDS_BYTES, stream);
    if (e != hipSuccess) fprintf(stderr, "kernel_launch: cooperative launch failed: %s (grid %d)\n", hipGetErrorString(e), grid);
}
```

```cpp
#include <hip/hip_runtime.h>
#include <cstdio>
#include <cstdint>
namespace pg8 {
#define PG8_LAS __attribute__((address_space(3)))
typedef unsigned short bf16_t;
typedef short bf16x8 __attribute__((ext_vector_type(8)));
typedef float f32x4 __attribute__((ext_vector_type(4)));
typedef unsigned u32x4 __attribute__((ext_vector_type(4)));
constexpr int BM = 256, BK = 64, HALF = 128, HTB = HALF * BK * 2  , STAGE_BYTES = 8 * HTB, NXCD = 8, WGM = 8;

__host__ __device__ __forceinline__ int lds_byte(int r, int c) { const int st = (r >> 4) * 2 + (c >> 5), rr = r & 15, cc = c & 31, ob = rr * 64 + cc * 2; return st * 1024 + (ob ^ (((ob >> 9) & 1) << 5)); }
__host__ __device__ __forceinline__ void stage_rc(int b, int& R, int& C) { const int st = b / 1024, sb = b % 1024, swz = sb ^ (((sb >> 9) & 1) << 5); R = (st >> 1) * 16 + swz / 64; C = (st & 1) * 32 + (swz % 64) / 2; }
__host__ __device__ __forceinline__ int perm32(int rho) { const int n = rho >> 4, i = rho & 15; return 8 * (i >> 2) + 4 * n + (i & 3); }

struct Unit { int pm, pn; };
struct Gemm { const bf16_t* A; const bf16_t* Bt; int M, N, K; };

struct StaticOrder {
    int nM, nN, nwg, G, c;
    __host__ __device__ void init(int M, int N, int G_, int c_) { nM = M / BM; nN = N / BM; nwg = nM * nN; G = G_; c = c_; }
    __host__ __device__ bool next(int i, Unit& u) const {
        const long L = (long)i * G + c; if (L >= nwg) return false;
        int wgid = (int)L; { const int q = nwg / NXCD, r = nwg % NXCD, xcd = wgid % NXCD, off = wgid / NXCD; wgid = (xcd < r ? xcd * (q + 1) : r * (q + 1) + (xcd - r) * q) + off; }
        const int nig = WGM * nN, gid = wgid / nig, fm = gid * WGM, gsz = (nM - fm) < WGM ? (nM - fm) : WGM;
        u.pm = fm + ((wgid % nig) % gsz); u.pn = (wgid % nig) / gsz; return true;
    }
    __device__ __forceinline__ void a_ready(const Unit&) const {}
    __device__ __forceinline__ void done(const Unit&) const {}
};

__device__ __forceinline__ unsigned cvt_pk_bf16(float lo, float hi) { unsigned r; asm volatile("v_cvt_pk_bf16_f32 %0, %1, %2" : "=v"(r) : "v"(lo), "v"(hi)); return r; }
typedef float f32x2 __attribute__((ext_vector_type(2)));
__device__ __forceinline__ float rstd_of(float ssq) { return __builtin_amdgcn_rsqf(ssq * (1.0f / 1024.0f) + 1e-6f); }
typedef unsigned u32x2 __attribute__((ext_vector_type(2)));
template <int ACT> struct EpiRow {
    static constexpr bool PERM = true, AFTER_DRAIN = false;
    bf16_t* O; int ldc; const float* ssq; int qtiles; float qscale;
    __device__ __forceinline__ void operator()(const f32x4 (&acc)[2][2][4][2], const Unit& u, int wr, int wc, int fr, int fq) const {
        const int row0 = u.pm * BM + wr * 64 + fr, col0 = u.pn * BM + wc * 32 + 8 * fq;
        const float sc = (u.pn < qtiles) ? qscale : 1.f;
        float rsv[2][4];
#pragma unroll
        for (int ai = 0; ai < 2; ++ai)
#pragma unroll
            for (int m = 0; m < 4; ++m) rsv[ai][m] = ssq[row0 + ai * HALF + m * 16];
#pragma unroll
        for (int ai = 0; ai < 2; ++ai)
#pragma unroll
            for (int m = 0; m < 4; ++m) { const int row = row0 + ai * HALF + m * 16; const float rs = rstd_of(rsv[ai][m]) * sc; bf16_t* rowp = O + (size_t)row * ldc + col0;
#pragma unroll
                for (int bj = 0; bj < 2; ++bj) { f32x4 v0 = acc[ai][bj][m][0], v1 = acc[ai][bj][m][1];
                    if (ACT == 1) { const f32x4 z = {0.f, 0.f, 0.f, 0.f}; v0 = v0 * rs; v1 = v1 * rs; v0 = __builtin_elementwise_max(v0, z); v1 = __builtin_elementwise_max(v1, z); v0 = v0 * v0; v1 = v1 * v1; }
                    else { v0 = v0 * rs; v1 = v1 * rs; }
                    u32x4 w; w.x = cvt_pk_bf16(v0[0], v0[1]); w.y = cvt_pk_bf16(v0[2], v0[3]); w.z = cvt_pk_bf16(v1[0], v1[1]); w.w = cvt_pk_bf16(v1[2], v1[3]);
                    *(u32x4*)(rowp + bj * HALF) = w; } }
    }
};
struct EpiColScale {
    static constexpr bool PERM = true, AFTER_DRAIN = false;
    bf16_t* O; int ldc; const float* ssq;
    __device__ __forceinline__ void operator()(const f32x4 (&acc)[2][2][4][2], const Unit& u, int wr, int wc, int fr, int fq) const {
        const int row0 = u.pm * BM + wr * 64 + fr, col0 = u.pn * BM + wc * 32 + 8 * fq;
        f32x4 sv[2][2];
#pragma unroll
        for (int bj = 0; bj < 2; ++bj)
#pragma unroll
            for (int n = 0; n < 2; ++n) { const f32x4 s = *(const f32x4*)(ssq + col0 + bj * HALF + 4 * n); sv[bj][n] = (f32x4){rstd_of(s[0]), rstd_of(s[1]), rstd_of(s[2]), rstd_of(s[3])}; }
#pragma unroll
        for (int ai = 0; ai < 2; ++ai)
#pragma unroll
            for (int m = 0; m < 4; ++m) { bf16_t* rowp = O + (size_t)(row0 + ai * HALF + m * 16) * ldc + col0;
#pragma unroll
                for (int bj = 0; bj < 2; ++bj) { const f32x4 v0 = acc[ai][bj][m][0] * sv[bj][0], v1 = acc[ai][bj][m][1] * sv[bj][1];
                    u32x4 w; w.x = cvt_pk_bf16(v0[0], v0[1]); w.y = cvt_pk_bf16(v0[2], v0[3]); w.z = cvt_pk_bf16(v1[0], v1[1]); w.w = cvt_pk_bf16(v1[2], v1[3]);
                    *(u32x4*)(rowp + bj * HALF) = w; } }
    }
};
struct EpiRes {
    static constexpr bool PERM = false, AFTER_DRAIN = false;
    const float* base; float* out; bf16_t* xb; float* ssq;
    __device__ __forceinline__ void operator()(const f32x4 (&acc)[2][2][4][2], const Unit& u, int wr, int wc, int fr, int fq) const {
        const int row0 = u.pm * BM + wr * 64 + fr, col0 = u.pn * BM + wc * 32 + 4 * fq;
#pragma unroll
        for (int ai = 0; ai < 2; ++ai) {
            f32x4 pre[4][2][2];
#pragma unroll
            for (int m = 0; m < 4; ++m) { const size_t off = (size_t)(row0 + ai * HALF + m * 16) * 1024 + col0;
#pragma unroll
                for (int bj = 0; bj < 2; ++bj)
#pragma unroll
                    for (int n = 0; n < 2; ++n) pre[m][bj][n] = __builtin_nontemporal_load((const f32x4*)(base + off + bj * HALF + n * 16)); }
            asm volatile("" ::: "memory");
#pragma unroll
            for (int m = 0; m < 4; ++m) { const int row = row0 + ai * HALF + m * 16; const size_t off = (size_t)row * 1024 + col0; float s = 0.f;
#pragma unroll
                for (int bj = 0; bj < 2; ++bj)
#pragma unroll
                    for (int n = 0; n < 2; ++n) { const f32x4 v = pre[m][bj][n] + acc[ai][bj][m][n];
                        __builtin_nontemporal_store(v, (f32x4*)(out + off + bj * HALF + n * 16)); s += (v[0] * v[0] + v[1] * v[1]) + (v[2] * v[2] + v[3] * v[3]);
                        u32x2 w; w.x = cvt_pk_bf16(v[0], v[1]); w.y = cvt_pk_bf16(v[2], v[3]); *(u32x2*)(xb + off + bj * HALF + n * 16) = w; }
                s += __shfl_xor(s, 16); s += __shfl_xor(s, 32);
                if (fq == 0) __hip_atomic_fetch_add(ssq + row, s, __ATOMIC_RELAXED, __HIP_MEMORY_SCOPE_AGENT); }
            asm volatile("" ::: "memory");
        }
    }
};

struct EpiResFinal {
    static constexpr bool PERM = false, AFTER_DRAIN = true;
    const float* base; float* out; float* ssq; unsigned* cnt; const float* gain;
    __device__ __forceinline__ void operator()(const f32x4 (&)[2][2][4][2], const Unit&, int, int, int, int) const {}
    __device__ __forceinline__ void fused(f32x4 (&acc)[2][2][4][2], const Unit& u, int wr, int wc, int fr, int fq, PG8_LAS unsigned char*, int, int lane) const {
        const int row0 = u.pm * BM + wr * 64 + fr, col0 = u.pn * BM + wc * 32 + 4 * fq;
#pragma unroll
        for (int ai = 0; ai < 2; ++ai) {
            f32x4 pre[4][2][2];
#pragma unroll
            for (int m = 0; m < 4; ++m) { const size_t off = (size_t)(row0 + ai * HALF + m * 16) * 1024 + col0;
#pragma unroll
                for (int bj = 0; bj < 2; ++bj)
#pragma unroll
                    for (int n = 0; n < 2; ++n) pre[m][bj][n] = __builtin_nontemporal_load((const f32x4*)(base + off + bj * HALF + n * 16)); }
            asm volatile("" ::: "memory");
#pragma unroll
            for (int m = 0; m < 4; ++m) { const int row = row0 + ai * HALF + m * 16; float s = 0.f;
#pragma unroll
                for (int bj = 0; bj < 2; ++bj)
#pragma unroll
                    for (int n = 0; n < 2; ++n) { const f32x4 v = pre[m][bj][n] + acc[ai][bj][m][n]; acc[ai][bj][m][n] = v; s += (v[0] * v[0] + v[1] * v[1]) + (v[2] * v[2] + v[3] * v[3]); }
                s += __shfl_xor(s, 16); s += __shfl_xor(s, 32);
                if (fq == 0) __hip_atomic_fetch_add(ssq + row, s, __ATOMIC_RELAXED, __HIP_MEMORY_SCOPE_AGENT); }
        }
        asm volatile("s_waitcnt vmcnt(0)" ::: "memory");
        unsigned* c = cnt + 64 * u.pm;
        if (lane == 0) __hip_atomic_fetch_add(c, 1u, __ATOMIC_RELAXED, __HIP_MEMORY_SCOPE_AGENT);
        { unsigned sp = 0; while ((unsigned)__builtin_amdgcn_readfirstlane(__hip_atomic_load(c, __ATOMIC_RELAXED, __HIP_MEMORY_SCOPE_AGENT)) < 32u) { __builtin_amdgcn_s_sleep(2); if (++sp > (1u << 22)) break; } }
        __builtin_amdgcn_fence(__ATOMIC_ACQUIRE, "agent");
        f32x4 gv[2][2];
#pragma unroll
        for (int bj = 0; bj < 2; ++bj)
#pragma unroll
            for (int n = 0; n < 2; ++n) gv[bj][n] = *(const f32x4*)(gain + col0 + bj * HALF + n * 16);
        float rsv[2][4];
#pragma unroll
        for (int ai = 0; ai < 2; ++ai)
#pragma unroll
            for (int m = 0; m < 4; ++m) rsv[ai][m] = __hip_atomic_load(ssq + row0 + ai * HALF + m * 16, __ATOMIC_RELAXED, __HIP_MEMORY_SCOPE_AGENT);
#pragma unroll
        for (int ai = 0; ai < 2; ++ai)
#pragma unroll
            for (int m = 0; m < 4; ++m) { const float rs = rstd_of(rsv[ai][m]); const size_t off = (size_t)(row0 + ai * HALF + m * 16) * 1024 + col0;
#pragma unroll
                for (int bj = 0; bj < 2; ++bj)
#pragma unroll
                    for (int n = 0; n < 2; ++n) __builtin_nontemporal_store(acc[ai][bj][m][n] * rs * gv[bj][n], (f32x4*)(out + off + bj * HALF + n * 16)); }
    }
};

template <class Epi, class Sched, bool ALIGN_EPI = false, bool SP2 = false>
__device__ __forceinline__ void gemm_phase(PG8_LAS unsigned char* lds, const Gemm g, const Sched& S, const Epi& E) {
    int tid_ = threadIdx.x; asm volatile("" : "+v"(tid_));
    const int tid = tid_, wid = __builtin_amdgcn_readfirstlane(tid >> 6), lane = tid & 63, wr = wid >> 2, wc = wid & 3, fr = lane & 15, fq = lane >> 4;
    const int K = g.K, nt = K / BK;
    unsigned voffA[2], voffB[2];
#pragma unroll
    for (int i = 0; i < 2; ++i) { int R, C; stage_rc(tid * 16 + i * 8192, R, C); const int Rb = Epi::PERM ? ((R & ~31) + perm32(R & 31)) : R;
        voffA[i] = (unsigned)(R * K + C) * 2u; voffB[i] = (unsigned)(Rb * K + C) * 2u; }
    const size_t kstep = (size_t)(BK * 2);
    const size_t hstep = (size_t)HALF * K * 2;
    const size_t tstep = 2 * hstep;
    const unsigned ldsw = (unsigned)wid * 1024u;
    const int aoff = lds_byte(wr * 64 + fr, fq * 8), boff = lds_byte(wc * 32 + fr, fq * 8);
#define PG8_SA(b, h) (((b) * 2 + (h)) * HTB)
#define PG8_SB(b, h) ((4 + (b) * 2 + (h)) * HTB)
#define PG8_STAGE(bufoff, gbase, voff) do { _Pragma("unroll") for (int _i = 0; _i < 2; ++_i) \
        __builtin_amdgcn_global_load_lds((const unsigned*)((const char*)(gbase) + (voff)[_i]), (PG8_LAS unsigned*)(lds + (bufoff) + ldsw + _i * 8192), 16, 0, 0); } while (0)
#define PG8_LDA(dst, b, h) do { _Pragma("unroll") for (int m = 0; m < 4; ++m) _Pragma("unroll") for (int k = 0; k < 2; ++k) dst[m][k] = *(const PG8_LAS bf16x8*)(lds + PG8_SA(b, h) + aoff + m * 2048 + k * 1024); } while (0)
#define PG8_LDB(dst, b, h) do { _Pragma("unroll") for (int n = 0; n < 2; ++n) _Pragma("unroll") for (int k = 0; k < 2; ++k) dst[n][k] = *(const PG8_LAS bf16x8*)(lds + PG8_SB(b, h) + boff + n * 2048 + k * 1024); } while (0)
#define PG8_MMA(ai, bj, At, Bt) do { __builtin_amdgcn_s_setprio(1); _Pragma("unroll") for (int m = 0; m < 4; ++m) _Pragma("unroll") for (int n = 0; n < 2; ++n) _Pragma("unroll") for (int k = 0; k < 2; ++k) \
        acc[ai][bj][m][n] = __builtin_amdgcn_mfma_f32_16x16x32_bf16(Bt[n][k], At[m][k], acc[ai][bj][m][n], 0, 0, 0); __builtin_amdgcn_s_setprio(0); } while (0)
#define PG8_WAIT_V(n) asm volatile("s_waitcnt vmcnt(" #n ")" ::: "memory")
#define PG8_WAIT_L(n) asm volatile("s_waitcnt lgkmcnt(" #n ")" ::: "memory")
#define PG8_BAR __builtin_amdgcn_s_barrier()
#define PG8_SCHED __builtin_amdgcn_sched_barrier(0)
    Unit cur, nxt; int ui = 0;
    if (!S.next(0, cur)) return;
    f32x4 acc[2][2][4][2];
#pragma unroll
    for (int a = 0; a < 2; ++a)
#pragma unroll
        for (int b = 0; b < 2; ++b)
#pragma unroll
            for (int m = 0; m < 4; ++m)
#pragma unroll
                for (int n = 0; n < 2; ++n) acc[a][b][m][n] = (f32x4){0.f, 0.f, 0.f, 0.f};
    bf16x8 At[4][2], B0[2][2], B1[2][2];
    const char* cA = (const char*)g.A + (size_t)cur.pm * tstep; const char* cB = (const char*)g.Bt + (size_t)cur.pn * tstep;
    S.a_ready(cur);
    if constexpr (SP2) {
        PG8_STAGE(PG8_SB(0, 0), cB, voffB); PG8_STAGE(PG8_SB(0, 1), cB + hstep, voffB); PG8_STAGE(PG8_SA(0, 0), cA, voffA); PG8_STAGE(PG8_SA(0, 1), cA + hstep, voffA);
        if (wr == 1) PG8_BAR;
        PG8_WAIT_V(2); PG8_BAR;
        PG8_STAGE(PG8_SB(1, 0), cB + kstep, voffB); PG8_STAGE(PG8_SA(1, 0), cA + kstep, voffA); PG8_STAGE(PG8_SB(1, 1), cB + hstep + kstep, voffB);
        PG8_WAIT_V(6); PG8_BAR;
    } else {
        PG8_STAGE(PG8_SB(0, 0), cB, voffB); PG8_STAGE(PG8_SA(0, 0), cA, voffA); PG8_STAGE(PG8_SB(0, 1), cB + hstep, voffB); PG8_STAGE(PG8_SA(0, 1), cA + hstep, voffA);
        if (wr == 1) PG8_BAR;
        PG8_WAIT_V(4); PG8_BAR;
        PG8_STAGE(PG8_SB(1, 0), cB + kstep, voffB); PG8_STAGE(PG8_SA(1, 0), cA + kstep, voffA); PG8_STAGE(PG8_SB(1, 1), cB + hstep + kstep, voffB);
        PG8_WAIT_V(6); PG8_BAR;
    }
    for (;;) {
        const bool has_next = S.next(ui + 1, nxt);
        const char* nA = has_next ? (const char*)g.A + (size_t)nxt.pm * tstep : cA; const char* nB = has_next ? (const char*)g.Bt + (size_t)nxt.pn * tstep : cB;
        for (int t = 0; t < nt; t += 2) {
            const bool last = (t == nt - 2);
            const char* a1 = cA + (size_t)(t + 1) * kstep;
            const char* a2 = last ? nA : cA + (size_t)(t + 2) * kstep; const char* b2 = last ? nB : cB + (size_t)(t + 2) * kstep;
            const char* a3 = a2 + kstep; const char* b3 = b2 + kstep;
            if (last && has_next) S.a_ready(nxt);
            if constexpr (SP2) {
            PG8_LDB(B0, 0, 0); PG8_LDB(B1, 0, 1); PG8_SCHED; PG8_LDA(At, 0, 0); PG8_STAGE(PG8_SA(1, 1), a1 + hstep, voffA);
            PG8_WAIT_V(8); PG8_WAIT_L(0); PG8_BAR; PG8_MMA(0, 0, At, B0); PG8_MMA(0, 1, At, B1); PG8_BAR; PG8_SCHED;
            PG8_LDA(At, 0, 1); PG8_STAGE(PG8_SB(0, 0), b2, voffB); PG8_STAGE(PG8_SB(0, 1), b2 + hstep, voffB); PG8_STAGE(PG8_SA(0, 0), a2, voffA);
            PG8_WAIT_V(8); PG8_WAIT_L(0); PG8_BAR; PG8_MMA(1, 0, At, B0); PG8_MMA(1, 1, At, B1); PG8_BAR; PG8_SCHED;
            PG8_LDB(B0, 1, 0); PG8_LDB(B1, 1, 1); PG8_SCHED; PG8_LDA(At, 1, 0); PG8_STAGE(PG8_SA(0, 1), a2 + hstep, voffA);
            PG8_WAIT_V(8); PG8_WAIT_L(0); PG8_BAR; PG8_MMA(0, 0, At, B0); PG8_MMA(0, 1, At, B1); PG8_BAR; PG8_SCHED;
            PG8_LDA(At, 1, 1); PG8_STAGE(PG8_SB(1, 0), b3, voffB); PG8_STAGE(PG8_SB(1, 1), b3 + hstep, voffB); PG8_STAGE(PG8_SA(1, 0), a3, voffA);
            PG8_WAIT_V(8); PG8_WAIT_L(0); PG8_BAR; PG8_MMA(1, 0, At, B0); PG8_MMA(1, 1, At, B1); PG8_BAR; PG8_SCHED;
            } else {
            PG8_LDB(B0, 0, 0); PG8_SCHED; PG8_LDA(At, 0, 0); PG8_STAGE(PG8_SA(1, 1), a1 + hstep, voffA);
            PG8_WAIT_L(8); PG8_BAR; PG8_WAIT_L(0); PG8_MMA(0, 0, At, B0); PG8_BAR; PG8_SCHED;
            PG8_LDB(B1, 0, 1); PG8_STAGE(PG8_SB(0, 0), b2, voffB);
            PG8_BAR; PG8_WAIT_L(0); PG8_MMA(0, 1, At, B1); PG8_BAR;
            PG8_LDA(At, 0, 1); PG8_STAGE(PG8_SA(0, 0), a2, voffA);
            PG8_BAR; PG8_WAIT_L(0); PG8_MMA(1, 0, At, B0); PG8_BAR; PG8_SCHED;
            PG8_STAGE(PG8_SB(0, 1), b2 + hstep, voffB);
            PG8_WAIT_V(6); PG8_BAR; PG8_MMA(1, 1, At, B1); PG8_BAR;
            PG8_LDB(B0, 1, 0); PG8_SCHED; PG8_LDA(At, 1, 0); PG8_STAGE(PG8_SA(0, 1), a2 + hstep, voffA);
            PG8_WAIT_L(8); PG8_BAR; PG8_WAIT_L(0); PG8_MMA(0, 0, At, B0); PG8_BAR; PG8_SCHED;
            PG8_LDB(B1, 1, 1); PG8_STAGE(PG8_SB(1, 0), b3, voffB);
            PG8_BAR; PG8_WAIT_L(0); PG8_MMA(0, 1, At, B1); PG8_BAR;
            PG8_LDA(At, 1, 1); PG8_STAGE(PG8_SA(1, 0), a3, voffA);
            PG8_BAR; PG8_WAIT_L(0); PG8_MMA(1, 0, At, B0); PG8_BAR; PG8_SCHED;
            PG8_STAGE(PG8_SB(1, 1), b3 + hstep, voffB);
            PG8_WAIT_V(6); PG8_BAR; PG8_MMA(1, 1, At, B1); PG8_BAR;
            }
        }
        if constexpr (ALIGN_EPI) { if (wr == 0) PG8_BAR; }
        if constexpr (!Epi::AFTER_DRAIN) { E(acc, cur, wr, wc, fr, fq); S.done(cur); }
        if (!has_next) break;
#pragma unroll
        for (int a = 0; a < 2; ++a)
#pragma unroll
            for (int b = 0; b < 2; ++b)
#pragma unroll
                for (int m = 0; m < 4; ++m)
#pragma unroll
                    for (int n = 0; n < 2; ++n) acc[a][b][m][n] = (f32x4){0.f, 0.f, 0.f, 0.f};
        cur = nxt; cA = nA; cB = nB; ++ui;
        if constexpr (ALIGN_EPI) { if (wr == 1) PG8_BAR; }
    }
    PG8_WAIT_V(0);
    if constexpr (!ALIGN_EPI) { if (wr == 0) PG8_BAR; }
    PG8_BAR;
    if constexpr (Epi::AFTER_DRAIN) { E.fused(acc, cur, wr, wc, fr, fq, lds, wid, lane); S.done(cur); }
#undef PG8_SA
#undef PG8_SB
#undef PG8_STAGE
#undef PG8_LDA
#undef PG8_LDB
#undef PG8_MMA
#undef PG8_WAIT_V
#undef PG8_WAIT_L
#undef PG8_BAR
#undef PG8_SCHED
}
}

#ifndef PG8_SP2
#define PG8_SP2 true
#endif
#ifndef PG8_ALIGN
#define PG8_ALIGN true
#endif
#include <hip/hip_bf16.h>
#include <cmath>
namespace dattn {
using bf16=__hip_bfloat16;
using bf16x8=__attribute__((ext_vector_type(8)))short;
using s16x4=__attribute__((ext_vector_type(4)))short;
using f32x16=__attribute__((ext_vector_type(16)))float;
using u32x4=__attribute__((ext_vector_type(4)))unsigned;
using u32x2=__attribute__((ext_vector_type(2)))unsigned;
constexpr int SEQ=8192,DM=3072,QB=256,NSLOT=4,KSLOT=8192,VSLOT=16384;
constexpr int LDS_K=0,LDS_V=NSLOT*KSLOT,LDS_END=LDS_V+NSLOT*VSLOT;
constexpr int OST_ROW=272,OST_WAVE=32*OST_ROW;
static_assert(8*OST_WAVE<=LDS_END,"O staging fits over the rings");
typedef __attribute__((address_space(3))) const char* lds_cptr;
typedef __attribute__((address_space(3))) char* lds_ptr;
typedef short v4i16_t __attribute__((ext_vector_type(4)));
__device__ __forceinline__ void glds16(const void*gsrc,unsigned lds_dst){unsigned keep;
  asm volatile("s_mov_b32 %0, m0\n\ts_mov_b32 m0, %2\n\ts_nop 0\n\tglobal_load_lds_dwordx4 %1, off\n\ts_mov_b32 m0, %0":"=&s"(keep):"v"(gsrc),"s"(lds_dst):"memory");}
__device__ __forceinline__ s16x4 vtr(lds_cptr p){ return __builtin_bit_cast(s16x4,__builtin_amdgcn_ds_read_tr16_b64_v4i16((__attribute__((address_space(3))) v4i16_t*)p)); }
typedef float f32x2_t __attribute__((ext_vector_type(2))); typedef __bf16 bf16x2_t __attribute__((ext_vector_type(2)));
__device__ __forceinline__ unsigned cvtpk_s(float lo,float hi){f32x2_t v={lo,hi};bf16x2_t b=__builtin_convertvector(v,bf16x2_t);return __builtin_bit_cast(unsigned,b);}
#define DWAIT_BAR(N) asm volatile("s_waitcnt vmcnt(" #N ") lgkmcnt(0)\n\ts_barrier":::"memory")
__device__ __forceinline__ void unit(int b,int qb,const bf16*Q,const bf16*__restrict__ K,const bf16*__restrict__ V,bf16*O,int opitch,char*shm){
  const int tid=threadIdx.x,lane=tid&63,r32=lane&31,hi=lane>>5; const int wid=__builtin_amdgcn_readfirstlane(tid>>6);
  const long rowbase=(long)b*SEQ; const int q0=qb*QB;
  const bf16*Qw=Q+(rowbase+q0+wid*32)*DM;
  const unsigned lds0=(unsigned)(uintptr_t)shm;
  const bf16*ksrc=K+rowbase*DM+(long)lane*DM+wid*8;
  const bf16*vsrc=V+rowbase*DM+(long)(16*(wid&3)+(lane>>2))*DM+(wid>>2)*32+(lane&3)*8;
  const unsigned kdst=lds0+LDS_K+wid*1024,vdst=lds0+LDS_V+wid*1024;
  #define DDMA(t,sl) do{ glds16(ksrc+(long)(t)*64*DM,(unsigned)__builtin_amdgcn_readfirstlane(kdst+(sl)*KSLOT)); \
      glds16(vsrc+(long)(t)*64*DM,(unsigned)__builtin_amdgcn_readfirstlane(vdst+(sl)*VSLOT)); \
      glds16(vsrc+(long)(t)*64*DM+64,(unsigned)__builtin_amdgcn_readfirstlane(vdst+(sl)*VSLOT+8192)); }while(0)
  #define SBARR() do{}while(0)
  #define DVRD(dst,vp_,cb_) do{ _Pragma("unroll") for(int c_=0;c_<4;++c_){ dst[2*c_]=vtr((vp_)+((cb_)>>1)*8192+((cb_)&1)*4096+c_*1024); dst[2*c_+1]=vtr((vp_)+((cb_)>>1)*8192+((cb_)&1)*4096+c_*1024+512); } }while(0)
  #define DVF(src,c_) (bf16x8){src[2*(c_)][0],src[2*(c_)][1],src[2*(c_)][2],src[2*(c_)][3],src[2*(c_)+1][0],src[2*(c_)+1][1],src[2*(c_)+1][2],src[2*(c_)+1][3]}
  #define DVRDC(dst,vp_,c_) do{ _Pragma("unroll") for(int b_=0;b_<4;++b_){ dst[2*b_]=vtr((vp_)+(b_>>1)*8192+(b_&1)*4096+(c_)*1024); dst[2*b_+1]=vtr((vp_)+(b_>>1)*8192+(b_&1)*4096+(c_)*1024+512); } }while(0)
  #define DPVC(src,c_) do{ _Pragma("unroll") for(int b_=0;b_<4;++b_) o[b_]=__builtin_amdgcn_mfma_f32_32x32x16_bf16(DVF(src,b_),pw[c_],o[b_],0,0,0); }while(0)
  #define DPV(src,cb_) do{ o[cb_]=__builtin_amdgcn_mfma_f32_32x32x16_bf16(DVF(src,0),pw[0],o[cb_],0,0,0); o[cb_]=__builtin_amdgcn_mfma_f32_32x32x16_bf16(DVF(src,1),pw[1],o[cb_],0,0,0); \
      o[cb_]=__builtin_amdgcn_mfma_f32_32x32x16_bf16(DVF(src,2),pw[2],o[cb_],0,0,0); o[cb_]=__builtin_amdgcn_mfma_f32_32x32x16_bf16(DVF(src,3),pw[3],o[cb_],0,0,0); }while(0)
  #define PV_PLAIN(vp_) do{ DPVC(va,0); DVRDC(va,vp_,2); DPVC(vb,1); DVRDC(vb,vp_,3); DPVC(va,2); DPVC(vb,3); }while(0)
  #define EXPS_PLAIN() do{ float ls0=0.f,ls1=0.f; \
      _Pragma("unroll") for(int r=0;r<16;++r){ p0[r]=__builtin_amdgcn_exp2f(p0[r]-mref); ls0+=p0[r]; p1[r]=__builtin_amdgcn_exp2f(p1[r]-mref); ls1+=p1[r]; } l+=ls0+ls1; \
      u32x4 w0,w1,w2,w3; w0.x=cvtpk_s(p0[0],p0[1]);w0.y=cvtpk_s(p0[2],p0[3]);w0.z=cvtpk_s(p0[4],p0[5]);w0.w=cvtpk_s(p0[6],p0[7]); \
      w1.x=cvtpk_s(p0[8],p0[9]);w1.y=cvtpk_s(p0[10],p0[11]);w1.z=cvtpk_s(p0[12],p0[13]);w1.w=cvtpk_s(p0[14],p0[15]); \
      w2.x=cvtpk_s(p1[0],p1[1]);w2.y=cvtpk_s(p1[2],p1[3]);w2.z=cvtpk_s(p1[4],p1[5]);w2.w=cvtpk_s(p1[6],p1[7]); \
      w3.x=cvtpk_s(p1[8],p1[9]);w3.y=cvtpk_s(p1[10],p1[11]);w3.z=cvtpk_s(p1[12],p1[13]);w3.w=cvtpk_s(p1[14],p1[15]); \
      pw[0]=__builtin_bit_cast(bf16x8,w0);pw[1]=__builtin_bit_cast(bf16x8,w1);pw[2]=__builtin_bit_cast(bf16x8,w2);pw[3]=__builtin_bit_cast(bf16x8,w3); }while(0)
  const int NT=(q0+QB)/64;
  DDMA(0,0); DDMA(1,1);
  bf16x8 qr[4];
  #pragma unroll
  for(int d0=0;d0<4;++d0)qr[d0]=*reinterpret_cast<const bf16x8*>(&Qw[(long)r32*DM+d0*16+hi*8]);
  asm volatile("":"+v"(qr[0]),"+v"(qr[1]),"+v"(qr[2]),"+v"(qr[3]));
  const lds_cptr shm3=(lds_cptr)shm;
  const lds_cptr kp0=shm3+LDS_K+hi*1024+r32*16;
  const lds_cptr vp0=shm3+LDS_V+((lane>>4)&1)*32+(lane&3)*8+(4*hi+((lane&15)>>2))*64;
  f32x16 o[4]; o[0]=f32x16{};o[1]=f32x16{};o[2]=f32x16{};o[3]=f32x16{};
  float mref=0.f,l=0.f;
  f32x16 negm=f32x16{};
  const int qfirst=q0+wid*32, qme=qfirst+r32;
  const int TI=(qfirst+1)>>6;
  int t=0;
  bf16x8 pw[4]; pw[0]=bf16x8{};pw[1]=bf16x8{};pw[2]=bf16x8{};pw[3]=bf16x8{};
  for(;t<TI;++t){
    const int slot=t&3;
    if(t+1<NT){DWAIT_BAR(3);}else{DWAIT_BAR(0);}
    const lds_cptr kp=kp0+slot*KSLOT; const lds_cptr vpp=vp0+((t?t-1:0)&3)*VSLOT;
    bf16x8 kf[8];
    #pragma unroll
    for(int d0=0;d0<4;++d0){ kf[2*d0]=*(const __attribute__((address_space(3))) bf16x8*)(kp+d0*2048); kf[2*d0+1]=*(const __attribute__((address_space(3))) bf16x8*)(kp+d0*2048+512); }
    s16x4 va[8],vb[8];
    f32x16 p0=__builtin_amdgcn_mfma_f32_32x32x16_bf16(kf[0],qr[0],negm,0,0,0),p1=__builtin_amdgcn_mfma_f32_32x32x16_bf16(kf[1],qr[0],negm,0,0,0);
    #pragma unroll
    for(int d0=1;d0<4;++d0){ p0=__builtin_amdgcn_mfma_f32_32x32x16_bf16(kf[2*d0],qr[d0],p0,0,0,0); p1=__builtin_amdgcn_mfma_f32_32x32x16_bf16(kf[2*d0+1],qr[d0],p1,0,0,0); }
    DVRDC(va,vpp,0);
    float mt;
    if(t==0){
      mt=__builtin_fmaxf(__builtin_fmaxf(p0[0],p0[1]),__builtin_fmaxf(p1[0],p1[1]));
      #pragma unroll
      for(int r=2;r<16;r+=2){ mt=__builtin_fmaxf(mt,__builtin_fmaxf(p0[r],p0[r+1])); mt=__builtin_fmaxf(mt,__builtin_fmaxf(p1[r],p1[r+1])); }
    } else {
      #define IMX(a_,b_) ((a_)>(b_)?(a_):(b_))
      int im=IMX(IMX(__float_as_int(p0[0]),__float_as_int(p0[1])),IMX(__float_as_int(p1[0]),__float_as_int(p1[1])));
      #pragma unroll
      for(int r=2;r<16;r+=2){ im=IMX(im,IMX(__float_as_int(p0[r]),__float_as_int(p0[r+1]))); im=IMX(im,IMX(__float_as_int(p1[r]),__float_as_int(p1[r+1]))); }
      #undef IMX
      mt=__int_as_float(im);
    }
    { auto rr=__builtin_amdgcn_permlane32_swap(__float_as_uint(mt),__float_as_uint(mt),false,false); mt=__builtin_fmaxf(__uint_as_float(rr[0]),__uint_as_float(rr[1])); }
    if(t==0||__any(mt>8.0f)){
      DVRDC(vb,vpp,1); PV_PLAIN(vpp);
      const float delta=t?__builtin_fmaxf(mt,0.f):mt; const float alpha=t?__builtin_amdgcn_exp2f(-delta):1.0f;
      #pragma unroll
      for(int cb=0;cb<4;++cb)o[cb]=o[cb]*alpha;
      l*=alpha; mref+=delta;
      #pragma unroll
      for(int r=0;r<16;++r){ p0[r]-=delta; p1[r]-=delta; negm[r]=-mref; }
      pw[0]=bf16x8{};pw[1]=bf16x8{};pw[2]=bf16x8{};pw[3]=bf16x8{};
      DVRDC(va,vpp,0);
    }
    {
      float ls0=0.f,ls1=0.f; u32x4 wq;
      DVRDC(vb,vpp,1);
      o[0]=__builtin_amdgcn_mfma_f32_32x32x16_bf16(DVF(va,0),pw[0],o[0],0,0,0);
      p0[0]=__builtin_amdgcn_exp2f(p0[0]); p0[1]=__builtin_amdgcn_exp2f(p0[1]); ls0+=p0[0]+p0[1];
      o[1]=__builtin_amdgcn_mfma_f32_32x32x16_bf16(DVF(va,1),pw[0],o[1],0,0,0);
      p0[2]=__builtin_amdgcn_exp2f(p0[2]); p0[3]=__builtin_amdgcn_exp2f(p0[3]); ls0+=p0[2]+p0[3];
      o[2]=__builtin_amdgcn_mfma_f32_32x32x16_bf16(DVF(va,2),pw[0],o[2],0,0,0);
      p0[4]=__builtin_amdgcn_exp2f(p0[4]); p0[5]=__builtin_amdgcn_exp2f(p0[5]); ls0+=p0[4]+p0[5];
      o[3]=__builtin_amdgcn_mfma_f32_32x32x16_bf16(DVF(va,3),pw[0],o[3],0,0,0);
      p0[6]=__builtin_amdgcn_exp2f(p0[6]); p0[7]=__builtin_amdgcn_exp2f(p0[7]); ls0+=p0[6]+p0[7];
      if(t+2<NT){ DDMA(t+2,(t+2)&3); }
      DVRDC(va,vpp,2);
      o[0]=__builtin_amdgcn_mfma_f32_32x32x16_bf16(DVF(vb,0),pw[1],o[0],0,0,0);
      p0[8]=__builtin_amdgcn_exp2f(p0[8]); p0[9]=__builtin_amdgcn_exp2f(p0[9]); ls0+=p0[8]+p0[9];
      wq.x=cvtpk_s(p0[0],p0[1]);
      o[1]=__builtin_amdgcn_mfma_f32_32x32x16_bf16(DVF(vb,1),pw[1],o[1],0,0,0);
      p0[10]=__builtin_amdgcn_exp2f(p0[10]); p0[11]=__builtin_amdgcn_exp2f(p0[11]); ls0+=p0[10]+p0[11];
      wq.y=cvtpk_s(p0[2],p0[3]);
      o[2]=__builtin_amdgcn_mfma_f32_32x32x16_bf16(DVF(vb,2),pw[1],o[2],0,0,0);
      p0[12]=__builtin_amdgcn_exp2f(p0[12]); p0[13]=__builtin_amdgcn_exp2f(p0[13]); ls0+=p0[12]+p0[13];
      wq.z=cvtpk_s(p0[4],p0[5]);
      o[3]=__builtin_amdgcn_mfma_f32_32x32x16_bf16(DVF(vb,3),pw[1],o[3],0,0,0);
      p0[14]=__builtin_amdgcn_exp2f(p0[14]); p0[15]=__builtin_amdgcn_exp2f(p0[15]); ls0+=p0[14]+p0[15];
      wq.w=cvtpk_s(p0[6],p0[7]);
      pw[0]=__builtin_bit_cast(bf16x8,wq);
      DVRDC(vb,vpp,3);
      o[0]=__builtin_amdgcn_mfma_f32_32x32x16_bf16(DVF(va,0),pw[2],o[0],0,0,0);
      p1[0]=__builtin_amdgcn_exp2f(p1[0]); p1[1]=__builtin_amdgcn_exp2f(p1[1]); ls1+=p1[0]+p1[1];
      wq.x=cvtpk_s(p0[8],p0[9]);
      o[1]=__builtin_amdgcn_mfma_f32_32x32x16_bf16(DVF(va,1),pw[2],o[1],0,0,0);
      p1[2]=__builtin_amdgcn_exp2f(p1[2]); p1[3]=__builtin_amdgcn_exp2f(p1[3]); ls1+=p1[2]+p1[3];
      wq.y=cvtpk_s(p0[10],p0[11]);
      o[2]=__builtin_amdgcn_mfma_f32_32x32x16_bf16(DVF(va,2),pw[2],o[2],0,0,0);
      p1[4]=__builtin_amdgcn_exp2f(p1[4]); p1[5]=__builtin_amdgcn_exp2f(p1[5]); ls1+=p1[4]+p1[5];
      wq.z=cvtpk_s(p0[12],p0[13]);
      o[3]=__builtin_amdgcn_mfma_f32_32x32x16_bf16(DVF(va,3),pw[2],o[3],0,0,0);
      p1[6]=__builtin_amdgcn_exp2f(p1[6]); p1[7]=__builtin_amdgcn_exp2f(p1[7]); ls1+=p1[6]+p1[7];
      wq.w=cvtpk_s(p0[14],p0[15]);
      pw[1]=__builtin_bit_cast(bf16x8,wq);
      o[0]=__builtin_amdgcn_mfma_f32_32x32x16_bf16(DVF(vb,0),pw[3],o[0],0,0,0);
      p1[8]=__builtin_amdgcn_exp2f(p1[8]); p1[9]=__builtin_amdgcn_exp2f(p1[9]); ls1+=p1[8]+p1[9];
      wq.x=cvtpk_s(p1[0],p1[1]);
      o[1]=__builtin_amdgcn_mfma_f32_32x32x16_bf16(DVF(vb,1),pw[3],o[1],0,0,0);
      p1[10]=__builtin_amdgcn_exp2f(p1[10]); p1[11]=__builtin_amdgcn_exp2f(p1[11]); ls1+=p1[10]+p1[11];
      wq.y=cvtpk_s(p1[2],p1[3]);
      o[2]=__builtin_amdgcn_mfma_f32_32x32x16_bf16(DVF(vb,2),pw[3],o[2],0,0,0);
      p1[12]=__builtin_amdgcn_exp2f(p1[12]); p1[13]=__builtin_amdgcn_exp2f(p1[13]); ls1+=p1[12]+p1[13];
      wq.z=cvtpk_s(p1[4],p1[5]);
      o[3]=__builtin_amdgcn_mfma_f32_32x32x16_bf16(DVF(vb,3),pw[3],o[3],0,0,0);
      p1[14]=__builtin_amdgcn_exp2f(p1[14]); p1[15]=__builtin_amdgcn_exp2f(p1[15]); ls1+=p1[14]+p1[15];
      wq.w=cvtpk_s(p1[6],p1[7]);
      pw[2]=__builtin_bit_cast(bf16x8,wq);
      wq.x=cvtpk_s(p1[8],p1[9]); wq.y=cvtpk_s(p1[10],p1[11]); wq.z=cvtpk_s(p1[12],p1[13]); wq.w=cvtpk_s(p1[14],p1[15]); pw[3]=__builtin_bit_cast(bf16x8,wq);
      l+=ls0+ls1;
    }
  }
  if(TI>0){ const lds_cptr vpp=vp0+((t+3)&3)*VSLOT; s16x4 va[8],vb[8]; DVRDC(va,vpp,0); DVRDC(vb,vpp,1); PV_PLAIN(vpp); }
  for(;t<NT;++t){
    const int slot=t&3;
    if(t+1<NT){DWAIT_BAR(3);}else{DWAIT_BAR(0);}
    if(t+2<NT){ DDMA(t+2,(t+2)&3); }
    const lds_cptr kp=kp0+slot*KSLOT; const lds_cptr vp=vp0+slot*VSLOT;
    #pragma unroll
    for(int s=0;s<2;++s){
      const int key0=64*t+32*s;
      if(key0>qfirst+31)continue;
      f32x16 p=f32x16{};
      #pragma unroll
      for(int d0=0;d0<4;++d0){ const bf16x8 kf=*(const __attribute__((address_space(3))) bf16x8*)(kp+d0*2048+s*512); p=__builtin_amdgcn_mfma_f32_32x32x16_bf16(kf,qr[d0],p,0,0,0); }
      if(key0+31>qfirst){
        #pragma unroll
        for(int r=0;r<16;++r){ const int kv=key0+(r&3)+8*(r>>2)+4*hi; if(kv>qme)p[r]=-INFINITY; } }
      float mt=__builtin_fmaxf(p[0],p[1]);
      #pragma unroll
      for(int r=2;r<16;++r)mt=__builtin_fmaxf(mt,p[r]);
      { auto rr=__builtin_amdgcn_permlane32_swap(__float_as_uint(mt),__float_as_uint(mt),false,false); mt=__builtin_fmaxf(__uint_as_float(rr[0]),__uint_as_float(rr[1])); }
      const bool first=(t==0&&s==0);
      if(first||__any(mt>mref+8.0f)){
        const float mnew=first?mt:__builtin_fmaxf(mref,mt); const float alpha=first?1.0f:__builtin_amdgcn_exp2f(mref-mnew);
        #pragma unroll
        for(int cb=0;cb<4;++cb)o[cb]=o[cb]*alpha;
        l*=alpha; mref=mnew; }
      float ls=0.f;
      #pragma unroll
      for(int r=0;r<16;++r){ p[r]=__builtin_amdgcn_exp2f(p[r]-mref); ls+=p[r]; }
      l+=ls;
      u32x4 w0,w1; w0.x=cvtpk_s(p[0],p[1]);w0.y=cvtpk_s(p[2],p[3]);w0.z=cvtpk_s(p[4],p[5]);w0.w=cvtpk_s(p[6],p[7]);
      w1.x=cvtpk_s(p[8],p[9]);w1.y=cvtpk_s(p[10],p[11]);w1.z=cvtpk_s(p[12],p[13]);w1.w=cvtpk_s(p[14],p[15]);
      const bf16x8 pb0=__builtin_bit_cast(bf16x8,w0),pb1=__builtin_bit_cast(bf16x8,w1);
      #pragma unroll
      for(int cb=0;cb<4;++cb){
        const int off=(cb>>1)*8192+(cb&1)*4096+(2*s)*1024;
        const s16x4 a0=vtr(vp+off),a1=vtr(vp+off+512),c0=vtr(vp+off+1024),c1=vtr(vp+off+1536);
        const bf16x8 v0=(bf16x8){a0[0],a0[1],a0[2],a0[3],a1[0],a1[1],a1[2],a1[3]},v1=(bf16x8){c0[0],c0[1],c0[2],c0[3],c1[0],c1[1],c1[2],c1[3]};
        o[cb]=__builtin_amdgcn_mfma_f32_32x32x16_bf16(v0,pb0,o[cb],0,0,0);
        o[cb]=__builtin_amdgcn_mfma_f32_32x32x16_bf16(v1,pb1,o[cb],0,0,0); }
    }

  }
  { auto rr=__builtin_amdgcn_permlane32_swap(__float_as_uint(l),__float_as_uint(l),false,false); l=__uint_as_float(rr[0])+__uint_as_float(rr[1]); }
  const float inv=__builtin_amdgcn_rcpf(l);
  DWAIT_BAR(0);
  const lds_ptr stg=(lds_ptr)shm+wid*OST_WAVE;
  #pragma unroll
  for(int cb=0;cb<4;++cb)
    #pragma unroll
    for(int g=0;g<4;++g){ u32x2 w; w.x=cvtpk_s(o[cb][4*g]*inv,o[cb][4*g+1]*inv); w.y=cvtpk_s(o[cb][4*g+2]*inv,o[cb][4*g+3]*inv);
      *(__attribute__((address_space(3))) u32x2*)(stg+r32*OST_ROW+(32*cb+8*g+4*hi)*2)=w; }
  asm volatile("s_waitcnt lgkmcnt(0)":::"memory");
  bf16*Ow=O+(rowbase+q0+wid*32)*(long)opitch;
  #pragma unroll
  for(int i=0;i<8;++i){ const int row=i*4+(lane>>4),ch=lane&15; const u32x4 v=*(const __attribute__((address_space(3))) u32x4*)(stg+row*OST_ROW+ch*16); *(u32x4*)(Ow+(long)row*opitch+ch*8)=v; }
  asm volatile("s_waitcnt lgkmcnt(0)\n\ts_barrier":::"memory");
  #undef DDMA
  #undef SBARR
  #undef DVRD
  #undef DVF
  #undef DPV
  #undef PV_PLAIN
  #undef DVRDC
  #undef DPVC
  #undef EXPS_PLAIN
}
struct DiffUnit { int bh; int qb; int m; };
struct DiffOrder {
  int vcu, G;
  __device__ __forceinline__ DiffOrder(int vcu_,int G_):vcu(vcu_),G(G_){}
  __device__ __forceinline__ bool next(int i,DiffUnit&u)const{
    const int ii=i>>1; u.m=i&1;
    if(G==256){ if(i>=4)return false; const int s=vcu&15; u.bh=vcu>>4; u.qb=ii?31-s:s; return true; }
    const int un=vcu+ii*G; if(un>=512)return false; u.bh=un>>5; u.qb=un&31; return true; }
};
__device__ __forceinline__ void diff_phase(char*shm,const unsigned short*PROJ,unsigned short*OA,const DiffOrder&S){
  DiffUnit u;
  for(int i=0;S.next(i,u);++i){
    const int h=u.bh&7;
    const bf16*Qp=(const bf16*)PROJ+h*128+u.m*64;
    unit(u.bh>>3,u.qb,Qp,Qp+1024,(const bf16*)PROJ+2048+h*128,u.m?((bf16*)PROJ+h*128):((bf16*)OA+h*128),u.m?DM:1024,shm);
  }
}
__device__ __forceinline__ float bflo(unsigned w){return __builtin_bit_cast(float,w<<16);}
__device__ __forceinline__ float bfhi(unsigned w){return __builtin_bit_cast(float,w&0xffff0000u);}
__device__ __forceinline__ void diff_combine(const unsigned short*PROJ,unsigned short*OA,const DiffOrder&S,float lam){
  asm volatile("s_waitcnt vmcnt(0)":::"memory");
  int tid_=threadIdx.x; asm volatile("":"+v"(tid_));
  const int lane=tid_&63; const int wid=__builtin_amdgcn_readfirstlane(tid_>>6); const int c8=(lane&7)*8;
  DiffUnit u;
  for(int i=0;S.next(i,u);i+=2){
    const int h=u.bh&7; const long row0=(long)(u.bh>>3)*SEQ+u.qb*QB+wid*32+(lane>>3);
    #pragma unroll 1
    for(int it=0;it<4;++it){
      unsigned short*ma=OA+(row0+it*8)*1024+h*128+c8; const unsigned short*pb=PROJ+(row0+it*8)*DM+h*128+c8;
      const u32x4 a0=*(const u32x4*)ma,a1=*(const u32x4*)(ma+64),b0=*(const u32x4*)pb,b1=*(const u32x4*)(pb+64);
      float o0[8],o1[8]; float ss=0.f;
      #pragma unroll
      for(int k=0;k<4;++k){ o0[2*k]=bflo(a0[k])-lam*bflo(b0[k]); o0[2*k+1]=bfhi(a0[k])-lam*bfhi(b0[k]); o1[2*k]=bflo(a1[k])-lam*bflo(b1[k]); o1[2*k+1]=bfhi(a1[k])-lam*bfhi(b1[k]); }
      #pragma unroll
      for(int k=0;k<8;++k)ss+=o0[k]*o0[k]+o1[k]*o1[k];
      ss+=__shfl_xor(ss,1); ss+=__shfl_xor(ss,2); ss+=__shfl_xor(ss,4);
      const float rs=__builtin_amdgcn_rsqf(ss*(1.0f/128.0f)+1e-6f);
      u32x4 w0,w1;
      #pragma unroll
      for(int k=0;k<4;++k){ w0[k]=cvtpk_s(o0[2*k]*rs,o0[2*k+1]*rs); w1[k]=cvtpk_s(o1[2*k]*rs,o1[2*k+1]*rs); }
      *(u32x4*)ma=w0; *(u32x4*)(ma+64)=w1;
    }
  }
}
#undef DWAIT_BAR
}
#include <hip/hip_cooperative_groups.h>
namespace cg = cooperative_groups;
constexpr int NWAVES = 8;
constexpr int SEQ = 8192, DMOD = 1024, MTOK = 2 * SEQ, FF = 4096;
constexpr int P0W = 2560;
constexpr int P1W = 3072;
constexpr float QSCALE = 0.125f * 1.4426950408889634f;
constexpr float LAMBDA_INIT1 = 0.35550906f;
constexpr size_t MiB = 1u << 20;
constexpr size_t WS_CTL = 0, CTL_ZERO_BYTES = 1 * MiB;
constexpr size_t WS_SSQ = 65536;
constexpr size_t WS_W = 2 * MiB;
constexpr size_t W_IN = 0, W_OUT = 6 * MiB, W_UP = 8 * MiB, W_DOWN = 16 * MiB, W_LAYER = 24 * MiB;
constexpr size_t WS_XB = 50 * MiB;
constexpr size_t WS_PROJ = 82 * MiB;
constexpr size_t WS_VT = WS_PROJ + 80 * MiB;
constexpr size_t WS_MIX = 178 * MiB;
constexpr size_t WS_H = WS_PROJ;
constexpr size_t WS_END = 210 * MiB;
constexpr int RING_BYTES = 131072, LDS_BYTES = 147456;

#define GAS __attribute__((address_space(1)))
#define LAS __attribute__((address_space(3)))
typedef unsigned short bf16;
typedef unsigned v4u __attribute__((ext_vector_type(4)));
typedef float f32x4 __attribute__((ext_vector_type(4)));
typedef short bf16x8 __attribute__((ext_vector_type(8)));
typedef float f32x16 __attribute__((ext_vector_type(16)));
#define LDS_WAIT() asm volatile("s_waitcnt lgkmcnt(0)" ::: "memory")
__device__ __forceinline__ unsigned f2bf(float f) { unsigned u = __builtin_bit_cast(unsigned, f); return (u + 0x7fffu + ((u >> 16) & 1u)) >> 16; }
__device__ __forceinline__ unsigned pk2(float lo, float hi) { return f2bf(lo) | (f2bf(hi) << 16); }
__device__ __forceinline__ float bf_lo(unsigned w) { return __builtin_bit_cast(float, w << 16); }
__device__ __forceinline__ float bf_hi(unsigned w) { return __builtin_bit_cast(float, w & 0xffff0000u); }
__device__ __forceinline__ float wave_sum(float v) {
#pragma unroll
    for (int o = 1; o < 64; o <<= 1) v += __shfl_xor(v, o);
    return v;
}
__device__ __forceinline__ void x_rows2_to_bf16(const float* xrow, bf16* orow, float* ssq, int lane) {
    const GAS f32x4* xr = (const GAS f32x4*)xrow + lane;
    f32x4 v[8]; float s0 = 0.f, s1 = 0.f;
#pragma unroll
    for (int j = 0; j < 8; ++j) v[j] = __builtin_nontemporal_load(xr + 64 * j);
#pragma unroll
    for (int j = 0; j < 4; ++j) { s0 += (v[j].x * v[j].x + v[j].y * v[j].y) + (v[j].z * v[j].z + v[j].w * v[j].w); s1 += (v[4 + j].x * v[4 + j].x + v[4 + j].y * v[4 + j].y) + (v[4 + j].z * v[4 + j].z + v[4 + j].w * v[4 + j].w); }
    s0 = wave_sum(s0); s1 = wave_sum(s1); if (lane == 0) { ssq[0] = s0; ssq[1] = s1; }
    GAS unsigned long long* o8 = (GAS unsigned long long*)orow + lane;
#pragma unroll
    for (int j = 0; j < 8; ++j) o8[64 * j] = (unsigned long long)pk2(v[j].x, v[j].y) | ((unsigned long long)pk2(v[j].z, v[j].w) << 32);
}

__device__ __forceinline__ int swap23(int i) { return (i & ~12) | ((i & 4) << 1) | ((i & 8) >> 1); }
__device__ __forceinline__ unsigned cvtpk2(float lo, float hi) { typedef float f2 __attribute__((ext_vector_type(2))); typedef __bf16 b2 __attribute__((ext_vector_type(2))); f2 v = {lo, hi}; b2 b = __builtin_convertvector(v, b2); return __builtin_bit_cast(unsigned, b); }
__device__ __forceinline__ void sb_unit(int b, int h, int qb, const bf16* __restrict__ proj, const bf16* __restrict__ Vt, bf16* __restrict__ mix, LAS unsigned char* stage, int lane) {
    const int r32 = lane & 31, hi = lane >> 5;
    const size_t rowbase = (size_t)b * SEQ; const int t0 = qb * 32;
    const bf16* qp = proj + (rowbase + t0 + r32) * P0W + h * 64 + hi * 8;
    bf16x8 qr[4];
#pragma unroll
    for (int d0 = 0; d0 < 4; ++d0) qr[d0] = *(const bf16x8*)(qp + d0 * 16);
    const bf16* kbase = proj + (rowbase + swap23(r32)) * P0W + 512 + h * 64 + hi * 8;
    const bf16* vbase = Vt + (size_t)(h * 64 + r32) * MTOK + rowbase + hi * 8;
    f32x16 o0 = {}, o1 = {};
    float R = 0.f;
#define SB_LOAD(KF, VF, kt_) do { const bf16* kp = kbase + (size_t)(kt_) * 32 * P0W; const bf16* vp = vbase + (kt_) * 32; \
        _Pragma("unroll") for (int d0 = 0; d0 < 4; ++d0) KF[d0] = *(const bf16x8*)(kp + d0 * 16); \
        VF[0] = *(const bf16x8*)(vp); VF[1] = *(const bf16x8*)(vp + 16); VF[2] = *(const bf16x8*)(vp + (size_t)32 * MTOK); VF[3] = *(const bf16x8*)(vp + (size_t)32 * MTOK + 16); } while (0)
#define SB_COMPUTE(KF, VF, kt_) do { \
        f32x16 p = {}; \
        _Pragma("unroll") for (int d0 = 0; d0 < 4; ++d0) p = __builtin_amdgcn_mfma_f32_32x32x16_bf16(KF[d0], qr[d0], p, 0, 0, 0); \
        const bool diag = ((kt_) == qb); \
        float sp[16], lb[16]; \
        _Pragma("unroll") for (int r = 0; r < 16; ++r) { const float z = p[r]; const float e = __builtin_amdgcn_exp2f(-__builtin_fabsf(z)); const float l = __builtin_amdgcn_logf(1.0f + e); \
            sp[r] = __builtin_fmaxf(z, 0.f) + l; lb[r] = __builtin_fminf(z, 0.f) - l; \
            if (diag) { const int koff = (r & 7) + 8 * hi + 16 * (r >> 3); if (koff >= r32) { sp[r] = 0.f; lb[r] = -INFINITY; } } } \
        float ex[16], G0, G1; \
        { float run = 0.f; \
          _Pragma("unroll") for (int j = 7; j >= 0; --j) { ex[j] = run; run += sp[j]; } G0 = run; run = 0.f; \
          _Pragma("unroll") for (int j = 7; j >= 0; --j) { ex[8 + j] = run; run += sp[8 + j]; } G1 = run; } \
        const float Gp0 = __shfl_xor(G0, 32), Gp1 = __shfl_xor(G1, 32); \
        const float base1 = R + (hi ? 0.f : Gp1), base0 = R + G1 + Gp1 + (hi ? 0.f : Gp0); \
        float w[16]; \
        _Pragma("unroll") for (int r = 0; r < 16; ++r) w[r] = __builtin_amdgcn_exp2f(lb[r] - ((r < 8) ? base0 : base1) - ex[r]); \
        R += (G0 + G1) + (Gp0 + Gp1); \
        v4u a0, a1; a0.x = cvtpk2(w[0], w[1]); a0.y = cvtpk2(w[2], w[3]); a0.z = cvtpk2(w[4], w[5]); a0.w = cvtpk2(w[6], w[7]); \
        a1.x = cvtpk2(w[8], w[9]); a1.y = cvtpk2(w[10], w[11]); a1.z = cvtpk2(w[12], w[13]); a1.w = cvtpk2(w[14], w[15]); \
        const bf16x8 pa0 = __builtin_bit_cast(bf16x8, a0), pa1 = __builtin_bit_cast(bf16x8, a1); \
        o0 = __builtin_amdgcn_mfma_f32_32x32x16_bf16(pa0, VF[0], o0, 0, 0, 0); o0 = __builtin_amdgcn_mfma_f32_32x32x16_bf16(pa1, VF[1], o0, 0, 0, 0); \
        o1 = __builtin_amdgcn_mfma_f32_32x32x16_bf16(pa0, VF[2], o1, 0, 0, 0); o1 = __builtin_amdgcn_mfma_f32_32x32x16_bf16(pa1, VF[3], o1, 0, 0, 0); \
        done = __all(R > 151.0f) != 0; } while (0)
    bf16x8 kA[4], vA[4], kB[4], vB[4];
    SB_LOAD(kA, vA, qb);
#pragma unroll
    for (int d0 = 0; d0 < 4; ++d0) { kB[d0] = kA[d0]; vB[d0] = vA[d0]; }
    if (qb > 0) SB_LOAD(kB, vB, qb - 1);
    bool done = false;
    for (int kt = qb;; kt -= 2) {
        SB_COMPUTE(kA, vA, kt);
        if (done || kt < 1) break;
        if (kt >= 2) SB_LOAD(kA, vA, kt - 2);
        SB_COMPUTE(kB, vB, kt - 1);
        if (done || kt < 2) break;
        if (kt >= 3) SB_LOAD(kB, vB, kt - 3);
    }
#undef SB_LOAD
#undef SB_COMPUTE
    LAS bf16* stg = (LAS bf16*)stage;
#pragma unroll
    for (int r = 0; r < 16; ++r) { const int orow = (r & 3) + 8 * (r >> 2) + 4 * hi; stg[orow * 64 + r32] = (bf16)f2bf(o0[r]); stg[orow * 64 + 32 + r32] = (bf16)f2bf(o1[r]); }
    LDS_WAIT(); asm volatile("" ::: "memory");
    bf16* op = mix + (rowbase + t0) * 1024 + h * 64;
#pragma unroll
    for (int i = 0; i < 4; ++i) { const int row = i * 8 + (lane >> 3), ch = lane & 7; const v4u v = *(const LAS v4u*)(stg + row * 64 + ch * 8); *(v4u*)(op + (size_t)row * 1024 + ch * 8) = v; }
    LDS_WAIT(); asm volatile("" ::: "memory");
}
__device__ __forceinline__ void conv_items(const bf16* __restrict__ proj, const float* __restrict__ cw, bf16* __restrict__ mix, int gtid, int nthreads) {
    for (int it = gtid; it < (MTOK / 8) * 64; it += nthreads) {
        const int rb = it >> 6, ch = (it & 63) * 8, m0 = rb * 8;
        float w0[8], w1[8], w2[8], c2[8], c1[8];
#pragma unroll
        for (int i = 0; i < 8; ++i) { w0[i] = cw[ch + i]; w1[i] = cw[512 + ch + i]; w2[i] = cw[1024 + ch + i]; c2[i] = 0.f; c1[i] = 0.f; }
        if ((m0 & (SEQ - 1)) != 0) {
            const v4u Ca = *(const v4u*)(proj + (size_t)(m0 - 2) * P0W + 1536 + ch), Ua = *(const v4u*)(proj + (size_t)(m0 - 2) * P0W + 2048 + ch);
            const v4u Cb = *(const v4u*)(proj + (size_t)(m0 - 1) * P0W + 1536 + ch), Ub = *(const v4u*)(proj + (size_t)(m0 - 1) * P0W + 2048 + ch);
#pragma unroll
            for (int i = 0; i < 4; ++i) { c2[2 * i] = bf_lo(Ca[i]) * bf_lo(Ua[i]); c2[2 * i + 1] = bf_hi(Ca[i]) * bf_hi(Ua[i]); c1[2 * i] = bf_lo(Cb[i]) * bf_lo(Ub[i]); c1[2 * i + 1] = bf_hi(Cb[i]) * bf_hi(Ub[i]); }
        }
#pragma unroll
        for (int r = 0; r < 8; ++r) { const bf16* rp = proj + (size_t)(m0 + r) * P0W + ch;
            const v4u Bv = __builtin_nontemporal_load((const v4u*)(rp + 1024)), Cv = __builtin_nontemporal_load((const v4u*)(rp + 1536)), Uv = __builtin_nontemporal_load((const v4u*)(rp + 2048));
            float c0[8], y[8];
#pragma unroll
            for (int i = 0; i < 4; ++i) { c0[2 * i] = bf_lo(Cv[i]) * bf_lo(Uv[i]); c0[2 * i + 1] = bf_hi(Cv[i]) * bf_hi(Uv[i]); }
#pragma unroll
            for (int i = 0; i < 8; ++i) y[i] = w0[i] * c2[i] + w1[i] * c1[i] + w2[i] * c0[i];
            v4u o;
#pragma unroll
            for (int i = 0; i < 4; ++i) o[i] = pk2(bf_lo(Bv[i]) * y[2 * i], bf_hi(Bv[i]) * y[2 * i + 1]);
            *(v4u*)(mix + (size_t)(m0 + r) * 1024 + 512 + ch) = o;
#pragma unroll
            for (int i = 0; i < 8; ++i) { c2[i] = c1[i]; c1[i] = c0[i]; } }
    }
}

typedef GAS unsigned gu32;
#define RLX_AGENT __ATOMIC_RELAXED, __HIP_MEMORY_SCOPE_AGENT
constexpr int CW_PANEL = 8192;
constexpr int CW_BAR = 4096;
constexpr int LDSCTL_OFF = RING_BYTES, MISC_OFF = LDSCTL_OFF + 320;
#define XB_TMO      128
#define XB_XCNT(j)  (256  + 64 * (j))
#define XB_XSUB(j)  (1280 + 64 * (j))
#define XB_XGEN(j)  (2304 + 64 * (j))
#define XB_TOP      3328
#define XB_TOPGEN   3392
#define XCD_BAR_WORDS 3456
#define XB_SPIN_CAP (1u << 18)

__device__ __forceinline__ unsigned xb_ld(unsigned* p)              { return __hip_atomic_load(p, __ATOMIC_RELAXED, __HIP_MEMORY_SCOPE_AGENT); }
__device__ __forceinline__ unsigned xb_add(unsigned* p, unsigned v) { return __hip_atomic_fetch_add(p, v, __ATOMIC_RELAXED, __HIP_MEMORY_SCOPE_AGENT); }
__device__ __forceinline__ unsigned xb_xcc_id() { return (unsigned)__builtin_amdgcn_s_getreg((3 << 11) | 20) & 0xFu; }
#define XB_SPIN(cond, bar) do { unsigned _sp = 0; while (cond) { __builtin_amdgcn_s_sleep(1); \
    if ((++_sp & 255u) == 0u) { if (xb_ld(&(bar)[XB_TMO])) break; if (_sp > XB_SPIN_CAP) { atomicAdd(&(bar)[XB_TMO], 1u); break; } } } } while (0)

struct XcdBarrier {
    unsigned* bar; unsigned x;
    volatile LAS unsigned* st;
};

__device__ __forceinline__ XcdBarrier xcd_barrier_post(unsigned* bar, volatile LAS unsigned* st) {
    XcdBarrier b; b.bar = bar; b.x = xb_xcc_id(); b.st = st;
    if (threadIdx.x == 0) (void)xb_add(&bar[XB_XCNT(b.x)], 1u);
    return b;
}
__device__ __forceinline__ void xcd_barrier_complete(unsigned* bar, unsigned x, unsigned& nloc, unsigned& nx) {
    const unsigned G = gridDim.x * gridDim.y * gridDim.z;
    unsigned sum, cnt, mine, sp = 0u;
    for (;;) {
        sum = 0u; cnt = 0u; mine = 0u;
#pragma unroll
        for (unsigned j = 0; j < 16; ++j) { const unsigned c = xb_ld(&bar[XB_XCNT(j)]); sum += c; cnt += (c > 0u) ? 1u : 0u; mine = (j == x) ? c : mine; }
        if (sum == G) break;
        __builtin_amdgcn_s_sleep(1);
        if ((++sp & 255u) == 0u) { if (xb_ld(&bar[XB_TMO])) break; if (sp > XB_SPIN_CAP) { atomicAdd(&bar[XB_TMO], 1u); break; } }
    }
    nloc = mine > 0u ? mine : 1u; nx = cnt > 0u ? cnt : 1u;
}

__device__ __forceinline__ void xcd_barrier_thread0(const XcdBarrier& b) {
    {
        unsigned* bar = b.bar;
        __builtin_amdgcn_s_waitcnt(0);
        unsigned nloc = b.st[0], nx = b.st[1];
        if (nloc == 0u) { xcd_barrier_complete(bar, b.x, nloc, nx); b.st[0] = nloc; b.st[1] = nx; }
        const unsigned old = xb_add(&bar[XB_XSUB(b.x)], 1u);
        const unsigned gen = old / nloc;
        if (old + 1u == (gen + 1u) * nloc) {
            __builtin_amdgcn_fence(__ATOMIC_RELEASE, "agent");
            asm volatile("s_waitcnt vmcnt(0)" ::: "memory");
            const unsigned og = xb_add(&bar[XB_TOP], 1u);
            const unsigned tg = og / nx;
            if (og + 1u == (tg + 1u) * nx) xb_add(&bar[XB_TOPGEN], 1u);
            else XB_SPIN(xb_ld(&bar[XB_TOPGEN]) == tg, bar);
            __builtin_amdgcn_fence(__ATOMIC_ACQUIRE, "agent");
            xb_add(&bar[XB_XGEN(b.x)], 1u);
            asm volatile("s_waitcnt vmcnt(0)" ::: "memory");
        } else {
            XB_SPIN(xb_ld(&bar[XB_XGEN(b.x)]) == gen, bar);
            __builtin_amdgcn_fence(__ATOMIC_ACQUIRE, "agent");
            asm volatile("s_waitcnt vmcnt(0)" ::: "memory");
        }
    }
}
__device__ __forceinline__ void xcd_barrier(const XcdBarrier& b) {
    asm volatile("s_waitcnt vmcnt(0)" ::: "memory");
    __syncthreads();
    if (threadIdx.x == 0) xcd_barrier_thread0(b);
    __syncthreads();
}
#define LAYER_TAIL(layer) \
        { PHASE_IDS pg8::Gemm g{MIXp, WLp(layer, W_OUT), MTOK, 1024, 1024}; pg8::StaticOrder S; S.init(MTOK, 1024, G, bx); \
          pg8::EpiRes E{layer ? (const float*)XRES : XIN, XRES, XBp, SSQ(2 * layer + 1)}; \
          pg8::gemm_phase<pg8::EpiRes, pg8::StaticOrder, PG8_ALIGN, PG8_SP2>(ldsp, g, S, E); } \
        if (layer == 0) xcd_barrier_work(bar, args, WSLICE(3), ldsp); else xcd_barrier(bar); \
        { PHASE_IDS pg8::Gemm g{XBp, WLp(layer, W_UP), MTOK, FF, 1024}; pg8::StaticOrder S; S.init(MTOK, FF, G, bx); \
          pg8::EpiRow<1> E{HBp, FF, SSQ(2 * layer + 1), 0, 1.f}; \
          pg8::gemm_phase<pg8::EpiRow<1>, pg8::StaticOrder, PG8_ALIGN, PG8_SP2>(ldsp, g, S, E); } \
        if (layer == 0) xcd_barrier_work(bar, args, WSLICE(4), ldsp); else xcd_barrier(bar); \
        if (layer == 1 && gridDim.x == 256) {     \
          PHASE_IDS pg8::Gemm g{HBp, WLp(layer, W_DOWN), MTOK, 1024, FF}; pg8::StaticOrder S; S.init(MTOK, 1024, G, bx); \
          pg8::EpiResFinal E{XRES, XRES, SSQ(4), (unsigned*)(args.ws + WS_CTL) + CW_PANEL, args.in[3]}; \
          pg8::gemm_phase<pg8::EpiResFinal, pg8::StaticOrder, false, PG8_SP2>(ldsp, g, S, E); \
        } else { \
        { PHASE_IDS pg8::Gemm g{HBp, WLp(layer, W_DOWN), MTOK, 1024, FF}; pg8::StaticOrder S; S.init(MTOK, 1024, G, bx); \
          pg8::EpiRes E{XRES, XRES, XBp, SSQ(2 * layer + 2)}; \
          pg8::gemm_phase<pg8::EpiRes, pg8::StaticOrder, PG8_ALIGN, PG8_SP2>(ldsp, g, S, E); } \
        if (layer == 0) xcd_barrier_work(bar, args, WSLICE(5), ldsp); else xcd_barrier(bar); }
constexpr int I_IN = 16 * 96, I_OUT = 16 * 32, I_UP = 16 * 128, I_DN = 64 * 32, I_L = I_IN + I_OUT + I_UP + I_DN;
struct Args { const float* in[16]; float* out; unsigned char* ws; };
struct CvtItem { const float* wp; bf16* op; int N, K; f32x4 g0, g1; };
__device__ __forceinline__ void cvt_decode(const Args& args, int it, int lane, CvtItem& d) {
    const int l = it / I_L; int r = it % I_L;
    const float* W; bf16* WT; int K = 1024, N; const float* gs = nullptr; int gmask = 1023; float gmul = 1.f; bool remap = false;
    if (r < I_IN) { W = l ? args.in[7] : args.in[4]; N = 3072; WT = (bf16*)(args.ws + WS_W + (size_t)l * W_LAYER + W_IN); gs = args.in[1] + l * 1024; remap = (l == 0); }
    else if ((r -= I_IN) < I_OUT) { W = l ? args.in[13] : args.in[6]; N = 1024; WT = (bf16*)(args.ws + WS_W + (size_t)l * W_LAYER + W_OUT); gs = l ? args.in[12] : nullptr; gmask = 127; gmul = 1.0f - LAMBDA_INIT1; }
    else if ((r -= I_OUT) < I_UP) { W = args.in[14] + (size_t)l * 1024 * 4096; N = 4096; WT = (bf16*)(args.ws + WS_W + (size_t)l * W_LAYER + W_UP); gs = args.in[2] + l * 1024; }
    else { r -= I_UP; W = args.in[15] + (size_t)l * 4096 * 1024; K = 4096; N = 1024; WT = (bf16*)(args.ws + WS_W + (size_t)l * W_LAYER + W_DOWN); }
    const int nblk = N / 32, kb = r / nblk, nb = r % nblk, k0 = 64 * kb, n0 = 32 * nb, c = lane & 7;
    int r0 = n0; if (remap) r0 = n0 < 1024 ? n0 : (n0 < 1536 ? n0 + 1536 : n0 - 512);
    d.N = N; d.K = K; d.wp = W + (size_t)(k0 + (lane >> 3)) * N + n0 + 4 * c; d.op = WT + (size_t)(r0 + (lane >> 3)) * K + k0 + 8 * c;
    d.g0 = (f32x4){1.f, 1.f, 1.f, 1.f}; d.g1 = d.g0;
    if (gs) { const float* gp = gs + ((k0 + 8 * c) & gmask); d.g0 = *(const f32x4*)gp * gmul; d.g1 = *(const f32x4*)(gp + 4) * gmul; }
}
__device__ __forceinline__ void cvt_load(const CvtItem& d, f32x4 (&v)[8]) {
#pragma unroll
    for (int i = 0; i < 8; ++i) v[i] = __builtin_nontemporal_load((const f32x4*)(d.wp + (size_t)(8 * i) * d.N));
}
__device__ __forceinline__ void cvt_lds_write(const f32x4 (&v)[8], LAS float* scr, int lane) {
    const int c = lane & 7;
#pragma unroll
    for (int i = 0; i < 8; ++i) { LAS float* p = scr + (8 * i + (lane >> 3)) * 33 + 4 * c; p[0] = v[i][0]; p[1] = v[i][1]; p[2] = v[i][2]; p[3] = v[i][3]; }
    LDS_WAIT(); asm volatile("" ::: "memory");
}
__device__ __forceinline__ void cvt_lds_read_store(const CvtItem& d, LAS float* scr, int lane) {
    const int c = lane & 7;
#pragma unroll
    for (int j = 0; j < 4; ++j) { const LAS float* s = scr + (8 * c) * 33 + (lane >> 3) + 8 * j;
        v4u o; o.x = pk2(s[0 * 33] * d.g0[0], s[1 * 33] * d.g0[1]); o.y = pk2(s[2 * 33] * d.g0[2], s[3 * 33] * d.g0[3]); o.z = pk2(s[4 * 33] * d.g1[0], s[5 * 33] * d.g1[1]); o.w = pk2(s[6 * 33] * d.g1[2], s[7 * 33] * d.g1[3]);
        *(GAS v4u*)(d.op + (size_t)(8 * j) * d.K) = o; }
    LDS_WAIT(); asm volatile("" ::: "memory");
}
__device__ __forceinline__ void convert_items(const Args& args, int lo, int hi, int gw, int NGW, int lane, LAS float* scr) {
    int it = lo + gw; if (it >= hi) return;
    CvtItem A, B, C; f32x4 va[8], vb[8];
    cvt_decode(args, it, lane, A); cvt_load(A, va);
    bool hb = (it + NGW) < hi; B = A;
#pragma unroll
    for (int i = 0; i < 8; ++i) vb[i] = va[i];
    if (hb) { cvt_decode(args, it + NGW, lane, B); cvt_load(B, vb); }
    for (;;) {
        cvt_lds_write(va, scr, lane);
        const bool hc = (it + 2 * NGW) < hi; C = A;
        if (hc) { cvt_decode(args, it + 2 * NGW, lane, C); cvt_load(C, va); }
        cvt_lds_read_store(A, scr, lane);
        if (!hb) break;
        cvt_lds_write(vb, scr, lane);
        const bool hd = (it + 3 * NGW) < hi; A = B;
        CvtItem D = B;
        if (hd) { cvt_decode(args, it + 3 * NGW, lane, D); cvt_load(D, vb); }
        cvt_lds_read_store(A, scr, lane);
        if (!hc) break;
        A = C; B = D; hb = hd; it += 2 * NGW;
    }
}
#define CONVERT_ITEMS(lo, hi) convert_items(args, (lo), (hi), gw, NGW, lane, scr);
__device__ __forceinline__ void xcd_barrier_work(const XcdBarrier& b, const Args& args, int lo, int hi, LAS unsigned char* ldsp) {
    asm volatile("s_waitcnt vmcnt(0)" ::: "memory");
    __syncthreads();
    int tid = threadIdx.x; asm volatile("" : "+v"(tid));
    const int wave = __builtin_amdgcn_readfirstlane(tid >> 6);
    if (wave == 0) { if (tid == 0) xcd_barrier_thread0(b); }
    else { int G = gridDim.x, bx = blockIdx.x; asm volatile("" : "+s"(G), "+s"(bx)); const int vcu = (G % 8 == 0) ? (bx % 8) * (G / 8) + bx / 8 : bx;
           convert_items(args, lo, hi, vcu * 7 + (wave - 1), G * 7, tid & 63, (LAS float*)(ldsp + wave * 16384)); }
    __syncthreads();
}
constexpr int I_W = (2 * I_L - I_IN) / 6;
#define WSLICE(k) (I_IN + (k) * I_W), (I_IN + ((k) + 1) * I_W)
static_assert((2 * I_L - I_IN) % 6 == 0 && I_IN + 1 * I_W >= I_IN + I_OUT && I_IN + 2 * I_W >= I_IN + I_OUT + I_UP && I_IN + 3 * I_W >= I_L && I_IN + 4 * I_W >= I_L + I_IN + I_OUT, "slice k is published by barrier k+1: out0 by 1, up0 by 2, down0 by 3, in1 by 4, out1 by 6, up1 by 7, down1 by 8");

__global__ void __launch_bounds__(NWAVES * 64, 2) mega_fwd(Args args) {
    extern __shared__ __attribute__((aligned(16))) unsigned char lds[];
    cg::grid_group grid = cg::this_grid();
    LAS unsigned char* ldsp = (LAS unsigned char*)lds;
    for (int u = threadIdx.x; u < (LDS_BYTES - LDSCTL_OFF) / 4; u += NWAVES * 64) ((LAS unsigned*)(ldsp + LDSCTL_OFF))[u] = 0u;
    __syncthreads();
    const XcdBarrier bar = xcd_barrier_post((unsigned*)(args.ws + WS_CTL) + CW_BAR, (volatile LAS unsigned*)(ldsp + MISC_OFF) + 8);
#define PHASE_IDS int tid = threadIdx.x; asm volatile("" : "+v"(tid)); const int lane = tid & 63, wave = __builtin_amdgcn_readfirstlane(tid >> 6); \
    int G = gridDim.x, bx = blockIdx.x; asm volatile("" : "+s"(G), "+s"(bx)); const int vcu = (G % 8 == 0) ? (bx % 8) * (G / 8) + bx / 8 : bx; \
    const int gw = vcu * NWAVES + wave, NGW = G * NWAVES; (void)lane; (void)gw; (void)NGW; (void)tid;
#define XIN   (args.in[0])
#define XRES  (args.out)
#define SSQ(i) ((float*)(args.ws + WS_SSQ) + (size_t)(i) * MTOK)
#define XBp   ((bf16*)(args.ws + WS_XB))
#define PROJp ((bf16*)(args.ws + WS_PROJ))
#define VTp   ((bf16*)(args.ws + WS_VT))
#define MIXp  ((bf16*)(args.ws + WS_MIX))
#define HBp   ((bf16*)(args.ws + WS_H))
#define WLp(l, off) ((bf16*)(args.ws + WS_W + (size_t)(l) * W_LAYER + (off)))

    {
        PHASE_IDS
        LAS float* scr = (LAS float*)(ldsp + wave * 16384);
        CONVERT_ITEMS(0, I_IN)
        for (int m = 2 * gw; m < MTOK; m += 2 * NGW) x_rows2_to_bf16(XIN + (size_t)m * 1024, XBp + (size_t)m * 1024, SSQ(0) + m, lane);
    }
    if (args.ws == nullptr) grid.sync();
    xcd_barrier_work(bar, args, WSLICE(0), ldsp);

    {
        { PHASE_IDS pg8::Gemm g{XBp, WLp(0, W_IN), MTOK, P0W, 1024}; pg8::StaticOrder S; S.init(MTOK, P0W, G, bx);
          pg8::EpiRow<0> E{PROJp, P0W, SSQ(0), 2, QSCALE};
          pg8::gemm_phase<pg8::EpiRow<0>, pg8::StaticOrder, PG8_ALIGN, PG8_SP2>(ldsp, g, S, E); }
        { PHASE_IDS pg8::Gemm g{WLp(0, W_IN) + (size_t)P0W * 1024, XBp, 512, MTOK, 1024}; pg8::StaticOrder S; S.init(512, MTOK, G, (bx + G / 2) % G);
          pg8::EpiColScale E{VTp, MTOK, SSQ(0)};
          pg8::gemm_phase<pg8::EpiColScale, pg8::StaticOrder, PG8_ALIGN, PG8_SP2>(ldsp, g, S, E); }
        xcd_barrier_work(bar, args, WSLICE(1), ldsp);
        { PHASE_IDS
          conv_items(PROJp, args.in[5], MIXp, vcu * (NWAVES * 64) + tid, G * NWAVES * 64);
          LAS float* scr = (LAS float*)(ldsp + wave * 16384);
          for (int u = gw; u < 2 * 8 * 256; u += NGW) sb_unit(u >> 11, (u >> 8) & 7, u & 255, PROJp, VTp, MIXp, ldsp + wave * 16384 + 8704, lane);
          (void)scr; }
        xcd_barrier_work(bar, args, WSLICE(2), ldsp);
        LAYER_TAIL(0)
    }
    {
        { PHASE_IDS pg8::Gemm g{XBp, WLp(1, W_IN), MTOK, P1W, 1024}; pg8::StaticOrder S; S.init(MTOK, P1W, G, bx);
          pg8::EpiRow<0> E{PROJp, P1W, SSQ(2), 4, QSCALE};
          pg8::gemm_phase<pg8::EpiRow<0>, pg8::StaticOrder, PG8_ALIGN, PG8_SP2>(ldsp, g, S, E); }
        xcd_barrier(bar);
        { PHASE_IDS const dattn::DiffOrder S(vcu, G); dattn::diff_phase((char*)lds, PROJp, MIXp, S); }
        { PHASE_IDS float lam;
          { const float a = wave_sum(args.in[8][lane] * args.in[9][lane]), c = wave_sum(args.in[10][lane] * args.in[11][lane]); lam = __expf(a) - __expf(c) + LAMBDA_INIT1; }
          const dattn::DiffOrder S(vcu, G); dattn::diff_combine(PROJp, MIXp, S, lam); }
        xcd_barrier(bar);
        LAYER_TAIL(1)
    }
    if (gridDim.x != 256) { PHASE_IDS const float* ssq_f = SSQ(4);
      f32x4 gv[4];
#pragma unroll
      for (int j = 0; j < 4; ++j) gv[j] = ((const f32x4*)args.in[3])[lane + 64 * j];
      for (int m = 2 * gw; m < MTOK; m += 2 * NGW) { const float rs0 = pg8::rstd_of(ssq_f[m]), rs1 = pg8::rstd_of(ssq_f[m + 1]); f32x4* xr = (f32x4*)(XRES + (size_t)m * 1024) + lane;
          f32x4 v[8];
#pragma unroll
          for (int j = 0; j < 8; ++j) v[j] = xr[64 * j];
#pragma unroll
          for (int j = 0; j < 4; ++j) { xr[64 * j] = v[j] * rs0 * gv[j]; xr[256 + 64 * j] = v[4 + j] * rs1 * gv[j]; } } }
}

extern "C" void kernel_launch(void* const* d_in, const int* in_sizes, int n_in, void* d_out, int out_size, void* d_ws, size_t ws_size, hipStream_t stream) {
    static int grid = 0;
    if (grid == 0) {
        if (n_in != 16 || in_sizes[0] != MTOK * DMOD || out_size != MTOK * DMOD || ws_size < WS_END) { fprintf(stderr, "kernel_launch: unexpected shapes (n_in %d, in0 %d, out %d, ws %zu)\n", n_in, n_in > 0 ? in_sizes[0] : -1, out_size, ws_size); grid = -1; return; }
        int dev = 0, cus = 0, per_cu = 0;
        if (hipGetDevice(&dev) != hipSuccess || hipDeviceGetAttribute(&cus, hipDeviceAttributeMultiprocessorCount, dev) != hipSuccess) { grid = -1; return; }
        if (hipFuncSetAttribute((const void*)mega_fwd, hipFuncAttributeMaxDynamicSharedMemorySize, LDS_BYTES) != hipSuccess) { fprintf(stderr, "kernel_launch: hipFuncSetAttribute failed\n"); grid = -1; return; }
        if (hipOccupancyMaxActiveBlocksPerMultiprocessor(&per_cu, (const void*)mega_fwd, NWAVES * 64, LDS_BYTES) != hipSuccess || per_cu < 1) { fprintf(stderr, "kernel_launch: occupancy query says %d\n", per_cu); per_cu = 1; }
        (void)hipGetLastError();
        grid = cus;
    }
    if (grid < 0) return;
    (void)hipMemsetAsync((char*)d_ws + WS_CTL, 0, CTL_ZERO_BYTES, stream);
    Args a{};
    for (int i = 0; i < 16; ++i) a.in[i] = (const float*)d_in[i];
    a.out = (float*)d_out; a.ws = (unsigned char*)d_ws;
    void* kargs[] = {&a};
    hipError_t e = hipLaunchCooperativeKernel((const void*)mega_fwd, dim3(grid), dim3(NWAVES * 64), kargs, LDS_BYTES, stream);
    if (e != hipSuccess) fprintf(stderr, "kernel_launch: cooperative launch failed: %s (grid %d)\n", hipGetErrorString(e), grid);
}
```

```cpp
#include <hip/hip_runtime.h>
#include <cstdio>
#include <cstdint>
namespace pg8 {
#define PG8_LAS __attribute__((address_space(3)))
typedef unsigned short bf16_t;
typedef short bf16x8 __attribute__((ext_vector_type(8)));
typedef float f32x4 __attribute__((ext_vector_type(4)));
typedef unsigned u32x4 __attribute__((ext_vector_type(4)));
constexpr int BM = 256, BK = 64, HALF = 128, HTB = HALF * BK * 2  , STAGE_BYTES = 8 * HTB, NXCD = 8, WGM = 8;

__host__ __device__ __forceinline__ int lds_byte(int r, int c) { const int st = (r >> 4) * 2 + (c >> 5), rr = r & 15, cc = c & 31, ob = rr * 64 + cc * 2; return st * 1024 + (ob ^ (((ob >> 9) & 1) << 5)); }
__host__ __device__ __forceinline__ void stage_rc(int b, int& R, int& C) { const int st = b / 1024, sb = b % 1024, swz = sb ^ (((sb >> 9) & 1) << 5); R = (st >> 1) * 16 + swz / 64; C = (st & 1) * 32 + (swz % 64) / 2; }
__host__ __device__ __forceinline__ int perm32(int rho) { const int n = rho >> 4, i = rho & 15; return 8 * (i >> 2) + 4 * n + (i & 3); }

struct Unit { int pm, pn; };
struct Gemm { const bf16_t* A; const bf16_t* Bt; int M, N, K; };

struct StaticOrder {
    int nM, nN, nwg, G, c;
    __host__ __device__ void init(int M, int N, int G_, int c_) { nM = M / BM; nN = N / BM; nwg = nM * nN; G = G_; c = c_; }
    __host__ __device__ bool next(int i, Unit& u) const {
        const long L = (long)i * G + c; if (L >= nwg) return false;
        int wgid = (int)L; { const int q = nwg / NXCD, r = nwg % NXCD, xcd = wgid % NXCD, off = wgid / NXCD; wgid = (xcd < r ? xcd * (q + 1) : r * (q + 1) + (xcd - r) * q) + off; }
        const int nig = WGM * nN, gid = wgid / nig, fm = gid * WGM, gsz = (nM - fm) < WGM ? (nM - fm) : WGM;
        u.pm = fm + ((wgid % nig) % gsz); u.pn = (wgid % nig) / gsz; return true;
    }
    __device__ __forceinline__ void a_ready(const Unit&) const {}
    __device__ __forceinline__ void done(const Unit&) const {}
};

__device__ __forceinline__ unsigned cvt_pk_bf16(float lo, float hi) { unsigned r; asm volatile("v_cvt_pk_bf16_f32 %0, %1, %2" : "=v"(r) : "v"(lo), "v"(hi)); return r; }
typedef float f32x2 __attribute__((ext_vector_type(2)));
__device__ __forceinline__ float rstd_of(float ssq) { return __builtin_amdgcn_rsqf(ssq * (1.0f / 1024.0f) + 1e-6f); }
typedef unsigned u32x2 __attribute__((ext_vector_type(2)));
template <int ACT> struct EpiRow {
    static constexpr bool PERM = true, AFTER_DRAIN = false;
    bf16_t* O; int ldc; const float* ssq; int qtiles; float qscale;
    __device__ __forceinline__ void operator()(const f32x4 (&acc)[2][2][4][2], const Unit& u, int wr, int wc, int fr, int fq) const {
        const int row0 = u.pm * BM + wr * 64 + fr, col0 = u.pn * BM + wc * 32 + 8 * fq;
        const float sc = (u.pn < qtiles) ? qscale : 1.f;
        float rsv[2][4];
#pragma unroll
        for (int ai = 0; ai < 2; ++ai)
#pragma unroll
            for (int m = 0; m < 4; ++m) rsv[ai][m] = ssq[row0 + ai * HALF + m * 16];
#pragma unroll
        for (int ai = 0; ai < 2; ++ai)
#pragma unroll
            for (int m = 0; m < 4; ++m) { const int row = row0 + ai * HALF + m * 16; const float rs = rstd_of(rsv[ai][m]) * sc; bf16_t* rowp = O + (size_t)row * ldc + col0;
#pragma unroll
                for (int bj = 0; bj < 2; ++bj) { f32x4 v0 = acc[ai][bj][m][0], v1 = acc[ai][bj][m][1];
                    if (ACT == 1) { const f32x4 z = {0.f, 0.f, 0.f, 0.f}; v0 = v0 * rs; v1 = v1 * rs; v0 = __builtin_elementwise_max(v0, z); v1 = __builtin_elementwise_max(v1, z); v0 = v0 * v0; v1 = v1 * v1; }
                    else { v0 = v0 * rs; v1 = v1 * rs; }
                    u32x4 w; w.x = cvt_pk_bf16(v0[0], v0[1]); w.y = cvt_pk_bf16(v0[2], v0[3]); w.z = cvt_pk_bf16(v1[0], v1[1]); w.w = cvt_pk_bf16(v1[2], v1[3]);
                    *(u32x4*)(rowp + bj * HALF) = w; } }
    }
};
struct EpiColScale {
    static constexpr bool PERM = true, AFTER_DRAIN = false;
    bf16_t* O; int ldc; const float* ssq;
    __device__ __forceinline__ void operator()(const f32x4 (&acc)[2][2][4][2], const Unit& u, int wr, int wc, int fr, int fq) const {
        const int row0 = u.pm * BM + wr * 64 + fr, col0 = u.pn * BM + wc * 32 + 8 * fq;
        f32x4 sv[2][2];
#pragma unroll
        for (int bj = 0; bj < 2; ++bj)
#pragma unroll
            for (int n = 0; n < 2; ++n) { const f32x4 s = *(const f32x4*)(ssq + col0 + bj * HALF + 4 * n); sv[bj][n] = (f32x4){rstd_of(s[0]), rstd_of(s[1]), rstd_of(s[2]), rstd_of(s[3])}; }
#pragma unroll
        for (int ai = 0; ai < 2; ++ai)
#pragma unroll
            for (int m = 0; m < 4; ++m) { bf16_t* rowp = O + (size_t)(row0 + ai * HALF + m * 16) * ldc + col0;
#pragma unroll
                for (int bj = 0; bj < 2; ++bj) { const f32x4 v0 = acc[ai][bj][m][0] * sv[bj][0], v1 = acc[ai][bj][m][1] * sv[bj][1];
                    u32x4 w; w.x = cvt_pk_bf16(v0[0], v0[1]); w.y = cvt_pk_bf16(v0[2], v0[3]); w.z = cvt_pk_bf16(v1[0], v1[1]); w.w = cvt_pk_bf16(v1[2], v1[3]);
                    *(u32x4*)(rowp + bj * HALF) = w; } }
    }
};
struct EpiRes {
    static constexpr bool PERM = false, AFTER_DRAIN = false;
    const float* base; float* out; bf16_t* xb; float* ssq;
    __device__ __forceinline__ void operator()(const f32x4 (&acc)[2][2][4][2], const Unit& u, int wr, int wc, int fr, int fq) const {
        const int row0 = u.pm * BM + wr * 64 + fr, col0 = u.pn * BM + wc * 32 + 4 * fq;
#pragma unroll
        for (int ai = 0; ai < 2; ++ai) {
            f32x4 pre[4][2][2];
#pragma unroll
            for (int m = 0; m < 4; ++m) { const size_t off = (size_t)(row0 + ai * HALF + m * 16) * 1024 + col0;
#pragma unroll
                for (int bj = 0; bj < 2; ++bj)
#pragma unroll
                    for (int n = 0; n < 2; ++n) pre[m][bj][n] = __builtin_nontemporal_load((const f32x4*)(base + off + bj * HALF + n * 16)); }
            asm volatile("" ::: "memory");
#pragma unroll
            for (int m = 0; m < 4; ++m) { const int row = row0 + ai * HALF + m * 16; const size_t off = (size_t)row * 1024 + col0; float s = 0.f;
#pragma unroll
                for (int bj = 0; bj < 2; ++bj)
#pragma unroll
                    for (int n = 0; n < 2; ++n) { const f32x4 v = pre[m][bj][n] + acc[ai][bj][m][n];
                        __builtin_nontemporal_store(v, (f32x4*)(out + off + bj * HALF + n * 16)); s += (v[0] * v[0] + v[1] * v[1]) + (v[2] * v[2] + v[3] * v[3]);
                        u32x2 w; w.x = cvt_pk_bf16(v[0], v[1]); w.y = cvt_pk_bf16(v[2], v[3]); *(u32x2*)(xb + off + bj * HALF + n * 16) = w; }
                s += __shfl_xor(s, 16); s += __shfl_xor(s, 32);
                if (fq == 0) __hip_atomic_fetch_add(ssq + row, s, __ATOMIC_RELAXED, __HIP_MEMORY_SCOPE_AGENT); }
            asm volatile("" ::: "memory");
        }
    }
};

struct EpiResFinal {
    static constexpr bool PERM = false, AFTER_DRAIN = true;
    const float* base; float* out; float* ssq; unsigned* cnt; const float* gain;
    __device__ __forceinline__ void operator()(const f32x4 (&)[2][2][4][2], const Unit&, int, int, int, int) const {}
    __device__ __forceinline__ void fused(f32x4 (&acc)[2][2][4][2], const Unit& u, int wr, int wc, int fr, int fq, PG8_LAS unsigned char*, int, int lane) const {
        const int row0 = u.pm * BM + wr * 64 + fr, col0 = u.pn * BM + wc * 32 + 4 * fq;
#pragma unroll
        for (int ai = 0; ai < 2; ++ai) {
            f32x4 pre[4][2][2];
#pragma unroll
            for (int m = 0; m < 4; ++m) { const size_t off = (size_t)(row0 + ai * HALF + m * 16) * 1024 + col0;
#pragma unroll
                for (int bj = 0; bj < 2; ++bj)
#pragma unroll
                    for (int n = 0; n < 2; ++n) pre[m][bj][n] = __builtin_nontemporal_load((const f32x4*)(base + off + bj * HALF + n * 16)); }
            asm volatile("" ::: "memory");
#pragma unroll
            for (int m = 0; m < 4; ++m) { const int row = row0 + ai * HALF + m * 16; float s = 0.f;
#pragma unroll
                for (int bj = 0; bj < 2; ++bj)
#pragma unroll
                    for (int n = 0; n < 2; ++n) { const f32x4 v = pre[m][bj][n] + acc[ai][bj][m][n]; acc[ai][bj][m][n] = v; s += (v[0] * v[0] + v[1] * v[1]) + (v[2] * v[2] + v[3] * v[3]); }
                s += __shfl_xor(s, 16); s += __shfl_xor(s, 32);
                if (fq == 0) __hip_atomic_fetch_add(ssq + row, s, __ATOMIC_RELAXED, __HIP_MEMORY_SCOPE_AGENT); }
        }
        asm volatile("s_waitcnt vmcnt(0)" ::: "memory");
        unsigned* c = cnt + 64 * u.pm;
        if (lane == 0) __hip_atomic_fetch_add(c, 1u, __ATOMIC_RELAXED, __HIP_MEMORY_SCOPE_AGENT);
        { unsigned sp = 0; while ((unsigned)__builtin_amdgcn_readfirstlane(__hip_atomic_load(c, __ATOMIC_RELAXED, __HIP_MEMORY_SCOPE_AGENT)) < 32u) { __builtin_amdgcn_s_sleep(2); if (++sp > (1u << 22)) break; } }
        __builtin_amdgcn_fence(__ATOMIC_ACQUIRE, "agent");
        f32x4 gv[2][2];
#pragma unroll
        for (int bj = 0; bj < 2; ++bj)
#pragma unroll
            for (int n = 0; n < 2; ++n) gv[bj][n] = *(const f32x4*)(gain + col0 + bj * HALF + n * 16);
        float rsv[2][4];
#pragma unroll
        for (int ai = 0; ai < 2; ++ai)
#pragma unroll
            for (int m = 0; m < 4; ++m) rsv[ai][m] = __hip_atomic_load(ssq + row0 + ai * HALF + m * 16, __ATOMIC_RELAXED, __HIP_MEMORY_SCOPE_AGENT);
#pragma unroll
        for (int ai = 0; ai < 2; ++ai)
#pragma unroll
            for (int m = 0; m < 4; ++m) { const float rs = rstd_of(rsv[ai][m]); const size_t off = (size_t)(row0 + ai * HALF + m * 16) * 1024 + col0;
#pragma unroll
                for (int bj = 0; bj < 2; ++bj)
#pragma unroll
                    for (int n = 0; n < 2; ++n) __builtin_nontemporal_store(acc[ai][bj][m][n] * rs * gv[bj][n], (f32x4*)(out + off + bj * HALF + n * 16)); }
    }
};

template <class Epi, class Sched, bool ALIGN_EPI = false, bool SP2 = false>
__device__ __forceinline__ void gemm_phase(PG8_LAS unsigned char* lds, const Gemm g, const Sched& S, const Epi& E) {
    int tid_ = threadIdx.x; asm volatile("" : "+v"(tid_));
    const int tid = tid_, wid = __builtin_amdgcn_readfirstlane(tid >> 6), lane = tid & 63, wr = wid >> 2, wc = wid & 3, fr = lane & 15, fq = lane >> 4;
    const int K = g.K, nt = K / BK;
    unsigned voffA[2], voffB[2];
#pragma unroll
    for (int i = 0; i < 2; ++i) { int R, C; stage_rc(tid * 16 + i * 8192, R, C); const int Rb = Epi::PERM ? ((R & ~31) + perm32(R & 31)) : R;
        voffA[i] = (unsigned)(R * K + C) * 2u; voffB[i] = (unsigned)(Rb * K + C) * 2u; }
    const size_t kstep = (size_t)(BK * 2);
    const size_t hstep = (size_t)HALF * K * 2;
    const size_t tstep = 2 * hstep;
    const unsigned ldsw = (unsigned)wid * 1024u;
    const int aoff = lds_byte(wr * 64 + fr, fq * 8), boff = lds_byte(wc * 32 + fr, fq * 8);
#define PG8_SA(b, h) (((b) * 2 + (h)) * HTB)
#define PG8_SB(b, h) ((4 + (b) * 2 + (h)) * HTB)
#define PG8_STAGE(bufoff, gbase, voff) do { _Pragma("unroll") for (int _i = 0; _i < 2; ++_i) \
        __builtin_amdgcn_global_load_lds((const unsigned*)((const char*)(gbase) + (voff)[_i]), (PG8_LAS unsigned*)(lds + (bufoff) + ldsw + _i * 8192), 16, 0, 0); } while (0)
#define PG8_LDA(dst, b, h) do { _Pragma("unroll") for (int m = 0; m < 4; ++m) _Pragma("unroll") for (int k = 0; k < 2; ++k) dst[m][k] = *(const PG8_LAS bf16x8*)(lds + PG8_SA(b, h) + aoff + m * 2048 + k * 1024); } while (0)
#define PG8_LDB(dst, b, h) do { _Pragma("unroll") for (int n = 0; n < 2; ++n) _Pragma("unroll") for (int k = 0; k < 2; ++k) dst[n][k] = *(const PG8_LAS bf16x8*)(lds + PG8_SB(b, h) + boff + n * 2048 + k * 1024); } while (0)
#define PG8_MMA(ai, bj, At, Bt) do { __builtin_amdgcn_s_setprio(1); _Pragma("unroll") for (int m = 0; m < 4; ++m) _Pragma("unroll") for (int n = 0; n < 2; ++n) _Pragma("unroll") for (int k = 0; k < 2; ++k) \
        acc[ai][bj][m][n] = __builtin_amdgcn_mfma_f32_16x16x32_bf16(Bt[n][k], At[m][k], acc[ai][bj][m][n], 0, 0, 0); __builtin_amdgcn_s_setprio(0); } while (0)
#define PG8_WAIT_V(n) asm volatile("s_waitcnt vmcnt(" #n ")" ::: "memory")
#define PG8_WAIT_L(n) asm volatile("s_waitcnt lgkmcnt(" #n ")" ::: "memory")
#define PG8_BAR __builtin_amdgcn_s_barrier()
#define PG8_SCHED __builtin_amdgcn_sched_barrier(0)
    Unit cur, nxt; int ui = 0;
    if (!S.next(0, cur)) return;
    f32x4 acc[2][2][4][2];
#pragma unroll
    for (int a = 0; a < 2; ++a)
#pragma unroll
        for (int b = 0; b < 2; ++b)
#pragma unroll
            for (int m = 0; m < 4; ++m)
#pragma unroll
                for (int n = 0; n < 2; ++n) acc[a][b][m][n] = (f32x4){0.f, 0.f, 0.f, 0.f};
    bf16x8 At[4][2], B0[2][2], B1[2][2];
    const char* cA = (const char*)g.A + (size_t)cur.pm * tstep; const char* cB = (const char*)g.Bt + (size_t)cur.pn * tstep;
    S.a_ready(cur);
    if constexpr (SP2) {
        PG8_STAGE(PG8_SB(0, 0), cB, voffB); PG8_STAGE(PG8_SB(0, 1), cB + hstep, voffB); PG8_STAGE(PG8_SA(0, 0), cA, voffA); PG8_STAGE(PG8_SA(0, 1), cA + hstep, voffA);
        if (wr == 1) PG8_BAR;
        PG8_WAIT_V(2); PG8_BAR;
        PG8_STAGE(PG8_SB(1, 0), cB + kstep, voffB); PG8_STAGE(PG8_SA(1, 0), cA + kstep, voffA); PG8_STAGE(PG8_SB(1, 1), cB + hstep + kstep, voffB);
        PG8_WAIT_V(6); PG8_BAR;
    } else {
        PG8_STAGE(PG8_SB(0, 0), cB, voffB); PG8_STAGE(PG8_SA(0, 0), cA, voffA); PG8_STAGE(PG8_SB(0, 1), cB + hstep, voffB); PG8_STAGE(PG8_SA(0, 1), cA + hstep, voffA);
        if (wr == 1) PG8_BAR;
        PG8_WAIT_V(4); PG8_BAR;
        PG8_STAGE(PG8_SB(1, 0), cB + kstep, voffB); PG8_STAGE(PG8_SA(1, 0), cA + kstep, voffA); PG8_STAGE(PG8_SB(1, 1), cB + hstep + kstep, voffB);
        PG8_WAIT_V(6); PG8_BAR;
    }
    for (;;) {
        const bool has_next = S.next(ui + 1, nxt);
        const char* nA = has_next ? (const char*)g.A + (size_t)nxt.pm * tstep : cA; const char* nB = has_next ? (const char*)g.Bt + (size_t)nxt.pn * tstep : cB;
        for (int t = 0; t < nt; t += 2) {
            const bool last = (t == nt - 2);
            const char* a1 = cA + (size_t)(t + 1) * kstep;
            const char* a2 = last ? nA : cA + (size_t)(t + 2) * kstep; const char* b2 = last ? nB : cB + (size_t)(t + 2) * kstep;
            const char* a3 = a2 + kstep; const char* b3 = b2 + kstep;
            if (last && has_next) S.a_ready(nxt);
            if constexpr (SP2) {
            PG8_LDB(B0, 0, 0); PG8_LDB(B1, 0, 1); PG8_SCHED; PG8_LDA(At, 0, 0); PG8_STAGE(PG8_SA(1, 1), a1 + hstep, voffA);
            PG8_WAIT_V(8); PG8_WAIT_L(0); PG8_BAR; PG8_MMA(0, 0, At, B0); PG8_MMA(0, 1, At, B1); PG8_BAR; PG8_SCHED;
            PG8_LDA(At, 0, 1); PG8_STAGE(PG8_SB(0, 0), b2, voffB); PG8_STAGE(PG8_SB(0, 1), b2 + hstep, voffB); PG8_STAGE(PG8_SA(0, 0), a2, voffA);
            PG8_WAIT_V(8); PG8_WAIT_L(0); PG8_BAR; PG8_MMA(1, 0, At, B0); PG8_MMA(1, 1, At, B1); PG8_BAR; PG8_SCHED;
            PG8_LDB(B0, 1, 0); PG8_LDB(B1, 1, 1); PG8_SCHED; PG8_LDA(At, 1, 0); PG8_STAGE(PG8_SA(0, 1), a2 + hstep, voffA);
            PG8_WAIT_V(8); PG8_WAIT_L(0); PG8_BAR; PG8_MMA(0, 0, At, B0); PG8_MMA(0, 1, At, B1); PG8_BAR; PG8_SCHED;
            PG8_LDA(At, 1, 1); PG8_STAGE(PG8_SB(1, 0), b3, voffB); PG8_STAGE(PG8_SB(1, 1), b3 + hstep, voffB); PG8_STAGE(PG8_SA(1, 0), a3, voffA);
            PG8_WAIT_V(8); PG8_WAIT_L(0); PG8_BAR; PG8_MMA(1, 0, At, B0); PG8_MMA(1, 1, At, B1); PG8_BAR; PG8_SCHED;
            } else {
            PG8_LDB(B0, 0, 0); PG8_SCHED; PG8_LDA(At, 0, 0); PG8_STAGE(PG8_SA(1, 1), a1 + hstep, voffA);
            PG8_WAIT_L(8); PG8_BAR; PG8_WAIT_L(0); PG8_MMA(0, 0, At, B0); PG8_BAR; PG8_SCHED;
            PG8_LDB(B1, 0, 1); PG8_STAGE(PG8_SB(0, 0), b2, voffB);
            PG8_BAR; PG8_WAIT_L(0); PG8_MMA(0, 1, At, B1); PG8_BAR;
            PG8_LDA(At, 0, 1); PG8_STAGE(PG8_SA(0, 0), a2, voffA);
            PG8_BAR; PG8_WAIT_L(0); PG8_MMA(1, 0, At, B0); PG8_BAR; PG8_SCHED;
            PG8_STAGE(PG8_SB(0, 1), b2 + hstep, voffB);
            PG8_WAIT_V(6); PG8_BAR; PG8_MMA(1, 1, At, B1); PG8_BAR;
            PG8_LDB(B0, 1, 0); PG8_SCHED; PG8_LDA(At, 1, 0); PG8_STAGE(PG8_SA(0, 1), a2 + hstep, voffA);
            PG8_WAIT_L(8); PG8_BAR; PG8_WAIT_L(0); PG8_MMA(0, 0, At, B0); PG8_BAR; PG8_SCHED;
            PG8_LDB(B1, 1, 1); PG8_STAGE(PG8_SB(1, 0), b3, voffB);
            PG8_BAR; PG8_WAIT_L(0); PG8_MMA(0, 1, At, B1); PG8_BAR;
            PG8_LDA(At, 1, 1); PG8_STAGE(PG8_SA(1, 0), a3, voffA);
            PG8_BAR; PG8_WAIT_L(0); PG8_MMA(1, 0, At, B0); PG8_BAR; PG8_SCHED;
            PG8_STAGE(PG8_SB(1, 1), b3 + hstep, voffB);
            PG8_WAIT_V(6); PG8_BAR; PG8_MMA(1, 1, At, B1); PG8_BAR;
            }
        }
        if constexpr (ALIGN_EPI) { if (wr == 0) PG8_BAR; }
        if constexpr (!Epi::AFTER_DRAIN) { E(acc, cur, wr, wc, fr, fq); S.done(cur); }
        if (!has_next) break;
#pragma unroll
        for (int a = 0; a < 2; ++a)
#pragma unroll
            for (int b = 0; b < 2; ++b)
#pragma unroll
                for (int m = 0; m < 4; ++m)
#pragma unroll
                    for (int n = 0; n < 2; ++n) acc[a][b][m][n] = (f32x4){0.f, 0.f, 0.f, 0.f};
        cur = nxt; cA = nA; cB = nB; ++ui;
        if constexpr (ALIGN_EPI) { if (wr == 1) PG8_BAR; }
    }
    PG8_WAIT_V(0);
    if constexpr (!ALIGN_EPI) { if (wr == 0) PG8_BAR; }
    PG8_BAR;
    if constexpr (Epi::AFTER_DRAIN) { E.fused(acc, cur, wr, wc, fr, fq, lds, wid, lane); S.done(cur); }
#undef PG8_SA
#undef PG8_SB
#undef PG8_STAGE
#undef PG8_LDA
#undef PG8_LDB
#undef PG8_MMA
#undef PG8_WAIT_V
#undef PG8_WAIT_L
#undef PG8_BAR
#undef PG8_SCHED
}
}

#ifndef PG8_SP2
#define PG8_SP2 true
#endif
#ifndef PG8_ALIGN
#define PG8_ALIGN true
#endif
#include <hip/hip_bf16.h>
#include <cmath>
namespace dattn {
using bf16=__hip_bfloat16;
using bf16x8=__attribute__((ext_vector_type(8)))short;
using s16x4=__attribute__((ext_vector_type(4)))short;
using f32x16=__attribute__((ext_vector_type(16)))float;
using u32x4=__attribute__((ext_vector_type(4)))unsigned;
using u32x2=__attribute__((ext_vector_type(2)))unsigned;
constexpr int SEQ=8192,DM=3072,QB=256,NSLOT=4,KSLOT=8192,VSLOT=16384;
constexpr int LDS_K=0,LDS_V=NSLOT*KSLOT,LDS_END=LDS_V+NSLOT*VSLOT;
constexpr int OST_ROW=272,OST_WAVE=32*OST_ROW;
static_assert(8*OST_WAVE<=LDS_END,"O staging fits over the rings");
typedef __attribute__((address_space(3))) const char* lds_cptr;
typedef __attribute__((address_space(3))) char* lds_ptr;
typedef short v4i16_t __attribute__((ext_vector_type(4)));
__device__ __forceinline__ void glds16(const void*gsrc,unsigned lds_dst){unsigned keep;
  asm volatile("s_mov_b32 %0, m0\n\ts_mov_b32 m0, %2\n\ts_nop 0\n\tglobal_load_lds_dwordx4 %1, off\n\ts_mov_b32 m0, %0":"=&s"(keep):"v"(gsrc),"s"(lds_dst):"memory");}
__device__ __forceinline__ s16x4 vtr(lds_cptr p){ return __builtin_bit_cast(s16x4,__builtin_amdgcn_ds_read_tr16_b64_v4i16((__attribute__((address_space(3))) v4i16_t*)p)); }
typedef float f32x2_t __attribute__((ext_vector_type(2))); typedef __bf16 bf16x2_t __attribute__((ext_vector_type(2)));
__device__ __forceinline__ unsigned cvtpk_s(float lo,float hi){f32x2_t v={lo,hi};bf16x2_t b=__builtin_convertvector(v,bf16x2_t);return __builtin_bit_cast(unsigned,b);}
#define DWAIT_BAR(N) asm volatile("s_waitcnt vmcnt(" #N ") lgkmcnt(0)\n\ts_barrier":::"memory")
__device__ __forceinline__ void unit(int b,int qb,const bf16*Q,const bf16*__restrict__ K,const bf16*__restrict__ V,bf16*O,int opitch,char*shm){
  const int tid=threadIdx.x,lane=tid&63,r32=lane&31,hi=lane>>5; const int wid=__builtin_amdgcn_readfirstlane(tid>>6);
  const long rowbase=(long)b*SEQ; const int q0=qb*QB;
  const bf16*Qw=Q+(rowbase+q0+wid*32)*DM;
  const unsigned lds0=(unsigned)(uintptr_t)shm;
  const bf16*ksrc=K+rowbase*DM+(long)lane*DM+wid*8;
  const bf16*vsrc=V+rowbase*DM+(long)(16*(wid&3)+(lane>>2))*DM+(wid>>2)*32+(lane&3)*8;
  const unsigned kdst=lds0+LDS_K+wid*1024,vdst=lds0+LDS_V+wid*1024;
  #define DDMA(t,sl) do{ glds16(ksrc+(long)(t)*64*DM,(unsigned)__builtin_amdgcn_readfirstlane(kdst+(sl)*KSLOT)); \
      glds16(vsrc+(long)(t)*64*DM,(unsigned)__builtin_amdgcn_readfirstlane(vdst+(sl)*VSLOT)); \
      glds16(vsrc+(long)(t)*64*DM+64,(unsigned)__builtin_amdgcn_readfirstlane(vdst+(sl)*VSLOT+8192)); }while(0)
  #define SBARR() do{}while(0)
  #define DVRD(dst,vp_,cb_) do{ _Pragma("unroll") for(int c_=0;c_<4;++c_){ dst[2*c_]=vtr((vp_)+((cb_)>>1)*8192+((cb_)&1)*4096+c_*1024); dst[2*c_+1]=vtr((vp_)+((cb_)>>1)*8192+((cb_)&1)*4096+c_*1024+512); } }while(0)
  #define DVF(src,c_) (bf16x8){src[2*(c_)][0],src[2*(c_)][1],src[2*(c_)][2],src[2*(c_)][3],src[2*(c_)+1][0],src[2*(c_)+1][1],src[2*(c_)+1][2],src[2*(c_)+1][3]}
  #define DVRDC(dst,vp_,c_) do{ _Pragma("unroll") for(int b_=0;b_<4;++b_){ dst[2*b_]=vtr((vp_)+(b_>>1)*8192+(b_&1)*4096+(c_)*1024); dst[2*b_+1]=vtr((vp_)+(b_>>1)*8192+(b_&1)*4096+(c_)*1024+512); } }while(0)
  #define DPVC(src,c_) do{ _Pragma("unroll") for(int b_=0;b_<4;++b_) o[b_]=__builtin_amdgcn_mfma_f32_32x32x16_bf16(DVF(src,b_),pw[c_],o[b_],0,0,0); }while(0)
  #define DPV(src,cb_) do{ o[cb_]=__builtin_amdgcn_mfma_f32_32x32x16_bf16(DVF(src,0),pw[0],o[cb_],0,0,0); o[cb_]=__builtin_amdgcn_mfma_f32_32x32x16_bf16(DVF(src,1),pw[1],o[cb_],0,0,0); \
      o[cb_]=__builtin_amdgcn_mfma_f32_32x32x16_bf16(DVF(src,2),pw[2],o[cb_],0,0,0); o[cb_]=__builtin_amdgcn_mfma_f32_32x32x16_bf16(DVF(src,3),pw[3],o[cb_],0,0,0); }while(0)
  #define PV_PLAIN(vp_) do{ DPVC(va,0); DVRDC(va,vp_,2); DPVC(vb,1); DVRDC(vb,vp_,3); DPVC(va,2); DPVC(vb,3); }while(0)
  #define EXPS_PLAIN() do{ float ls0=0.f,ls1=0.f; \
      _Pragma("unroll") for(int r=0;r<16;++r){ p0[r]=__builtin_amdgcn_exp2f(p0[r]-mref); ls0+=p0[r]; p1[r]=__builtin_amdgcn_exp2f(p1[r]-mref); ls1+=p1[r]; } l+=ls0+ls1; \
      u32x4 w0,w1,w2,w3; w0.x=cvtpk_s(p0[0],p0[1]);w0.y=cvtpk_s(p0[2],p0[3]);w0.z=cvtpk_s(p0[4],p0[5]);w0.w=cvtpk_s(p0[6],p0[7]); \
      w1.x=cvtpk_s(p0[8],p0[9]);w1.y=cvtpk_s(p0[10],p0[11]);w1.z=cvtpk_s(p0[12],p0[13]);w1.w=cvtpk_s(p0[14],p0[15]); \
      w2.x=cvtpk_s(p1[0],p1[1]);w2.y=cvtpk_s(p1[2],p1[3]);w2.z=cvtpk_s(p1[4],p1[5]);w2.w=cvtpk_s(p1[6],p1[7]); \
      w3.x=cvtpk_s(p1[8],p1[9]);w3.y=cvtpk_s(p1[10],p1[11]);w3.z=cvtpk_s(p1[12],p1[13]);w3.w=cvtpk_s(p1[14],p1[15]); \
      pw[0]=__builtin_bit_cast(bf16x8,w0);pw[1]=__builtin_bit_cast(bf16x8,w1);pw[2]=__builtin_bit_cast(bf16x8,w2);pw[3]=__builtin_bit_cast(bf16x8,w3); }while(0)
  const int NT=(q0+QB)/64;
  DDMA(0,0); DDMA(1,1);
  bf16x8 qr[4];
  #pragma unroll
  for(int d0=0;d0<4;++d0)qr[d0]=*reinterpret_cast<const bf16x8*>(&Qw[(long)r32*DM+d0*16+hi*8]);
  asm volatile("":"+v"(qr[0]),"+v"(qr[1]),"+v"(qr[2]),"+v"(qr[3]));
  const lds_cptr shm3=(lds_cptr)shm;
  const lds_cptr kp0=shm3+LDS_K+hi*1024+r32*16;
  const lds_cptr vp0=shm3+LDS_V+((lane>>4)&1)*32+(lane&3)*8+(4*hi+((lane&15)>>2))*64;
  f32x16 o[4]; o[0]=f32x16{};o[1]=f32x16{};o[2]=f32x16{};o[3]=f32x16{};
  float mref=0.f,l=0.f;
  f32x16 negm=f32x16{};
  const int qfirst=q0+wid*32, qme=qfirst+r32;
  const int TI=(qfirst+1)>>6;
  int t=0;
  bf16x8 pw[4]; pw[0]=bf16x8{};pw[1]=bf16x8{};pw[2]=bf16x8{};pw[3]=bf16x8{};
  for(;t<TI;++t){
    const int slot=t&3;
    if(t+1<NT){DWAIT_BAR(3);}else{DWAIT_BAR(0);}
    const lds_cptr kp=kp0+slot*KSLOT; const lds_cptr vpp=vp0+((t?t-1:0)&3)*VSLOT;
    bf16x8 kf[8];
    #pragma unroll
    for(int d0=0;d0<4;++d0){ kf[2*d0]=*(const __attribute__((address_space(3))) bf16x8*)(kp+d0*2048); kf[2*d0+1]=*(const __attribute__((address_space(3))) bf16x8*)(kp+d0*2048+512); }
    s16x4 va[8],vb[8];
    f32x16 p0=__builtin_amdgcn_mfma_f32_32x32x16_bf16(kf[0],qr[0],negm,0,0,0),p1=__builtin_amdgcn_mfma_f32_32x32x16_bf16(kf[1],qr[0],negm,0,0,0);
    #pragma unroll
    for(int d0=1;d0<4;++d0){ p0=__builtin_amdgcn_mfma_f32_32x32x16_bf16(kf[2*d0],qr[d0],p0,0,0,0); p1=__builtin_amdgcn_mfma_f32_32x32x16_bf16(kf[2*d0+1],qr[d0],p1,0,0,0); }
    DVRDC(va,vpp,0);
    float mt;
    if(t==0){
      mt=__builtin_fmaxf(__builtin_fmaxf(p0[0],p0[1]),__builtin_fmaxf(p1[0],p1[1]));
      #pragma unroll
      for(int r=2;r<16;r+=2){ mt=__builtin_fmaxf(mt,__builtin_fmaxf(p0[r],p0[r+1])); mt=__builtin_fmaxf(mt,__builtin_fmaxf(p1[r],p1[r+1])); }
    } else {
      #define IMX(a_,b_) ((a_)>(b_)?(a_):(b_))
      int im=IMX(__float_as_int(p0[0]),__float_as_int(p0[1])), in=IMX(__float_as_int(p1[0]),__float_as_int(p1[1]));
      #pragma unroll
      for(int r=2;r<16;r+=2){ im=IMX(IMX(im,__float_as_int(p0[r])),__float_as_int(p0[r+1])); in=IMX(IMX(in,__float_as_int(p1[r])),__float_as_int(p1[r+1])); }
      im=IMX(im,in);
      #undef IMX
      mt=__int_as_float(im);
    }
    { auto rr=__builtin_amdgcn_permlane32_swap(__float_as_uint(mt),__float_as_uint(mt),false,false); mt=__builtin_fmaxf(__uint_as_float(rr[0]),__uint_as_float(rr[1])); }
    if(t==0||__any(mt>8.0f)){
      DVRDC(vb,vpp,1); PV_PLAIN(vpp);
      const float delta=t?__builtin_fmaxf(mt,0.f):mt; const float alpha=t?__builtin_amdgcn_exp2f(-delta):1.0f;
      #pragma unroll
      for(int cb=0;cb<4;++cb)o[cb]=o[cb]*alpha;
      l*=alpha; mref+=delta;
      #pragma unroll
      for(int r=0;r<16;++r){ p0[r]-=delta; p1[r]-=delta; negm[r]=-mref; }
      pw[0]=bf16x8{};pw[1]=bf16x8{};pw[2]=bf16x8{};pw[3]=bf16x8{};
      DVRDC(va,vpp,0);
    }
    {
      float ls0=0.f,ls1=0.f; u32x4 wq;
      DVRDC(vb,vpp,1);
      o[0]=__builtin_amdgcn_mfma_f32_32x32x16_bf16(DVF(va,0),pw[0],o[0],0,0,0);
      p0[0]=__builtin_amdgcn_exp2f(p0[0]); p0[1]=__builtin_amdgcn_exp2f(p0[1]); ls0+=p0[0]+p0[1];
      o[1]=__builtin_amdgcn_mfma_f32_32x32x16_bf16(DVF(va,1),pw[0],o[1],0,0,0);
      p0[2]=__builtin_amdgcn_exp2f(p0[2]); p0[3]=__builtin_amdgcn_exp2f(p0[3]); ls0+=p0[2]+p0[3];
      o[2]=__builtin_amdgcn_mfma_f32_32x32x16_bf16(DVF(va,2),pw[0],o[2],0,0,0);
      p0[4]=__builtin_amdgcn_exp2f(p0[4]); p0[5]=__builtin_amdgcn_exp2f(p0[5]); ls0+=p0[4]+p0[5];
      o[3]=__builtin_amdgcn_mfma_f32_32x32x16_bf16(DVF(va,3),pw[0],o[3],0,0,0);
      p0[6]=__builtin_amdgcn_exp2f(p0[6]); p0[7]=__builtin_amdgcn_exp2f(p0[7]); ls0+=p0[6]+p0[7];
      if(t+2<NT){ DDMA(t+2,(t+2)&3); }
      DVRDC(va,vpp,2);
      o[0]=__builtin_amdgcn_mfma_f32_32x32x16_bf16(DVF(vb,0),pw[1],o[0],0,0,0);
      p0[8]=__builtin_amdgcn_exp2f(p0[8]); p0[9]=__builtin_amdgcn_exp2f(p0[9]); ls0+=p0[8]+p0[9];
      wq.x=cvtpk_s(p0[0],p0[1]);
      o[1]=__builtin_amdgcn_mfma_f32_32x32x16_bf16(DVF(vb,1),pw[1],o[1],0,0,0);
      p0[10]=__builtin_amdgcn_exp2f(p0[10]); p0[11]=__builtin_amdgcn_exp2f(p0[11]); ls0+=p0[10]+p0[11];
      wq.y=cvtpk_s(p0[2],p0[3]);
      o[2]=__builtin_amdgcn_mfma_f32_32x32x16_bf16(DVF(vb,2),pw[1],o[2],0,0,0);
      p0[12]=__builtin_amdgcn_exp2f(p0[12]); p0[13]=__builtin_amdgcn_exp2f(p0[13]); ls0+=p0[12]+p0[13];
      wq.z=cvtpk_s(p0[4],p0[5]);
      o[3]=__builtin_amdgcn_mfma_f32_32x32x16_bf16(DVF(vb,3),pw[1],o[3],0,0,0);
      p0[14]=__builtin_amdgcn_exp2f(p0[14]); p0[15]=__builtin_amdgcn_exp2f(p0[15]); ls0+=p0[14]+p0[15];
      wq.w=cvtpk_s(p0[6],p0[7]);
      pw[0]=__builtin_bit_cast(bf16x8,wq);
      DVRDC(vb,vpp,3);
      o[0]=__builtin_amdgcn_mfma_f32_32x32x16_bf16(DVF(va,0),pw[2],o[0],0,0,0);
      p1[0]=__builtin_amdgcn_exp2f(p1[0]); p1[1]=__builtin_amdgcn_exp2f(p1[1]); ls1+=p1[0]+p1[1];
      wq.x=cvtpk_s(p0[8],p0[9]);
      o[1]=__builtin_amdgcn_mfma_f32_32x32x16_bf16(DVF(va,1),pw[2],o[1],0,0,0);
      p1[2]=__builtin_amdgcn_exp2f(p1[2]); p1[3]=__builtin_amdgcn_exp2f(p1[3]); ls1+=p1[2]+p1[3];
      wq.y=cvtpk_s(p0[10],p0[11]);
      o[2]=__builtin_amdgcn_mfma_f32_32x32x16_bf16(DVF(va,2),pw[2],o[2],0,0,0);
      p1[4]=__builtin_amdgcn_exp2f(p1[4]); p1[5]=__builtin_amdgcn_exp2f(p1[5]); ls1+=p1[4]+p1[5];
      wq.z=cvtpk_s(p0[12],p0[13]);
      o[3]=__builtin_amdgcn_mfma_f32_32x32x16_bf16(DVF(va,3),pw[2],o[3],0,0,0);
      p1[6]=__builtin_amdgcn_exp2f(p1[6]); p1[7]=__builtin_amdgcn_exp2f(p1[7]); ls1+=p1[6]+p1[7];
      wq.w=cvtpk_s(p0[14],p0[15]);
      pw[1]=__builtin_bit_cast(bf16x8,wq);
      o[0]=__builtin_amdgcn_mfma_f32_32x32x16_bf16(DVF(vb,0),pw[3],o[0],0,0,0);
      p1[8]=__builtin_amdgcn_exp2f(p1[8]); p1[9]=__builtin_amdgcn_exp2f(p1[9]); ls1+=p1[8]+p1[9];
      wq.x=cvtpk_s(p1[0],p1[1]);
      o[1]=__builtin_amdgcn_mfma_f32_32x32x16_bf16(DVF(vb,1),pw[3],o[1],0,0,0);
      p1[10]=__builtin_amdgcn_exp2f(p1[10]); p1[11]=__builtin_amdgcn_exp2f(p1[11]); ls1+=p1[10]+p1[11];
      wq.y=cvtpk_s(p1[2],p1[3]);
      o[2]=__builtin_amdgcn_mfma_f32_32x32x16_bf16(DVF(vb,2),pw[3],o[2],0,0,0);
      p1[12]=__builtin_amdgcn_exp2f(p1[12]); p1[13]=__builtin_amdgcn_exp2f(p1[13]); ls1+=p1[12]+p1[13];
      wq.z=cvtpk_s(p1[4],p1[5]);
      o[3]=__builtin_amdgcn_mfma_f32_32x32x16_bf16(DVF(vb,3),pw[3],o[3],0,0,0);
      p1[14]=__builtin_amdgcn_exp2f(p1[14]); p1[15]=__builtin_amdgcn_exp2f(p1[15]); ls1+=p1[14]+p1[15];
      wq.w=cvtpk_s(p1[6],p1[7]);
      pw[2]=__builtin_bit_cast(bf16x8,wq);
      wq.x=cvtpk_s(p1[8],p1[9]); wq.y=cvtpk_s(p1[10],p1[11]); wq.z=cvtpk_s(p1[12],p1[13]); wq.w=cvtpk_s(p1[14],p1[15]); pw[3]=__builtin_bit_cast(bf16x8,wq);
      l+=ls0+ls1;
    }
  }
  if(TI>0){ const lds_cptr vpp=vp0+((t+3)&3)*VSLOT; s16x4 va[8],vb[8]; DVRDC(va,vpp,0); DVRDC(vb,vpp,1); PV_PLAIN(vpp); }
  for(;t<NT;++t){
    const int slot=t&3;
    if(t+1<NT){DWAIT_BAR(3);}else{DWAIT_BAR(0);}
    if(t+2<NT){ DDMA(t+2,(t+2)&3); }
    const lds_cptr kp=kp0+slot*KSLOT; const lds_cptr vp=vp0+slot*VSLOT;
    #pragma unroll
    for(int s=0;s<2;++s){
      const int key0=64*t+32*s;
      if(key0>qfirst+31)continue;
      f32x16 p=f32x16{};
      #pragma unroll
      for(int d0=0;d0<4;++d0){ const bf16x8 kf=*(const __attribute__((address_space(3))) bf16x8*)(kp+d0*2048+s*512); p=__builtin_amdgcn_mfma_f32_32x32x16_bf16(kf,qr[d0],p,0,0,0); }
      if(key0+31>qfirst){
        #pragma unroll
        for(int r=0;r<16;++r){ const int kv=key0+(r&3)+8*(r>>2)+4*hi; if(kv>qme)p[r]=-INFINITY; } }
      float mt=__builtin_fmaxf(p[0],p[1]);
      #pragma unroll
      for(int r=2;r<16;++r)mt=__builtin_fmaxf(mt,p[r]);
      { auto rr=__builtin_amdgcn_permlane32_swap(__float_as_uint(mt),__float_as_uint(mt),false,false); mt=__builtin_fmaxf(__uint_as_float(rr[0]),__uint_as_float(rr[1])); }
      const bool first=(t==0&&s==0);
      if(first||__any(mt>mref+8.0f)){
        const float mnew=first?mt:__builtin_fmaxf(mref,mt); const float alpha=first?1.0f:__builtin_amdgcn_exp2f(mref-mnew);
        #pragma unroll
        for(int cb=0;cb<4;++cb)o[cb]=o[cb]*alpha;
        l*=alpha; mref=mnew; }
      float ls=0.f;
      #pragma unroll
      for(int r=0;r<16;++r){ p[r]=__builtin_amdgcn_exp2f(p[r]-mref); ls+=p[r]; }
      l+=ls;
      u32x4 w0,w1; w0.x=cvtpk_s(p[0],p[1]);w0.y=cvtpk_s(p[2],p[3]);w0.z=cvtpk_s(p[4],p[5]);w0.w=cvtpk_s(p[6],p[7]);
      w1.x=cvtpk_s(p[8],p[9]);w1.y=cvtpk_s(p[10],p[11]);w1.z=cvtpk_s(p[12],p[13]);w1.w=cvtpk_s(p[14],p[15]);
      const bf16x8 pb0=__builtin_bit_cast(bf16x8,w0),pb1=__builtin_bit_cast(bf16x8,w1);
      #pragma unroll
      for(int cb=0;cb<4;++cb){
        const int off=(cb>>1)*8192+(cb&1)*4096+(2*s)*1024;
        const s16x4 a0=vtr(vp+off),a1=vtr(vp+off+512),c0=vtr(vp+off+1024),c1=vtr(vp+off+1536);
        const bf16x8 v0=(bf16x8){a0[0],a0[1],a0[2],a0[3],a1[0],a1[1],a1[2],a1[3]},v1=(bf16x8){c0[0],c0[1],c0[2],c0[3],c1[0],c1[1],c1[2],c1[3]};
        o[cb]=__builtin_amdgcn_mfma_f32_32x32x16_bf16(v0,pb0,o[cb],0,0,0);
        o[cb]=__builtin_amdgcn_mfma_f32_32x32x16_bf16(v1,pb1,o[cb],0,0,0); }
    }

  }
  { auto rr=__builtin_amdgcn_permlane32_swap(__float_as_uint(l),__float_as_uint(l),false,false); l=__uint_as_float(rr[0])+__uint_as_float(rr[1]); }
  const float inv=__builtin_amdgcn_rcpf(l);
  DWAIT_BAR(0);
  const lds_ptr stg=(lds_ptr)shm+wid*OST_WAVE;
  #pragma unroll
  for(int cb=0;cb<4;++cb)
    #pragma unroll
    for(int g=0;g<4;++g){ u32x2 w; w.x=cvtpk_s(o[cb][4*g]*inv,o[cb][4*g+1]*inv); w.y=cvtpk_s(o[cb][4*g+2]*inv,o[cb][4*g+3]*inv);
      *(__attribute__((address_space(3))) u32x2*)(stg+r32*OST_ROW+(32*cb+8*g+4*hi)*2)=w; }
  asm volatile("s_waitcnt lgkmcnt(0)":::"memory");
  bf16*Ow=O+(rowbase+q0+wid*32)*(long)opitch;
  #pragma unroll
  for(int i=0;i<8;++i){ const int row=i*4+(lane>>4),ch=lane&15; const u32x4 v=*(const __attribute__((address_space(3))) u32x4*)(stg+row*OST_ROW+ch*16); *(u32x4*)(Ow+(long)row*opitch+ch*8)=v; }
  asm volatile("s_waitcnt lgkmcnt(0)\n\ts_barrier":::"memory");
  #undef DDMA
  #undef SBARR
  #undef DVRD
  #undef DVF
  #undef DPV
  #undef PV_PLAIN
  #undef DVRDC
  #undef DPVC
  #undef EXPS_PLAIN
}
struct DiffUnit { int bh; int qb; int m; };
struct DiffOrder {
  int vcu, G;
  __device__ __forceinline__ DiffOrder(int vcu_,int G_):vcu(vcu_),G(G_){}
  __device__ __forceinline__ bool next(int i,DiffUnit&u)const{
    const int ii=i>>1; u.m=i&1;
    if(G==256){ if(i>=4)return false; const int s=vcu&15; u.bh=vcu>>4; u.qb=ii?31-s:s; return true; }
    const int un=vcu+ii*G; if(un>=512)return false; u.bh=un>>5; u.qb=un&31; return true; }
};
__device__ __forceinline__ void diff_phase(char*shm,const unsigned short*PROJ,unsigned short*OA,const DiffOrder&S){
  DiffUnit u;
  for(int i=0;S.next(i,u);++i){
    const int h=u.bh&7;
    const bf16*Qp=(const bf16*)PROJ+h*128+u.m*64;
    unit(u.bh>>3,u.qb,Qp,Qp+1024,(const bf16*)PROJ+2048+h*128,u.m?((bf16*)PROJ+h*128):((bf16*)OA+h*128),u.m?DM:1024,shm);
  }
}
__device__ __forceinline__ float bflo(unsigned w){return __builtin_bit_cast(float,w<<16);}
__device__ __forceinline__ float bfhi(unsigned w){return __builtin_bit_cast(float,w&0xffff0000u);}
__device__ __forceinline__ void diff_combine(const unsigned short*PROJ,unsigned short*OA,const DiffOrder&S,float lam){
  asm volatile("s_waitcnt vmcnt(0)":::"memory");
  int tid_=threadIdx.x; asm volatile("":"+v"(tid_));
  const int lane=tid_&63; const int wid=__builtin_amdgcn_readfirstlane(tid_>>6); const int c8=(lane&7)*8;
  DiffUnit u;
  for(int i=0;S.next(i,u);i+=2){
    const int h=u.bh&7; const long row0=(long)(u.bh>>3)*SEQ+u.qb*QB+wid*32+(lane>>3);
    #pragma unroll 1
    for(int it=0;it<4;++it){
      unsigned short*ma=OA+(row0+it*8)*1024+h*128+c8; const unsigned short*pb=PROJ+(row0+it*8)*DM+h*128+c8;
      const u32x4 a0=*(const u32x4*)ma,a1=*(const u32x4*)(ma+64),b0=*(const u32x4*)pb,b1=*(const u32x4*)(pb+64);
      float o0[8],o1[8]; float ss=0.f;
      #pragma unroll
      for(int k=0;k<4;++k){ o0[2*k]=bflo(a0[k])-lam*bflo(b0[k]); o0[2*k+1]=bfhi(a0[k])-lam*bfhi(b0[k]); o1[2*k]=bflo(a1[k])-lam*bflo(b1[k]); o1[2*k+1]=bfhi(a1[k])-lam*bfhi(b1[k]); }
      #pragma unroll
      for(int k=0;k<8;++k)ss+=o0[k]*o0[k]+o1[k]*o1[k];
      ss+=__shfl_xor(ss,1); ss+=__shfl_xor(ss,2); ss+=__shfl_xor(ss,4);
      const float rs=__builtin_amdgcn_rsqf(ss*(1.0f/128.0f)+1e-6f);
      u32x4 w0,w1;
      #pragma unroll
      for(int k=0;k<4;++k){ w0[k]=cvtpk_s(o0[2*k]*rs,o0[2*k+1]*rs); w1[k]=cvtpk_s(o1[2*k]*rs,o1[2*k+1]*rs); }
      *(u32x4*)ma=w0; *(u32x4*)(ma+64)=w1;
    }
  }
}
#undef DWAIT_BAR
}
#include <hip/hip_cooperative_groups.h>
namespace cg = cooperative_groups;
constexpr int NWAVES = 8;
constexpr int SEQ = 8192, DMOD = 1024, MTOK = 2 * SEQ, FF = 4096;
constexpr int P0W = 2560;
constexpr int P1W = 3072;
constexpr float QSCALE = 0.125f * 1.4426950408889634f;
constexpr float LAMBDA_INIT1 = 0.35550906f;
constexpr size_t MiB = 1u << 20;
constexpr size_t WS_CTL = 0, CTL_ZERO_BYTES = 1 * MiB;
constexpr size_t WS_SSQ = 65536;
constexpr size_t WS_W = 2 * MiB;
constexpr size_t W_IN = 0, W_OUT = 6 * MiB, W_UP = 8 * MiB, W_DOWN = 16 * MiB, W_LAYER = 24 * MiB;
constexpr size_t WS_XB = 50 * MiB;
constexpr size_t WS_PROJ = 82 * MiB;
constexpr size_t WS_VT = WS_PROJ + 80 * MiB;
constexpr size_t WS_MIX = 178 * MiB;
constexpr size_t WS_H = WS_PROJ;
constexpr size_t WS_END = 210 * MiB;
constexpr int RING_BYTES = 131072, LDS_BYTES = 147456;

#define GAS __attribute__((address_space(1)))
#define LAS __attribute__((address_space(3)))
typedef unsigned short bf16;
typedef unsigned v4u __attribute__((ext_vector_type(4)));
typedef float f32x4 __attribute__((ext_vector_type(4)));
typedef short bf16x8 __attribute__((ext_vector_type(8)));
typedef float f32x16 __attribute__((ext_vector_type(16)));
#define LDS_WAIT() asm volatile("s_waitcnt lgkmcnt(0)" ::: "memory")
__device__ __forceinline__ unsigned f2bf(float f) { unsigned u = __builtin_bit_cast(unsigned, f); return (u + 0x7fffu + ((u >> 16) & 1u)) >> 16; }
__device__ __forceinline__ unsigned pk2(float lo, float hi) { return f2bf(lo) | (f2bf(hi) << 16); }
__device__ __forceinline__ float bf_lo(unsigned w) { return __builtin_bit_cast(float, w << 16); }
__device__ __forceinline__ float bf_hi(unsigned w) { return __builtin_bit_cast(float, w & 0xffff0000u); }
__device__ __forceinline__ float wave_sum(float v) {
#pragma unroll
    for (int o = 1; o < 64; o <<= 1) v += __shfl_xor(v, o);
    return v;
}
__device__ __forceinline__ void x_rows2_to_bf16(const float* xrow, bf16* orow, float* ssq, int lane) {
    const GAS f32x4* xr = (const GAS f32x4*)xrow + lane;
    f32x4 v[8]; float s0 = 0.f, s1 = 0.f;
#pragma unroll
    for (int j = 0; j < 8; ++j) v[j] = __builtin_nontemporal_load(xr + 64 * j);
#pragma unroll
    for (int j = 0; j < 4; ++j) { s0 += (v[j].x * v[j].x + v[j].y * v[j].y) + (v[j].z * v[j].z + v[j].w * v[j].w); s1 += (v[4 + j].x * v[4 + j].x + v[4 + j].y * v[4 + j].y) + (v[4 + j].z * v[4 + j].z + v[4 + j].w * v[4 + j].w); }
    s0 = wave_sum(s0); s1 = wave_sum(s1); if (lane == 0) { ssq[0] = s0; ssq[1] = s1; }
    GAS unsigned long long* o8 = (GAS unsigned long long*)orow + lane;
#pragma unroll
    for (int j = 0; j < 8; ++j) o8[64 * j] = (unsigned long long)pk2(v[j].x, v[j].y) | ((unsigned long long)pk2(v[j].z, v[j].w) << 32);
}

__device__ __forceinline__ int swap23(int i) { return (i & ~12) | ((i & 4) << 1) | ((i & 8) >> 1); }
__device__ __forceinline__ unsigned cvtpk2(float lo, float hi) { typedef float f2 __attribute__((ext_vector_type(2))); typedef __bf16 b2 __attribute__((ext_vector_type(2))); f2 v = {lo, hi}; b2 b = __builtin_convertvector(v, b2); return __builtin_bit_cast(unsigned, b); }
__device__ __forceinline__ void sb_unit(int b, int h, int qb, const bf16* __restrict__ proj, const bf16* __restrict__ Vt, bf16* __restrict__ mix, LAS unsigned char* stage, int lane) {
    const int r32 = lane & 31, hi = lane >> 5;
    const size_t rowbase = (size_t)b * SEQ; const int t0 = qb * 32;
    const bf16* qp = proj + (rowbase + t0 + r32) * P0W + h * 64 + hi * 8;
    bf16x8 qr[4];
#pragma unroll
    for (int d0 = 0; d0 < 4; ++d0) qr[d0] = *(const bf16x8*)(qp + d0 * 16);
    const bf16* kbase = proj + (rowbase + swap23(r32)) * P0W + 512 + h * 64 + hi * 8;
    const bf16* vbase = Vt + (size_t)(h * 64 + r32) * MTOK + rowbase + hi * 8;
    f32x16 o0 = {}, o1 = {};
    float R = 0.f;
#define SB_LOAD(KF, VF, kt_) do { const bf16* kp = kbase + (size_t)(kt_) * 32 * P0W; const bf16* vp = vbase + (kt_) * 32; \
        _Pragma("unroll") for (int d0 = 0; d0 < 4; ++d0) KF[d0] = *(const bf16x8*)(kp + d0 * 16); \
        VF[0] = *(const bf16x8*)(vp); VF[1] = *(const bf16x8*)(vp + 16); VF[2] = *(const bf16x8*)(vp + (size_t)32 * MTOK); VF[3] = *(const bf16x8*)(vp + (size_t)32 * MTOK + 16); } while (0)
#define SB_COMPUTE(KF, VF, kt_) do { \
        f32x16 p = {}; \
        _Pragma("unroll") for (int d0 = 0; d0 < 4; ++d0) p = __builtin_amdgcn_mfma_f32_32x32x16_bf16(KF[d0], qr[d0], p, 0, 0, 0); \
        const bool diag = ((kt_) == qb); \
        float sp[16], lb[16]; \
        _Pragma("unroll") for (int r = 0; r < 16; ++r) { const float z = p[r]; const float e = __builtin_amdgcn_exp2f(-__builtin_fabsf(z)); const float l = __builtin_amdgcn_logf(1.0f + e); \
            sp[r] = __builtin_fmaxf(z, 0.f) + l; lb[r] = __builtin_fminf(z, 0.f) - l; \
            if (diag) { const int koff = (r & 7) + 8 * hi + 16 * (r >> 3); if (koff >= r32) { sp[r] = 0.f; lb[r] = -INFINITY; } } } \
        float ex[16], G0, G1; \
        { float run = 0.f; \
          _Pragma("unroll") for (int j = 7; j >= 0; --j) { ex[j] = run; run += sp[j]; } G0 = run; run = 0.f; \
          _Pragma("unroll") for (int j = 7; j >= 0; --j) { ex[8 + j] = run; run += sp[8 + j]; } G1 = run; } \
        const float Gp0 = __shfl_xor(G0, 32), Gp1 = __shfl_xor(G1, 32); \
        const float base1 = R + (hi ? 0.f : Gp1), base0 = R + G1 + Gp1 + (hi ? 0.f : Gp0); \
        float w[16]; \
        _Pragma("unroll") for (int r = 0; r < 16; ++r) w[r] = __builtin_amdgcn_exp2f(lb[r] - ((r < 8) ? base0 : base1) - ex[r]); \
        R += (G0 + G1) + (Gp0 + Gp1); \
        v4u a0, a1; a0.x = cvtpk2(w[0], w[1]); a0.y = cvtpk2(w[2], w[3]); a0.z = cvtpk2(w[4], w[5]); a0.w = cvtpk2(w[6], w[7]); \
        a1.x = cvtpk2(w[8], w[9]); a1.y = cvtpk2(w[10], w[11]); a1.z = cvtpk2(w[12], w[13]); a1.w = cvtpk2(w[14], w[15]); \
        const bf16x8 pa0 = __builtin_bit_cast(bf16x8, a0), pa1 = __builtin_bit_cast(bf16x8, a1); \
        o0 = __builtin_amdgcn_mfma_f32_32x32x16_bf16(pa0, VF[0], o0, 0, 0, 0); o0 = __builtin_amdgcn_mfma_f32_32x32x16_bf16(pa1, VF[1], o0, 0, 0, 0); \
        o1 = __builtin_amdgcn_mfma_f32_32x32x16_bf16(pa0, VF[2], o1, 0, 0, 0); o1 = __builtin_amdgcn_mfma_f32_32x32x16_bf16(pa1, VF[3], o1, 0, 0, 0); \
        done = __all(R > 151.0f) != 0; } while (0)
    bf16x8 kA[4], vA[4], kB[4], vB[4];
    SB_LOAD(kA, vA, qb);
#pragma unroll
    for (int d0 = 0; d0 < 4; ++d0) { kB[d0] = kA[d0]; vB[d0] = vA[d0]; }
    if (qb > 0) SB_LOAD(kB, vB, qb - 1);
    bool done = false;
    for (int kt = qb;; kt -= 2) {
        SB_COMPUTE(kA, vA, kt);
        if (done || kt < 1) break;
        if (kt >= 2) SB_LOAD(kA, vA, kt - 2);
        SB_COMPUTE(kB, vB, kt - 1);
        if (done || kt < 2) break;
        if (kt >= 3) SB_LOAD(kB, vB, kt - 3);
    }
#undef SB_LOAD
#undef SB_COMPUTE
    LAS bf16* stg = (LAS bf16*)stage;
#pragma unroll
    for (int r = 0; r < 16; ++r) { const int orow = (r & 3) + 8 * (r >> 2) + 4 * hi; stg[orow * 64 + r32] = (bf16)f2bf(o0[r]); stg[orow * 64 + 32 + r32] = (bf16)f2bf(o1[r]); }
    LDS_WAIT(); asm volatile("" ::: "memory");
    bf16* op = mix + (rowbase + t0) * 1024 + h * 64;
#pragma unroll
    for (int i = 0; i < 4; ++i) { const int row = i * 8 + (lane >> 3), ch = lane & 7; const v4u v = *(const LAS v4u*)(stg + row * 64 + ch * 8); *(v4u*)(op + (size_t)row * 1024 + ch * 8) = v; }
    LDS_WAIT(); asm volatile("" ::: "memory");
}
__device__ __forceinline__ void conv_items(const bf16* __restrict__ proj, const float* __restrict__ cw, bf16* __restrict__ mix, int gtid, int nthreads) {
    for (int it = gtid; it < (MTOK / 8) * 64; it += nthreads) {
        const int rb = it >> 6, ch = (it & 63) * 8, m0 = rb * 8;
        float w0[8], w1[8], w2[8], c2[8], c1[8];
#pragma unroll
        for (int i = 0; i < 8; ++i) { w0[i] = cw[ch + i]; w1[i] = cw[512 + ch + i]; w2[i] = cw[1024 + ch + i]; c2[i] = 0.f; c1[i] = 0.f; }
        if ((m0 & (SEQ - 1)) != 0) {
            const v4u Ca = *(const v4u*)(proj + (size_t)(m0 - 2) * P0W + 1536 + ch), Ua = *(const v4u*)(proj + (size_t)(m0 - 2) * P0W + 2048 + ch);
            const v4u Cb = *(const v4u*)(proj + (size_t)(m0 - 1) * P0W + 1536 + ch), Ub = *(const v4u*)(proj + (size_t)(m0 - 1) * P0W + 2048 + ch);
#pragma unroll
            for (int i = 0; i < 4; ++i) { c2[2 * i] = bf_lo(Ca[i]) * bf_lo(Ua[i]); c2[2 * i + 1] = bf_hi(Ca[i]) * bf_hi(Ua[i]); c1[2 * i] = bf_lo(Cb[i]) * bf_lo(Ub[i]); c1[2 * i + 1] = bf_hi(Cb[i]) * bf_hi(Ub[i]); }
        }
#pragma unroll
        for (int r = 0; r < 8; ++r) { const bf16* rp = proj + (size_t)(m0 + r) * P0W + ch;
            const v4u Bv = __builtin_nontemporal_load((const v4u*)(rp + 1024)), Cv = __builtin_nontemporal_load((const v4u*)(rp + 1536)), Uv = __builtin_nontemporal_load((const v4u*)(rp + 2048));
            float c0[8], y[8];
#pragma unroll
            for (int i = 0; i < 4; ++i) { c0[2 * i] = bf_lo(Cv[i]) * bf_lo(Uv[i]); c0[2 * i + 1] = bf_hi(Cv[i]) * bf_hi(Uv[i]); }
#pragma unroll
            for (int i = 0; i < 8; ++i) y[i] = w0[i] * c2[i] + w1[i] * c1[i] + w2[i] * c0[i];
            v4u o;
#pragma unroll
            for (int i = 0; i < 4; ++i) o[i] = pk2(bf_lo(Bv[i]) * y[2 * i], bf_hi(Bv[i]) * y[2 * i + 1]);
            *(v4u*)(mix + (size_t)(m0 + r) * 1024 + 512 + ch) = o;
#pragma unroll
            for (int i = 0; i < 8; ++i) { c2[i] = c1[i]; c1[i] = c0[i]; } }
    }
}

typedef GAS unsigned gu32;
#define RLX_AGENT __ATOMIC_RELAXED, __HIP_MEMORY_SCOPE_AGENT
constexpr int CW_PANEL = 8192;
constexpr int CW_BAR = 4096;
constexpr int LDSCTL_OFF = RING_BYTES, MISC_OFF = LDSCTL_OFF + 320;
#define XB_TMO      128
#define XB_XCNT(j)  (256  + 64 * (j))
#define XB_XSUB(j)  (1280 + 64 * (j))
#define XB_XGEN(j)  (2304 + 64 * (j))
#define XB_TOP      3328
#define XB_TOPGEN   3392
#define XCD_BAR_WORDS 3456
#define XB_SPIN_CAP (1u << 18)

__device__ __forceinline__ unsigned xb_ld(unsigned* p)              { return __hip_atomic_load(p, __ATOMIC_RELAXED, __HIP_MEMORY_SCOPE_AGENT); }
__device__ __forceinline__ unsigned xb_add(unsigned* p, unsigned v) { return __hip_atomic_fetch_add(p, v, __ATOMIC_RELAXED, __HIP_MEMORY_SCOPE_AGENT); }
__device__ __forceinline__ unsigned xb_xcc_id() { return (unsigned)__builtin_amdgcn_s_getreg((3 << 11) | 20) & 0xFu; }
#define XB_SPIN(cond, bar) do { unsigned _sp = 0; while (cond) { __builtin_amdgcn_s_sleep(1); \
    if ((++_sp & 255u) == 0u) { if (xb_ld(&(bar)[XB_TMO])) break; if (_sp > XB_SPIN_CAP) { atomicAdd(&(bar)[XB_TMO], 1u); break; } } } } while (0)

struct XcdBarrier {
    unsigned* bar; unsigned x;
    volatile LAS unsigned* st;
};

__device__ __forceinline__ XcdBarrier xcd_barrier_post(unsigned* bar, volatile LAS unsigned* st) {
    XcdBarrier b; b.bar = bar; b.x = xb_xcc_id(); b.st = st;
    if (threadIdx.x == 0) (void)xb_add(&bar[XB_XCNT(b.x)], 1u);
    return b;
}
__device__ __forceinline__ void xcd_barrier_complete(unsigned* bar, unsigned x, unsigned& nloc, unsigned& nx) {
    const unsigned G = gridDim.x * gridDim.y * gridDim.z;
    unsigned sum, cnt, mine, sp = 0u;
    for (;;) {
        sum = 0u; cnt = 0u; mine = 0u;
#pragma unroll
        for (unsigned j = 0; j < 16; ++j) { const unsigned c = xb_ld(&bar[XB_XCNT(j)]); sum += c; cnt += (c > 0u) ? 1u : 0u; mine = (j == x) ? c : mine; }
        if (sum == G) break;
        __builtin_amdgcn_s_sleep(1);
        if ((++sp & 255u) == 0u) { if (xb_ld(&bar[XB_TMO])) break; if (sp > XB_SPIN_CAP) { atomicAdd(&bar[XB_TMO], 1u); break; } }
    }
    nloc = mine > 0u ? mine : 1u; nx = cnt > 0u ? cnt : 1u;
}

__device__ __forceinline__ void xcd_barrier_thread0(const XcdBarrier& b) {
    {
        unsigned* bar = b.bar;
        __builtin_amdgcn_s_waitcnt(0);
        unsigned nloc = b.st[0], nx = b.st[1];
        if (nloc == 0u) { xcd_barrier_complete(bar, b.x, nloc, nx); b.st[0] = nloc; b.st[1] = nx; }
        const unsigned old = xb_add(&bar[XB_XSUB(b.x)], 1u);
        const unsigned gen = old / nloc;
        if (old + 1u == (gen + 1u) * nloc) {
            __builtin_amdgcn_fence(__ATOMIC_RELEASE, "agent");
            asm volatile("s_waitcnt vmcnt(0)" ::: "memory");
            const unsigned og = xb_add(&bar[XB_TOP], 1u);
            const unsigned tg = og / nx;
            if (og + 1u == (tg + 1u) * nx) xb_add(&bar[XB_TOPGEN], 1u);
            else XB_SPIN(xb_ld(&bar[XB_TOPGEN]) == tg, bar);
            __builtin_amdgcn_fence(__ATOMIC_ACQUIRE, "agent");
            xb_add(&bar[XB_XGEN(b.x)], 1u);
            asm volatile("s_waitcnt vmcnt(0)" ::: "memory");
        } else {
            XB_SPIN(xb_ld(&bar[XB_XGEN(b.x)]) == gen, bar);
            __builtin_amdgcn_fence(__ATOMIC_ACQUIRE, "agent");
            asm volatile("s_waitcnt vmcnt(0)" ::: "memory");
        }
    }
}
__device__ __forceinline__ void xcd_barrier(const XcdBarrier& b) {
    asm volatile("s_waitcnt vmcnt(0)" ::: "memory");
    __syncthreads();
    if (threadIdx.x == 0) xcd_barrier_thread0(b);
    __syncthreads();
}
#define LAYER_TAIL(layer) \
        { PHASE_IDS pg8::Gemm g{MIXp, WLp(layer, W_OUT), MTOK, 1024, 1024}; pg8::StaticOrder S; S.init(MTOK, 1024, G, bx); \
          pg8::EpiRes E{layer ? (const float*)XRES : XIN, XRES, XBp, SSQ(2 * layer + 1)}; \
          pg8::gemm_phase<pg8::EpiRes, pg8::StaticOrder, PG8_ALIGN, PG8_SP2>(ldsp, g, S, E); } \
        if (layer == 0) xcd_barrier_work(bar, args, WSLICE(3), ldsp); else xcd_barrier(bar); \
        { PHASE_IDS pg8::Gemm g{XBp, WLp(layer, W_UP), MTOK, FF, 1024}; pg8::StaticOrder S; S.init(MTOK, FF, G, bx); \
          pg8::EpiRow<1> E{HBp, FF, SSQ(2 * layer + 1), 0, 1.f}; \
          pg8::gemm_phase<pg8::EpiRow<1>, pg8::StaticOrder, PG8_ALIGN, PG8_SP2>(ldsp, g, S, E); } \
        if (layer == 0) xcd_barrier_work(bar, args, WSLICE(4), ldsp); else xcd_barrier(bar); \
        if (layer == 1 && gridDim.x == 256) {     \
          PHASE_IDS pg8::Gemm g{HBp, WLp(layer, W_DOWN), MTOK, 1024, FF}; pg8::StaticOrder S; S.init(MTOK, 1024, G, bx); \
          pg8::EpiResFinal E{XRES, XRES, SSQ(4), (unsigned*)(args.ws + WS_CTL) + CW_PANEL, args.in[3]}; \
          pg8::gemm_phase<pg8::EpiResFinal, pg8::StaticOrder, false, PG8_SP2>(ldsp, g, S, E); \
        } else { \
        { PHASE_IDS pg8::Gemm g{HBp, WLp(layer, W_DOWN), MTOK, 1024, FF}; pg8::StaticOrder S; S.init(MTOK, 1024, G, bx); \
          pg8::EpiRes E{XRES, XRES, XBp, SSQ(2 * layer + 2)}; \
          pg8::gemm_phase<pg8::EpiRes, pg8::StaticOrder, PG8_ALIGN, PG8_SP2>(ldsp, g, S, E); } \
        if (layer == 0) xcd_barrier_work(bar, args, WSLICE(5), ldsp); else xcd_barrier(bar); }
constexpr int I_IN = 16 * 96, I_OUT = 16 * 32, I_UP = 16 * 128, I_DN = 64 * 32, I_L = I_IN + I_OUT + I_UP + I_DN;
struct Args { const float* in[16]; float* out; unsigned char* ws; };
struct CvtItem { const float* wp; bf16* op; int N, K; f32x4 g0, g1; };
__device__ __forceinline__ void cvt_decode(const Args& args, int it, int lane, CvtItem& d) {
    const int l = it / I_L; int r = it % I_L;
    const float* W; bf16* WT; int K = 1024, N; const float* gs = nullptr; int gmask = 1023; float gmul = 1.f; bool remap = false;
    if (r < I_IN) { W = l ? args.in[7] : args.in[4]; N = 3072; WT = (bf16*)(args.ws + WS_W + (size_t)l * W_LAYER + W_IN); gs = args.in[1] + l * 1024; remap = (l == 0); }
    else if ((r -= I_IN) < I_OUT) { W = l ? args.in[13] : args.in[6]; N = 1024; WT = (bf16*)(args.ws + WS_W + (size_t)l * W_LAYER + W_OUT); gs = l ? args.in[12] : nullptr; gmask = 127; gmul = 1.0f - LAMBDA_INIT1; }
    else if ((r -= I_OUT) < I_UP) { W = args.in[14] + (size_t)l * 1024 * 4096; N = 4096; WT = (bf16*)(args.ws + WS_W + (size_t)l * W_LAYER + W_UP); gs = args.in[2] + l * 1024; }
    else { r -= I_UP; W = args.in[15] + (size_t)l * 4096 * 1024; K = 4096; N = 1024; WT = (bf16*)(args.ws + WS_W + (size_t)l * W_LAYER + W_DOWN); }
    const int nblk = N / 32, kb = r / nblk, nb = r % nblk, k0 = 64 * kb, n0 = 32 * nb, c = lane & 7;
    int r0 = n0; if (remap) r0 = n0 < 1024 ? n0 : (n0 < 1536 ? n0 + 1536 : n0 - 512);
    d.N = N; d.K = K; d.wp = W + (size_t)(k0 + (lane >> 3)) * N + n0 + 4 * c; d.op = WT + (size_t)(r0 + (lane >> 3)) * K + k0 + 8 * c;
    d.g0 = (f32x4){1.f, 1.f, 1.f, 1.f}; d.g1 = d.g0;
    if (gs) { const float* gp = gs + ((k0 + 8 * c) & gmask); d.g0 = *(const f32x4*)gp * gmul; d.g1 = *(const f32x4*)(gp + 4) * gmul; }
}
__device__ __forceinline__ void cvt_load(const CvtItem& d, f32x4 (&v)[8]) {
#pragma unroll
    for (int i = 0; i < 8; ++i) v[i] = __builtin_nontemporal_load((const f32x4*)(d.wp + (size_t)(8 * i) * d.N));
}
__device__ __forceinline__ void cvt_lds_write(const f32x4 (&v)[8], LAS float* scr, int lane) {
    const int c = lane & 7;
#pragma unroll
    for (int i = 0; i < 8; ++i) { LAS float* p = scr + (8 * i + (lane >> 3)) * 33 + 4 * c; p[0] = v[i][0]; p[1] = v[i][1]; p[2] = v[i][2]; p[3] = v[i][3]; }
    LDS_WAIT(); asm volatile("" ::: "memory");
}
__device__ __forceinline__ void cvt_lds_read_store(const CvtItem& d, LAS float* scr, int lane) {
    const int c = lane & 7;
#pragma unroll
    for (int j = 0; j < 4; ++j) { const LAS float* s = scr + (8 * c) * 33 + (lane >> 3) + 8 * j;
        v4u o; o.x = pk2(s[0 * 33] * d.g0[0], s[1 * 33] * d.g0[1]); o.y = pk2(s[2 * 33] * d.g0[2], s[3 * 33] * d.g0[3]); o.z = pk2(s[4 * 33] * d.g1[0], s[5 * 33] * d.g1[1]); o.w = pk2(s[6 * 33] * d.g1[2], s[7 * 33] * d.g1[3]);
        *(GAS v4u*)(d.op + (size_t)(8 * j) * d.K) = o; }
    LDS_WAIT(); asm volatile("" ::: "memory");
}
__device__ __forceinline__ void convert_items(const Args& args, int lo, int hi, int gw, int NGW, int lane, LAS float* scr) {
    int it = lo + gw; if (it >= hi) return;
    CvtItem A, B, C; f32x4 va[8], vb[8];
    cvt_decode(args, it, lane, A); cvt_load(A, va);
    bool hb = (it + NGW) < hi; B = A;
#pragma unroll
    for (int i = 0; i < 8; ++i) vb[i] = va[i];
    if (hb) { cvt_decode(args, it + NGW, lane, B); cvt_load(B, vb); }
    for (;;) {
        cvt_lds_write(va, scr, lane);
        const bool hc = (it + 2 * NGW) < hi; C = A;
        if (hc) { cvt_decode(args, it + 2 * NGW, lane, C); cvt_load(C, va); }
        cvt_lds_read_store(A, scr, lane);
        if (!hb) break;
        cvt_lds_write(vb, scr, lane);
        const bool hd = (it + 3 * NGW) < hi; A = B;
        CvtItem D = B;
        if (hd) { cvt_decode(args, it + 3 * NGW, lane, D); cvt_load(D, vb); }
        cvt_lds_read_store(A, scr, lane);
        if (!hc) break;
        A = C; B = D; hb = hd; it += 2 * NGW;
    }
}
#define CONVERT_ITEMS(lo, hi) convert_items(args, (lo), (hi), gw, NGW, lane, scr);
__device__ __forceinline__ void xcd_barrier_work(const XcdBarrier& b, const Args& args, int lo, int hi, LAS unsigned char* ldsp) {
    asm volatile("s_waitcnt vmcnt(0)" ::: "memory");
    __syncthreads();
    int tid = threadIdx.x; asm volatile("" : "+v"(tid));
    const int wave = __builtin_amdgcn_readfirstlane(tid >> 6);
    if (wave == 0) { if (tid == 0) xcd_barrier_thread0(b); }
    else { int G = gridDim.x, bx = blockIdx.x; asm volatile("" : "+s"(G), "+s"(bx)); const int vcu = (G % 8 == 0) ? (bx % 8) * (G / 8) + bx / 8 : bx;
           convert_items(args, lo, hi, vcu * 7 + (wave - 1), G * 7, tid & 63, (LAS float*)(ldsp + wave * 16384)); }
    __syncthreads();
}
constexpr int I_W = (2 * I_L - I_IN) / 6;
#define WSLICE(k) (I_IN + (k) * I_W), (I_IN + ((k) + 1) * I_W)
static_assert((2 * I_L - I_IN) % 6 == 0 && I_IN + 1 * I_W >= I_IN + I_OUT && I_IN + 2 * I_W >= I_IN + I_OUT + I_UP && I_IN + 3 * I_W >= I_L && I_IN + 4 * I_W >= I_L + I_IN + I_OUT, "slice k is published by barrier k+1: out0 by 1, up0 by 2, down0 by 3, in1 by 4, out1 by 6, up1 by 7, down1 by 8");

__global__ void __launch_bounds__(NWAVES * 64, 2) mega_fwd(Args args) {
    extern __shared__ __attribute__((aligned(16))) unsigned char lds[];
    cg::grid_group grid = cg::this_grid();
    LAS unsigned char* ldsp = (LAS unsigned char*)lds;
    for (int u = threadIdx.x; u < (LDS_BYTES - LDSCTL_OFF) / 4; u += NWAVES * 64) ((LAS unsigned*)(ldsp + LDSCTL_OFF))[u] = 0u;
    __syncthreads();
    const XcdBarrier bar = xcd_barrier_post((unsigned*)(args.ws + WS_CTL) + CW_BAR, (volatile LAS unsigned*)(ldsp + MISC_OFF) + 8);
#define PHASE_IDS int tid = threadIdx.x; asm volatile("" : "+v"(tid)); const int lane = tid & 63, wave = __builtin_amdgcn_readfirstlane(tid >> 6); \
    int G = gridDim.x, bx = blockIdx.x; asm volatile("" : "+s"(G), "+s"(bx)); const int vcu = (G % 8 == 0) ? (bx % 8) * (G / 8) + bx / 8 : bx; \
    const int gw = vcu * NWAVES + wave, NGW = G * NWAVES; (void)lane; (void)gw; (void)NGW; (void)tid;
#define XIN   (args.in[0])
#define XRES  (args.out)
#define SSQ(i) ((float*)(args.ws + WS_SSQ) + (size_t)(i) * MTOK)
#define XBp   ((bf16*)(args.ws + WS_XB))
#define PROJp ((bf16*)(args.ws + WS_PROJ))
#define VTp   ((bf16*)(args.ws + WS_VT))
#define MIXp  ((bf16*)(args.ws + WS_MIX))
#define HBp   ((bf16*)(args.ws + WS_H))
#define WLp(l, off) ((bf16*)(args.ws + WS_W + (size_t)(l) * W_LAYER + (off)))

    {
        PHASE_IDS
        LAS float* scr = (LAS float*)(ldsp + wave * 16384);
        CONVERT_ITEMS(0, I_IN)
        for (int m = 2 * gw; m < MTOK; m += 2 * NGW) x_rows2_to_bf16(XIN + (size_t)m * 1024, XBp + (size_t)m * 1024, SSQ(0) + m, lane);
    }
    if (args.ws == nullptr) grid.sync();
    xcd_barrier_work(bar, args, WSLICE(0), ldsp);

    {
        { PHASE_IDS pg8::Gemm g{XBp, WLp(0, W_IN), MTOK, P0W, 1024}; pg8::StaticOrder S; S.init(MTOK, P0W, G, bx);
          pg8::EpiRow<0> E{PROJp, P0W, SSQ(0), 2, QSCALE};
          pg8::gemm_phase<pg8::EpiRow<0>, pg8::StaticOrder, PG8_ALIGN, PG8_SP2>(ldsp, g, S, E); }
        { PHASE_IDS pg8::Gemm g{WLp(0, W_IN) + (size_t)P0W * 1024, XBp, 512, MTOK, 1024}; pg8::StaticOrder S; S.init(512, MTOK, G, (bx + G / 2) % G);
          pg8::EpiColScale E{VTp, MTOK, SSQ(0)};
          pg8::gemm_phase<pg8::EpiColScale, pg8::StaticOrder, PG8_ALIGN, PG8_SP2>(ldsp, g, S, E); }
        xcd_barrier_work(bar, args, WSLICE(1), ldsp);
        { PHASE_IDS
          conv_items(PROJp, args.in[5], MIXp, vcu * (NWAVES * 64) + tid, G * NWAVES * 64);
          LAS float* scr = (LAS float*)(ldsp + wave * 16384);
          for (int u = gw; u < 2 * 8 * 256; u += NGW) sb_unit(u >> 11, (u >> 8) & 7, u & 255, PROJp, VTp, MIXp, ldsp + wave * 16384 + 8704, lane);
          (void)scr; }
        xcd_barrier_work(bar, args, WSLICE(2), ldsp);
        LAYER_TAIL(0)
    }
    {
        { PHASE_IDS pg8::Gemm g{XBp, WLp(1, W_IN), MTOK, P1W, 1024}; pg8::StaticOrder S; S.init(MTOK, P1W, G, bx);
          pg8::EpiRow<0> E{PROJp, P1W, SSQ(2), 4, QSCALE};
          pg8::gemm_phase<pg8::EpiRow<0>, pg8::StaticOrder, PG8_ALIGN, PG8_SP2>(ldsp, g, S, E); }
        xcd_barrier(bar);
        { PHASE_IDS const dattn::DiffOrder S(vcu, G); dattn::diff_phase((char*)lds, PROJp, MIXp, S); }
        { PHASE_IDS float lam;
          { const float a = wave_sum(args.in[8][lane] * args.in[9][lane]), c = wave_sum(args.in[10][lane] * args.in[11][lane]); lam = __expf(a) - __expf(c) + LAMBDA_INIT1; }
          const dattn::DiffOrder S(vcu, G); dattn::diff_combine(PROJp, MIXp, S, lam); }
        xcd_barrier(bar);
        LAYER_TAIL(1)
    }
    if (gridDim.x != 256) { PHASE_IDS const float* ssq_f = SSQ(4);
      f32x4 gv[4];
#pragma unroll
      for (int j = 0; j < 4; ++j) gv[j] = ((const f32x4*)args.in[3])[lane + 64 * j];
      for (int m = 2 * gw; m < MTOK; m += 2 * NGW) { const float rs0 = pg8::rstd_of(ssq_f[m]), rs1 = pg8::rstd_of(ssq_f[m + 1]); f32x4* xr = (f32x4*)(XRES + (size_t)m * 1024) + lane;
          f32x4 v[8];
#pragma unroll
          for (int j = 0; j < 8; ++j) v[j] = xr[64 * j];
#pragma unroll
          for (int j = 0; j < 4; ++j) { xr[64 * j] = v[j] * rs0 * gv[j]; xr[256 + 64 * j] = v[4 + j] * rs1 * gv[j]; } } }
}

extern "C" void kernel_launch(void* const* d_in, const int* in_sizes, int n_in, void* d_out, int out_size, void* d_ws, size_t ws_size, hipStream_t stream) {
    static int grid = 0;
    if (grid == 0) {
        if (n_in != 16 || in_sizes[0] != MTOK * DMOD || out_size != MTOK * DMOD || ws_size < WS_END) { fprintf(stderr, "kernel_launch: unexpected shapes (n_in %d, in0 %d, out %d, ws %zu)\n", n_in, n_in > 0 ? in_sizes[0] : -1, out_size, ws_size); grid = -1; return; }
        int dev = 0, cus = 0, per_cu = 0;
        if (hipGetDevice(&dev) != hipSuccess || hipDeviceGetAttribute(&cus, hipDeviceAttributeMultiprocessorCount, dev) != hipSuccess) { grid = -1; return; }
        if (hipFuncSetAttribute((const void*)mega_fwd, hipFuncAttributeMaxDynamicSharedMemorySize, LDS_BYTES) != hipSuccess) { fprintf(stderr, "kernel_launch: hipFuncSetAttribute failed\n"); grid = -1; return; }
        if (hipOccupancyMaxActiveBlocksPerMultiprocessor(&per_cu, (const void*)mega_fwd, NWAVES * 64, LDS_BYTES) != hipSuccess || per_cu < 1) { fprintf(stderr, "kernel_launch: occupancy query says %d\n", per_cu); per_cu = 1; }
        (void)hipGetLastError();
        grid = cus;
    }
    if (grid < 0) return;
    (void)hipMemsetAsync((char*)d_ws + WS_CTL, 0, CTL_ZERO_BYTES, stream);
    Args a{};
    for (int i = 0; i < 16; ++i) a.in[i] = (const float*)d_in[i];
    a.out = (float*)d_out; a.ws = (unsigned char*)d_ws;
    void* kargs[] = {&a};
    hipError_t e = hipLaunchCooperativeKernel((const void*)mega_fwd, dim3(grid), dim3(NWAVES * 64), kargs, LDS_BYTES, stream);
    if (e != hipSuccess) fprintf(stderr, "kernel_launch: cooperative launch failed: %s (grid %d)\n", hipGetErrorString(e), grid);
}
```
